# Optimizing an MI355X kernel written in HIP

```python
import math
import jax
import jax.numpy as jnp
from jax import lax
import numpy as np

D_MODEL = 1024
BATCH = 8
SEQ = 4096
DEPTH = 1

D_MIX = D_MODEL
CONV_CH = D_MIX // 2
CONV_GROUPS = 8
CONV_K = 3
N_HEADS = 8
N_KV_HEADS = 2
HEAD_DIM = 64
ATTN_WIDTH = N_HEADS * HEAD_DIM
KV_WIDTH = N_KV_HEADS * HEAD_DIM
IN_WIDTH = 3 * CONV_CH + ATTN_WIDTH + 2 * KV_WIDTH
WINDOW = 128
BLOCK = 128
N_BUCKETS = 32
MAX_DISTANCE = 128
PEER_HEADS = 8
PEER_NKEYS = 128
PEER_EXPERTS = PEER_NKEYS * PEER_NKEYS
PEER_DK = 128
PEER_TOPK = 16
PEER_CHUNK = 128
EPS = 1e-6

kernel_name = 'hymba_conv_swa_peer_adaln_block'


def rms_norm(x, g):
    xf = x.astype(jnp.float32)
    y = xf * lax.rsqrt(jnp.mean(xf * xf, axis=-1, keepdims=True) + EPS)
    return (y * g.astype(jnp.float32)).astype(x.dtype)


def group_rms_norm(y, g, n_groups):
    w = y.shape[-1]
    yg = y.reshape(y.shape[:-1] + (n_groups, w // n_groups))
    return rms_norm(yg, g.reshape(n_groups, w // n_groups)).reshape(y.shape)


def t5_bucket(dist):
    max_exact = N_BUCKETS // 2
    d = jnp.maximum(dist, 1).astype(jnp.float32)
    large = max_exact + (jnp.log(d / max_exact) / math.log(MAX_DISTANCE / max_exact)
                         * (N_BUCKETS - max_exact)).astype(jnp.int32)
    large = jnp.minimum(large, N_BUCKETS - 1)
    return jnp.where(dist < max_exact, dist, large)


def short_conv(b_gate, c_gate, h, conv_w):
    u = c_gate * h
    s = u.shape[1]
    up = jnp.pad(u, ((0, 0), (CONV_K - 1, 0), (0, 0)))
    y = conv_w[0] * up[:, 0:s]
    for j in range(1, CONV_K):
        y = y + conv_w[j] * up[:, j:j + s]
    return b_gate * y


def window_attention(q, k, v, rel_bias, sinks):
    bsz, s = q.shape[0], q.shape[1]
    nb = s // BLOCK
    grp = N_HEADS // N_KV_HEADS
    qb = q.reshape(bsz, nb, BLOCK, N_KV_HEADS, grp, HEAD_DIM)
    kb = k.reshape(bsz, nb, BLOCK, N_KV_HEADS, HEAD_DIM)
    vb = v.reshape(bsz, nb, BLOCK, N_KV_HEADS, HEAD_DIM)

    def with_prev(t):
        prev = jnp.concatenate([jnp.zeros_like(t[:, :1]), t[:, :-1]], axis=1)
        return jnp.concatenate([prev, t], axis=2)

    kw = with_prev(kb)
    vw = with_prev(vb)
    scores = jnp.einsum('bnqkgd,bnjkd->bnkgqj', qb, kw).astype(jnp.float32) * (HEAD_DIM ** -0.5)

    qi = jnp.arange(BLOCK)[:, None]
    kj = jnp.arange(2 * BLOCK)[None, :]
    dist = qi + BLOCK - kj
    bias = rel_bias.astype(jnp.float32)[t5_bucket(jnp.maximum(dist, 0))]
    bias = bias.transpose(2, 0, 1).reshape(N_KV_HEADS, grp, BLOCK, 2 * BLOCK)
    blk = jnp.arange(nb)[:, None, None]
    valid = (dist >= 0) & (dist < WINDOW) & (blk * BLOCK - BLOCK + kj >= 0)
    scores = jnp.where(valid[None, :, None, None], scores + bias, -jnp.inf)

    sink = sinks.astype(jnp.float32).reshape(N_KV_HEADS, grp)[None, None, :, :, None]
    m = jnp.maximum(scores.max(axis=-1), sink)
    p = jnp.exp(scores - m[..., None])
    denom = p.sum(axis=-1) + jnp.exp(sink - m)
    o = jnp.einsum('bnkgqj,bnjkd->bnkgqd', p, vw.astype(jnp.float32)) / denom[..., None]
    o = o.transpose(0, 1, 4, 2, 3, 5).reshape(bsz, s, ATTN_WIDTH)
    return o.astype(q.dtype)


def peer_ffn(h, wq, keys, u_tab, v_tab):
    bsz, s, d = h.shape

    def chunk(ht):
        t = ht.shape[0]
        q = (ht @ wq).reshape(t, PEER_HEADS, 2, PEER_DK)
        sa = jnp.einsum('thd,hnd->thn', q[:, :, 0], keys[0]).astype(jnp.float32)
        sb = jnp.einsum('thd,hnd->thn', q[:, :, 1], keys[1]).astype(jnp.float32)
        va, ia = lax.top_k(sa, PEER_TOPK)
        vb, ib = lax.top_k(sb, PEER_TOPK)
        cand = (va[..., :, None] + vb[..., None, :]).reshape(t, PEER_HEADS, PEER_TOPK * PEER_TOPK)
        cidx = (ia[..., :, None] * PEER_NKEYS + ib[..., None, :]).reshape(t, PEER_HEADS, PEER_TOPK * PEER_TOPK)
        top, pos = lax.top_k(cand, PEER_TOPK)
        eidx = jnp.take_along_axis(cidx, pos, axis=-1)
        g = jax.nn.softmax(top, axis=-1).astype(ht.dtype)
        u = u_tab[eidx]
        v = v_tab[eidx]
        a = jax.nn.gelu(jnp.einsum('thkd,td->thk', u, ht))
        return jnp.einsum('thk,thkd->td', g * a, v)

    out = lax.map(chunk, h.reshape(-1, PEER_CHUNK, d))
    return out.reshape(bsz, s, d)


def setup_inputs(seed: int = 0) -> dict:
    key = jax.random.key(seed)
    ks = jax.random.split(key, 20)
    f32 = jnp.float32
    nrm = lambda k, shp, sc: jax.random.normal(k, shp, f32) * sc
    return {
        'x': nrm(ks[0], (BATCH, SEQ, D_MODEL), 1.0),
        'c': nrm(ks[1], (BATCH, D_MODEL), 1.0),
        'w_ada': nrm(ks[2], (DEPTH, D_MODEL, 6 * D_MODEL), 0.5 * D_MODEL ** -0.5),
        'b_ada': nrm(ks[3], (DEPTH, 6 * D_MODEL), 0.02),
        'norm1_g': 1.0 + nrm(ks[4], (DEPTH, D_MODEL), 0.1),
        'w_in': nrm(ks[5], (DEPTH, D_MODEL, IN_WIDTH), D_MODEL ** -0.5),
        'conv_w': nrm(ks[6], (DEPTH, CONV_K, CONV_CH), CONV_K ** -0.5),
        'q_norm_g': 1.0 + nrm(ks[7], (DEPTH, HEAD_DIM), 0.1),
        'k_norm_g': 1.0 + nrm(ks[8], (DEPTH, HEAD_DIM), 0.1),
        'sinks': nrm(ks[9], (DEPTH, N_HEADS), 0.5),
        'rel_bias': nrm(ks[10], (N_BUCKETS, N_HEADS), 0.5),
        'conv_out_g': 1.0 + nrm(ks[11], (DEPTH, CONV_CH), 0.1),
        'attn_out_g': 1.0 + nrm(ks[12], (DEPTH, ATTN_WIDTH), 0.1),
        'w_out': nrm(ks[13], (DEPTH, D_MIX, D_MODEL), D_MIX ** -0.5),
        'norm2_g': 1.0 + nrm(ks[14], (DEPTH, D_MODEL), 0.1),
        'peer_wq': nrm(ks[15], (DEPTH, D_MODEL, PEER_HEADS * 2 * PEER_DK), D_MODEL ** -0.5),
        'peer_keys': nrm(ks[16], (DEPTH, 2, PEER_HEADS, PEER_NKEYS, PEER_DK), PEER_DK ** -0.5),
        'peer_u': nrm(ks[17], (DEPTH, PEER_EXPERTS, D_MODEL), D_MODEL ** -0.5),
        'peer_v': nrm(ks[18], (DEPTH, PEER_EXPERTS, D_MODEL), 0.5),
    }


def reference(x, c, w_ada, b_ada, norm1_g, w_in, conv_w, q_norm_g, k_norm_g, sinks, rel_bias,
              conv_out_g, attn_out_g, w_out, norm2_g, peer_wq, peer_keys, peer_u, peer_v):
    bsz, s, _ = x.shape
    cond = jax.nn.silu(c)
    splits = [CONV_CH, 2 * CONV_CH, 3 * CONV_CH, 3 * CONV_CH + ATTN_WIDTH,
              3 * CONV_CH + ATTN_WIDTH + KV_WIDTH]
    for l in range(DEPTH):
        mod = cond @ w_ada[l] + b_ada[l]
        sh1, sc1, g1, sh2, sc2, g2 = jnp.split(mod, 6, axis=-1)

        h = rms_norm(x, norm1_g[l]) * (1.0 + sc1[:, None]) + sh1[:, None]
        proj = h @ w_in[l]
        b_gate, c_gate, hc, q, k, v = jnp.split(proj, splits, axis=-1)
        y_conv = short_conv(b_gate, c_gate, hc, conv_w[l])
        q = rms_norm(q.reshape(bsz, s, N_HEADS, HEAD_DIM), q_norm_g[l])
        k = rms_norm(k.reshape(bsz, s, N_KV_HEADS, HEAD_DIM), k_norm_g[l])
        v = v.reshape(bsz, s, N_KV_HEADS, HEAD_DIM)
        y_attn = window_attention(q, k, v, rel_bias, sinks[l])
        mixed = jnp.concatenate([group_rms_norm(y_conv, conv_out_g[l], CONV_GROUPS),
                                 group_rms_norm(y_attn, attn_out_g[l], N_HEADS)], axis=-1)
        x = x + g1[:, None] * (mixed @ w_out[l])

        h2 = rms_norm(x, norm2_g[l]) * (1.0 + sc2[:, None]) + sh2[:, None]
        x = x + g2[:, None] * peer_ffn(h2, peer_wq[l], peer_keys[l], peer_u[l], peer_v[l])
    return x
```

```cpp
#include <hip/hip_runtime.h>
#include <hip/hip_cooperative_groups.h>
#include <cstdio>
#include <cstdint>
namespace cg = cooperative_groups;

#ifndef REP_MASK
#define REP_MASK 0
#endif
#ifndef USE_CG_SYNC
#define USE_CG_SYNC 0
#endif
#ifndef ATT_VAR
#define ATT_VAR 0
#endif
#ifndef V_MFMA
#define V_MFMA 1
#endif
#ifndef VS_VAR
#define VS_VAR 0
#endif
#ifndef MIX_VAR
#define MIX_VAR 0
#endif
#ifndef REP_PH
#define REP_PH -1
#endif
#ifndef REP_N
#define REP_N 0
#endif
#ifndef LATE_MASK
#define LATE_MASK 0
#endif
#ifndef LATE_VAR
#define LATE_VAR 0
#endif
#ifndef N_LAUNCH_SPLIT
#define N_LAUNCH_SPLIT 0
#endif

namespace pg8 {
#define PG8_LAS __attribute__((address_space(3)))
typedef unsigned short bf16_t;
typedef short bf16x8 __attribute__((ext_vector_type(8)));
typedef float f32x4 __attribute__((ext_vector_type(4)));
typedef unsigned u32x4 __attribute__((ext_vector_type(4)));
constexpr int BM = 256, BK = 64, HALF = 128, HTB = HALF * BK * 2  , STAGE_BYTES = 8 * HTB, NXCD = 8, WGM = 8;

__host__ __device__ __forceinline__ int lds_byte(int r, int c) { const int st = (r >> 4) * 2 + (c >> 5), rr = r & 15, cc = c & 31, ob = rr * 64 + cc * 2; return st * 1024 + (ob ^ (((ob >> 9) & 1) << 5)); }
__host__ __device__ __forceinline__ void stage_rc(int b, int& R, int& C) { const int st = b / 1024, sb = b % 1024, swz = sb ^ (((sb >> 9) & 1) << 5); R = (st >> 1) * 16 + swz / 64; C = (st & 1) * 32 + (swz % 64) / 2; }
__host__ __device__ __forceinline__ int perm32(int rho) { const int n = rho >> 4, i = rho & 15; return 8 * (i >> 2) + 4 * n + (i & 3); }

struct Unit { int pm, pn; };
struct Gemm { const bf16_t* A; const bf16_t* Bt; int M, N, K; };

struct StaticOrder {
    int nM, nN, nwg, G, c;
    __host__ __device__ void init(int M, int N, int G_, int c_) { nM = M / BM; nN = N / BM; nwg = nM * nN; G = G_; c = c_; }
    __host__ __device__ bool next(int i, Unit& u) const {
        const long L = (long)i * G + c; if (L >= nwg) return false;
        int wgid = (int)L; { const int q = nwg / NXCD, r = nwg % NXCD, xcd = wgid % NXCD, off = wgid / NXCD; wgid = (xcd < r ? xcd * (q + 1) : r * (q + 1) + (xcd - r) * q) + off; }
        const int nig = WGM * nN, gid = wgid / nig, fm = gid * WGM, gsz = (nM - fm) < WGM ? (nM - fm) : WGM;
        u.pm = fm + ((wgid % nig) % gsz); u.pn = (wgid % nig) / gsz; return true;
    }
    __device__ __forceinline__ void a_ready(const Unit&) const {}
    __device__ __forceinline__ void done(const Unit&) const {}
};

__device__ __forceinline__ unsigned cvt_pk_bf16(float lo, float hi) { unsigned r; asm volatile("v_cvt_pk_bf16_f32 %0, %1, %2" : "=v"(r) : "v"(lo), "v"(hi)); return r; }

struct EpiBf16 {
    static constexpr bool PERM = true, AFTER_DRAIN = false;
    bf16_t* O; int ldc;
    __device__ __forceinline__ void operator()(const f32x4 (&acc)[2][2][4][2], const Unit& u, int wr, int wc, int fr, int fq) const {
        const int row0 = u.pm * BM + wr * 64 + fr; const int col0 = u.pn * BM + wc * 32 + 8 * fq;
#pragma unroll
        for (int ai = 0; ai < 2; ++ai)
#pragma unroll
            for (int m = 0; m < 4; ++m) { bf16_t* rowp = O + (size_t)(row0 + ai * HALF + m * 16) * ldc + col0;
#pragma unroll
                for (int bj = 0; bj < 2; ++bj) { const f32x4 v0 = acc[ai][bj][m][0], v1 = acc[ai][bj][m][1];
                    u32x4 w; w.x = cvt_pk_bf16(v0[0], v0[1]); w.y = cvt_pk_bf16(v0[2], v0[3]); w.z = cvt_pk_bf16(v1[0], v1[1]); w.w = cvt_pk_bf16(v1[2], v1[3]);
                    *(u32x4*)(rowp + bj * HALF) = w; } }
    }
};
struct EpiGateBf16 {
    static constexpr bool PERM = true, AFTER_DRAIN = false;
    bf16_t* O; int ldc; const float* gate; int gstride; int rows_per_batch;
    __device__ __forceinline__ void operator()(const f32x4 (&acc)[2][2][4][2], const Unit& u, int wr, int wc, int fr, int fq) const {
        const int row0 = u.pm * BM + wr * 64 + fr; const int col0 = u.pn * BM + wc * 32 + 8 * fq;
        const float* gp = gate + (size_t)((u.pm * BM) / rows_per_batch) * gstride + col0;
        f32x4 gv[2][2];
#pragma unroll
        for (int bj = 0; bj < 2; ++bj)
#pragma unroll
            for (int n = 0; n < 2; ++n) gv[bj][n] = *(const f32x4*)(gp + bj * HALF + 4 * n);
#pragma unroll
        for (int ai = 0; ai < 2; ++ai)
#pragma unroll
            for (int m = 0; m < 4; ++m) { bf16_t* rowp = O + (size_t)(row0 + ai * HALF + m * 16) * ldc + col0;
#pragma unroll
                for (int bj = 0; bj < 2; ++bj) { const f32x4 v0 = acc[ai][bj][m][0] * gv[bj][0], v1 = acc[ai][bj][m][1] * gv[bj][1];
                    u32x4 w; w.x = cvt_pk_bf16(v0[0], v0[1]); w.y = cvt_pk_bf16(v0[2], v0[3]); w.z = cvt_pk_bf16(v1[0], v1[1]); w.w = cvt_pk_bf16(v1[2], v1[3]);
                    *(u32x4*)(rowp + bj * HALF) = w; } }
    }
};
struct EpiResid {
    static constexpr bool PERM = false, AFTER_DRAIN = false;
    const float* base; float* out; int ldc; const float* gate; int gstride; int rows_per_batch;
    __device__ __forceinline__ void operator()(const f32x4 (&acc)[2][2][4][2], const Unit& u, int wr, int wc, int fr, int fq) const {
        const int row0 = u.pm * BM + wr * 64 + fr; const int col0 = u.pn * BM + wc * 32 + 4 * fq;
        const float* gp = gate + (size_t)((u.pm * BM) / rows_per_batch) * gstride + col0;
        f32x4 gv[2][2];
#pragma unroll
        for (int bj = 0; bj < 2; ++bj)
#pragma unroll
            for (int n = 0; n < 2; ++n) gv[bj][n] = *(const f32x4*)(gp + bj * HALF + n * 16);
#pragma unroll
        for (int ai = 0; ai < 2; ++ai)
#pragma unroll
            for (int m = 0; m < 4; ++m) { const size_t off = (size_t)(row0 + ai * HALF + m * 16) * ldc + col0;
#pragma unroll
                for (int bj = 0; bj < 2; ++bj)
#pragma unroll
                    for (int n = 0; n < 2; ++n) { const f32x4 bs = *(const f32x4*)(base + off + bj * HALF + n * 16);
                        *(f32x4*)(out + off + bj * HALF + n * 16) = bs + gv[bj][n] * acc[ai][bj][m][n]; } }
    }
};

template <class Epi, class Sched, bool ALIGN_EPI = false, bool SP2 = false>
__device__ __forceinline__ void gemm_phase(PG8_LAS unsigned char* lds, const Gemm g, const Sched& S, const Epi& E) {
    const int tid = threadIdx.x, wid = __builtin_amdgcn_readfirstlane(tid >> 6), lane = tid & 63, wr = wid >> 2, wc = wid & 3, fr = lane & 15, fq = lane >> 4;
    const int K = g.K, nt = K / BK;
    unsigned voffA[2], voffB[2];
#pragma unroll
    for (int i = 0; i < 2; ++i) { int R, C; stage_rc(tid * 16 + i * 8192, R, C); const int Rb = Epi::PERM ? ((R & ~31) + perm32(R & 31)) : R;
        voffA[i] = (unsigned)(R * K + C) * 2u; voffB[i] = (unsigned)(Rb * K + C) * 2u; }
    const size_t kstep = (size_t)(BK * 2);
    const size_t hstep = (size_t)HALF * K * 2;
    const size_t tstep = 2 * hstep;
    const unsigned ldsw = (unsigned)wid * 1024u;
    const int aoff = lds_byte(wr * 64 + fr, fq * 8), boff = lds_byte(wc * 32 + fr, fq * 8);
#define PG8_SA(b, h) (((b) * 2 + (h)) * HTB)
#define PG8_SB(b, h) ((4 + (b) * 2 + (h)) * HTB)
#define PG8_STAGE(bufoff, gbase, voff) do { _Pragma("unroll") for (int _i = 0; _i < 2; ++_i) \
        __builtin_amdgcn_global_load_lds((const unsigned*)((const char*)(gbase) + (voff)[_i]), (PG8_LAS unsigned*)(lds + (bufoff) + ldsw + _i * 8192), 16, 0, 0); } while (0)
#define PG8_LDA(dst, b, h) do { _Pragma("unroll") for (int m = 0; m < 4; ++m) _Pragma("unroll") for (int k = 0; k < 2; ++k) dst[m][k] = *(const PG8_LAS bf16x8*)(lds + PG8_SA(b, h) + aoff + m * 2048 + k * 1024); } while (0)
#define PG8_LDB(dst, b, h) do { _Pragma("unroll") for (int n = 0; n < 2; ++n) _Pragma("unroll") for (int k = 0; k < 2; ++k) dst[n][k] = *(const PG8_LAS bf16x8*)(lds + PG8_SB(b, h) + boff + n * 2048 + k * 1024); } while (0)
#define PG8_MMA(ai, bj, At, Bt) do { __builtin_amdgcn_s_setprio(1); _Pragma("unroll") for (int m = 0; m < 4; ++m) _Pragma("unroll") for (int n = 0; n < 2; ++n) _Pragma("unroll") for (int k = 0; k < 2; ++k) \
        acc[ai][bj][m][n] = __builtin_amdgcn_mfma_f32_16x16x32_bf16(Bt[n][k], At[m][k], acc[ai][bj][m][n], 0, 0, 0); __builtin_amdgcn_s_setprio(0); } while (0)
#define PG8_WAIT_V(n) asm volatile("s_waitcnt vmcnt(" #n ")" ::: "memory")
#define PG8_WAIT_L(n) asm volatile("s_waitcnt lgkmcnt(" #n ")" ::: "memory")
#define PG8_BAR __builtin_amdgcn_s_barrier()
#define PG8_SCHED __builtin_amdgcn_sched_barrier(0)
    Unit cur, nxt; int ui = 0;
    if (!S.next(0, cur)) return;
    f32x4 acc[2][2][4][2];
#pragma unroll
    for (int a = 0; a < 2; ++a)
#pragma unroll
        for (int b = 0; b < 2; ++b)
#pragma unroll
            for (int m = 0; m < 4; ++m)
#pragma unroll
                for (int n = 0; n < 2; ++n) acc[a][b][m][n] = (f32x4){0.f, 0.f, 0.f, 0.f};
    bf16x8 At[4][2], B0[2][2], B1[2][2];
    const char* cA = (const char*)g.A + (size_t)cur.pm * tstep; const char* cB = (const char*)g.Bt + (size_t)cur.pn * tstep;
    S.a_ready(cur);
    if constexpr (SP2) {
        PG8_STAGE(PG8_SB(0, 0), cB, voffB); PG8_STAGE(PG8_SB(0, 1), cB + hstep, voffB); PG8_STAGE(PG8_SA(0, 0), cA, voffA); PG8_STAGE(PG8_SA(0, 1), cA + hstep, voffA);
        if (wr == 1) PG8_BAR;
        PG8_WAIT_V(2); PG8_BAR;
        PG8_STAGE(PG8_SB(1, 0), cB + kstep, voffB); PG8_STAGE(PG8_SA(1, 0), cA + kstep, voffA); PG8_STAGE(PG8_SB(1, 1), cB + hstep + kstep, voffB);
        PG8_WAIT_V(6); PG8_BAR;
    } else {
        PG8_STAGE(PG8_SB(0, 0), cB, voffB); PG8_STAGE(PG8_SA(0, 0), cA, voffA); PG8_STAGE(PG8_SB(0, 1), cB + hstep, voffB); PG8_STAGE(PG8_SA(0, 1), cA + hstep, voffA);
        if (wr == 1) PG8_BAR;
        PG8_WAIT_V(4); PG8_BAR;
        PG8_STAGE(PG8_SB(1, 0), cB + kstep, voffB); PG8_STAGE(PG8_SA(1, 0), cA + kstep, voffA); PG8_STAGE(PG8_SB(1, 1), cB + hstep + kstep, voffB);
        PG8_WAIT_V(6); PG8_BAR;
    }
    for (;;) {
        const bool has_next = S.next(ui + 1, nxt);
        const char* nA = has_next ? (const char*)g.A + (size_t)nxt.pm * tstep : cA; const char* nB = has_next ? (const char*)g.Bt + (size_t)nxt.pn * tstep : cB;
        for (int t = 0; t < nt; t += 2) {
            const bool last = (t == nt - 2);
            const char* a1 = cA + (size_t)(t + 1) * kstep;
            const char* a2 = last ? nA : cA + (size_t)(t + 2) * kstep; const char* b2 = last ? nB : cB + (size_t)(t + 2) * kstep;
            const char* a3 = a2 + kstep; const char* b3 = b2 + kstep;
            if (last && has_next) S.a_ready(nxt);
            if constexpr (SP2) {
            PG8_LDB(B0, 0, 0); PG8_LDB(B1, 0, 1); PG8_SCHED; PG8_LDA(At, 0, 0); PG8_STAGE(PG8_SA(1, 1), a1 + hstep, voffA);
            PG8_WAIT_V(8); PG8_WAIT_L(0); PG8_BAR; PG8_MMA(0, 0, At, B0); PG8_MMA(0, 1, At, B1); PG8_BAR; PG8_SCHED;
            PG8_LDA(At, 0, 1); PG8_STAGE(PG8_SB(0, 0), b2, voffB); PG8_STAGE(PG8_SB(0, 1), b2 + hstep, voffB); PG8_STAGE(PG8_SA(0, 0), a2, voffA);
            PG8_WAIT_V(8); PG8_WAIT_L(0); PG8_BAR; PG8_MMA(1, 0, At, B0); PG8_MMA(1, 1, At, B1); PG8_BAR; PG8_SCHED;
            PG8_LDB(B0, 1, 0); PG8_LDB(B1, 1, 1); PG8_SCHED; PG8_LDA(At, 1, 0); PG8_STAGE(PG8_SA(0, 1), a2 + hstep, voffA);
            PG8_WAIT_V(8); PG8_WAIT_L(0); PG8_BAR; PG8_MMA(0, 0, At, B0); PG8_MMA(0, 1, At, B1); PG8_BAR; PG8_SCHED;
            PG8_LDA(At, 1, 1); PG8_STAGE(PG8_SB(1, 0), b3, voffB); PG8_STAGE(PG8_SB(1, 1), b3 + hstep, voffB); PG8_STAGE(PG8_SA(1, 0), a3, voffA);
            PG8_WAIT_V(8); PG8_WAIT_L(0); PG8_BAR; PG8_MMA(1, 0, At, B0); PG8_MMA(1, 1, At, B1); PG8_BAR; PG8_SCHED;
            } else {
            PG8_LDB(B0, 0, 0); PG8_SCHED; PG8_LDA(At, 0, 0); PG8_STAGE(PG8_SA(1, 1), a1 + hstep, voffA);
            PG8_WAIT_L(8); PG8_BAR; PG8_WAIT_L(0); PG8_MMA(0, 0, At, B0); PG8_BAR; PG8_SCHED;
            PG8_LDB(B1, 0, 1); PG8_STAGE(PG8_SB(0, 0), b2, voffB);
            PG8_BAR; PG8_WAIT_L(0); PG8_MMA(0, 1, At, B1); PG8_BAR;
            PG8_LDA(At, 0, 1); PG8_STAGE(PG8_SA(0, 0), a2, voffA);
            PG8_BAR; PG8_WAIT_L(0); PG8_MMA(1, 0, At, B0); PG8_BAR; PG8_SCHED;
            PG8_STAGE(PG8_SB(0, 1), b2 + hstep, voffB);
            PG8_WAIT_V(6); PG8_BAR; PG8_MMA(1, 1, At, B1); PG8_BAR;
            PG8_LDB(B0, 1, 0); PG8_SCHED; PG8_LDA(At, 1, 0); PG8_STAGE(PG8_SA(0, 1), a2 + hstep, voffA);
            PG8_WAIT_L(8); PG8_BAR; PG8_WAIT_L(0); PG8_MMA(0, 0, At, B0); PG8_BAR; PG8_SCHED;
            PG8_LDB(B1, 1, 1); PG8_STAGE(PG8_SB(1, 0), b3, voffB);
            PG8_BAR; PG8_WAIT_L(0); PG8_MMA(0, 1, At, B1); PG8_BAR;
            PG8_LDA(At, 1, 1); PG8_STAGE(PG8_SA(1, 0), a3, voffA);
            PG8_BAR; PG8_WAIT_L(0); PG8_MMA(1, 0, At, B0); PG8_BAR; PG8_SCHED;
            PG8_STAGE(PG8_SB(1, 1), b3 + hstep, voffB);
            PG8_WAIT_V(6); PG8_BAR; PG8_MMA(1, 1, At, B1); PG8_BAR;
            }
        }
        if constexpr (ALIGN_EPI) { if (wr == 0) PG8_BAR; }
        if constexpr (!Epi::AFTER_DRAIN) { E(acc, cur, wr, wc, fr, fq); S.done(cur); }
        if (!has_next) break;
#pragma unroll
        for (int a = 0; a < 2; ++a)
#pragma unroll
            for (int b = 0; b < 2; ++b)
#pragma unroll
                for (int m = 0; m < 4; ++m)
#pragma unroll
                    for (int n = 0; n < 2; ++n) acc[a][b][m][n] = (f32x4){0.f, 0.f, 0.f, 0.f};
        cur = nxt; cA = nA; cB = nB; ++ui;
        if constexpr (ALIGN_EPI) { if (wr == 1) PG8_BAR; }
    }
    PG8_WAIT_V(0);
    if constexpr (!ALIGN_EPI) { if (wr == 0) PG8_BAR; }
    PG8_BAR;
#undef PG8_SA
#undef PG8_SB
#undef PG8_STAGE
#undef PG8_LDA
#undef PG8_LDB
#undef PG8_MMA
#undef PG8_WAIT_V
#undef PG8_WAIT_L
#undef PG8_BAR
#undef PG8_SCHED
}
}

constexpr int NWAVES = 8, NTHREADS = 512;
constexpr int BATCH = 8, SEQ = 4096, D = 1024, T = BATCH * SEQ;
constexpr int NIN = 2304, NQ = 2048, NEXP = 16384;
constexpr int C_B = 0, C_C = 512, C_H = 1024, C_Q = 1536, C_K = 2048, C_V = 2176;
constexpr float EPS = 1e-6f;
constexpr size_t MiB = 1u << 20;
constexpr size_t WS_CTL = 0;
constexpr size_t WS_MOD = 1 * MiB;
constexpr size_t WS_BIAS = WS_MOD + 256 * 1024;
constexpr size_t WS_WIN = 2 * MiB;
constexpr size_t WS_WOUT = 7 * MiB;
constexpr size_t WS_WQ = 9 * MiB;
constexpr size_t WS_KEYS = 13 * MiB;
constexpr size_t WS_SU = WS_MOD + 384 * 1024;
constexpr size_t WS_SV = WS_MOD + 448 * 1024;
constexpr size_t WS_U = 14 * MiB;
constexpr size_t WS_V = 30 * MiB;
constexpr size_t WS_H = 78 * MiB;
constexpr size_t WS_MIX = 142 * MiB;
constexpr size_t WS_H4 = WS_MIX + 16 * MiB;
constexpr size_t WS_ST = WS_MOD + 512 * 1024;
constexpr size_t WS_CP = WS_MIX + 48 * MiB;
constexpr size_t WS_CS = WS_MOD + 640 * 1024;
constexpr size_t WS_PACK = WS_MIX;
constexpr size_t WS_PROJ = 206 * MiB;
constexpr size_t WS_PART = WS_PROJ;
constexpr size_t WS_EIDX = 350 * MiB;
constexpr size_t WS_GATE = 366 * MiB;
constexpr size_t WS_DELTA = 382 * MiB;
constexpr size_t WS_END = 510 * MiB;

constexpr int LDS_BYTES = 147456;

#define GAS __attribute__((address_space(1)))
#define LAS __attribute__((address_space(3)))
typedef unsigned short bf16;
typedef unsigned v4u __attribute__((ext_vector_type(4)));
typedef unsigned v2u __attribute__((ext_vector_type(2)));
typedef float f32x4 __attribute__((ext_vector_type(4)));
typedef float f32x16 __attribute__((ext_vector_type(16)));
typedef short bf16x8 __attribute__((ext_vector_type(8)));
typedef int v8i __attribute__((ext_vector_type(8)));

__device__ __forceinline__ unsigned f2bf(float f) { unsigned u = __builtin_bit_cast(unsigned, f); return (u + 0x7fffu + ((u >> 16) & 1u)) >> 16; }
__device__ __forceinline__ unsigned pk2(float lo, float hi) { unsigned r; asm("v_cvt_pk_bf16_f32 %0, %1, %2" : "=v"(r) : "v"(lo), "v"(hi)); return r; }
__device__ __forceinline__ float bf_lo(unsigned w) { return __builtin_bit_cast(float, w << 16); }
__device__ __forceinline__ float bf_hi(unsigned w) { return __builtin_bit_cast(float, w & 0xffff0000u); }
__device__ __forceinline__ float wave_sum(float v) {
#pragma unroll
    for (int o = 1; o < 64; o <<= 1) v += __shfl_xor(v, o);
    return v;
}

#define XB_TMO      128
#define XB_XCNT(j)  (256  + 64 * (j))
#define XB_XSUB(j)  (1280 + 64 * (j))
#define XB_XGEN(j)  (2304 + 64 * (j))
#define XB_TOP      3328
#define XB_TOPGEN   3392
#define XCD_BAR_WORDS 3456
#define XB_SPIN_CAP (1u << 18)
__device__ __forceinline__ unsigned xb_ld(unsigned* p)              { return __hip_atomic_load(p, __ATOMIC_RELAXED, __HIP_MEMORY_SCOPE_AGENT); }
__device__ __forceinline__ unsigned xb_add(unsigned* p, unsigned v) { return __hip_atomic_fetch_add(p, v, __ATOMIC_RELAXED, __HIP_MEMORY_SCOPE_AGENT); }
__device__ __forceinline__ unsigned xb_xcc_id() { return (unsigned)__builtin_amdgcn_s_getreg((3 << 11) | 20) & 0xFu; }
#define XB_SPIN(cond, bar) do { unsigned _sp = 0; while (cond) { __builtin_amdgcn_s_sleep(1); \
    if ((++_sp & 255u) == 0u) { if (xb_ld(&(bar)[XB_TMO])) break; if (_sp > XB_SPIN_CAP) { atomicAdd(&(bar)[XB_TMO], 1u); break; } } } } while (0)
struct XcdBarrier { unsigned* bar; unsigned x; volatile LAS unsigned* st; };
__device__ __forceinline__ XcdBarrier xcd_barrier_post(unsigned* bar, volatile LAS unsigned* st) {
    XcdBarrier b; b.bar = bar; b.x = xb_xcc_id(); b.st = st;
    if (threadIdx.x == 0) (void)xb_add(&bar[XB_XCNT(b.x)], 1u);
    return b;
}
__device__ __forceinline__ void xcd_barrier_complete(unsigned* bar, unsigned x, unsigned& nloc, unsigned& nx) {
    const unsigned G = gridDim.x * gridDim.y * gridDim.z;
    unsigned sum, cnt, mine, sp = 0u;
    for (;;) {
        sum = 0u; cnt = 0u; mine = 0u;
#pragma unroll
        for (unsigned j = 0; j < 16; ++j) { const unsigned c = xb_ld(&bar[XB_XCNT(j)]); sum += c; cnt += (c > 0u) ? 1u : 0u; mine = (j == x) ? c : mine; }
        if (sum == G) break;
        __builtin_amdgcn_s_sleep(1);
        if ((++sp & 255u) == 0u) { if (xb_ld(&bar[XB_TMO])) break; if (sp > XB_SPIN_CAP) { atomicAdd(&bar[XB_TMO], 1u); break; } }
    }
    nloc = mine > 0u ? mine : 1u; nx = cnt > 0u ? cnt : 1u;
}
__device__ __forceinline__ void xcd_barrier(const XcdBarrier& b) {
    asm volatile("s_waitcnt vmcnt(0)" ::: "memory");
    __syncthreads();
    if (threadIdx.x == 0) {
        unsigned* bar = b.bar;
        __builtin_amdgcn_s_waitcnt(0);
        unsigned nloc = b.st[0], nx = b.st[1];
        if (nloc == 0u) { xcd_barrier_complete(bar, b.x, nloc, nx); b.st[0] = nloc; b.st[1] = nx; }
        const unsigned old = xb_add(&bar[XB_XSUB(b.x)], 1u);
        const unsigned gen = old / nloc;
        if (old + 1u == (gen + 1u) * nloc) {
            __builtin_amdgcn_fence(__ATOMIC_RELEASE, "agent");
            asm volatile("s_waitcnt vmcnt(0)" ::: "memory");
            const unsigned og = xb_add(&bar[XB_TOP], 1u);
            const unsigned tg = og / nx;
            if (og + 1u == (tg + 1u) * nx) xb_add(&bar[XB_TOPGEN], 1u);
            else XB_SPIN(xb_ld(&bar[XB_TOPGEN]) == tg, bar);
            __builtin_amdgcn_fence(__ATOMIC_ACQUIRE, "agent");
            xb_add(&bar[XB_XGEN(b.x)], 1u);
            asm volatile("s_waitcnt vmcnt(0)" ::: "memory");
        } else {
            XB_SPIN(xb_ld(&bar[XB_XGEN(b.x)]) == gen, bar);
            __builtin_amdgcn_fence(__ATOMIC_ACQUIRE, "agent");
            asm volatile("s_waitcnt vmcnt(0)" ::: "memory");
        }
    }
    __syncthreads();
}

struct Args {
    const float *x, *c, *w_ada, *b_ada, *norm1_g, *w_in, *conv_w, *q_norm_g, *k_norm_g, *sinks, *rel_bias, *conv_out_g, *attn_out_g, *w_out, *norm2_g, *peer_wq, *peer_keys, *peer_u, *peer_v;
    float* out; unsigned char* ws; int ph_lo, ph_hi, var, pad;
};

struct Frame {
    LAS unsigned char* lds; int tid, lane, wave, G, bid;
    int sl_x, sl_rank, sl_n;
};

__device__ __forceinline__ void mod_item(const Args& a, Frame& F, int item) {
    LAS float* sc = (LAS float*)F.lds;
    LAS float* red = (LAS float*)(F.lds + 32768);
    for (int i = F.tid; i < 8192; i += NTHREADS) { const float v = a.c[i]; sc[i] = v / (1.f + __expf(-v)); }
    __syncthreads();
    const int cl = F.tid & 31, kg = F.tid >> 5, col = item * 32 + cl;
    float acc[8];
#pragma unroll
    for (int b = 0; b < 8; ++b) acc[b] = 0.f;
#pragma unroll 8
    for (int k = kg * 64; k < kg * 64 + 64; ++k) { const float w = a.w_ada[(size_t)k * 6144 + col];
#pragma unroll
        for (int b = 0; b < 8; ++b) acc[b] += sc[b * 1024 + k] * w; }
#pragma unroll
    for (int b = 0; b < 8; ++b) red[(kg * 32 + cl) * 8 + b] = acc[b];
    __syncthreads();
    if (F.tid < 256) { const int b = F.tid >> 5; float s = 0.f;
#pragma unroll
      for (int g = 0; g < 16; ++g) s += red[(g * 32 + cl) * 8 + b];
      ((float*)(a.ws + WS_MOD))[b * 6144 + col] = s + a.b_ada[col]; }
    __syncthreads();
}
__device__ __forceinline__ void transpose_item(const float* W, int K, int N, bf16* WT, LAS float* scr, int item, int lane) {
    const int nblk = N / 32, kb = item / nblk, nb = item % nblk, k0 = 64 * kb, n0 = 32 * nb;
#pragma unroll 8
    for (int i = 0; i < 32; ++i) { const int kk = 2 * i + (lane >> 5); scr[kk * 33 + (lane & 31)] = W[(size_t)(k0 + kk) * N + n0 + (lane & 31)]; }
    asm volatile("s_waitcnt lgkmcnt(0)" ::: "memory");
    const int c = lane & 7;
#pragma unroll
    for (int j = 0; j < 4; ++j) { const int n = (lane >> 3) + 8 * j; const LAS float* s = scr + (8 * c) * 33 + n;
        v4u o; o.x = pk2(s[0 * 33], s[1 * 33]); o.y = pk2(s[2 * 33], s[3 * 33]); o.z = pk2(s[4 * 33], s[5 * 33]); o.w = pk2(s[6 * 33], s[7 * 33]);
        *(v4u*)(WT + (size_t)(n0 + n) * K + k0 + 8 * c) = o; }
    asm volatile("s_waitcnt lgkmcnt(0)" ::: "memory");
}
__device__ __forceinline__ void cvt_rows(const float* src, bf16* dst, size_t n8, size_t gtid, size_t gn) {
    for (size_t i = gtid; i < n8; i += gn) { const f32x4 a = ((const f32x4*)src)[2 * i], b = ((const f32x4*)src)[2 * i + 1];
        v4u o; o.x = pk2(a.x, a.y); o.y = pk2(a.z, a.w); o.z = pk2(b.x, b.y); o.w = pk2(b.z, b.w); ((v4u*)dst)[i] = o; }
}
__device__ __forceinline__ void quant_tables(const Args& a, Frame& F, int widx, int nw) {
    for (int r0 = 4 * widx; r0 < 2 * NEXP; r0 += 4 * nw) {
        const bool isv = r0 >= NEXP; const int e0 = isv ? r0 - NEXP : r0;
        const float* tab = isv ? a.peer_v : a.peer_u;
        f32x4 v[4][4];
#pragma unroll
        for (int r = 0; r < 4; ++r) { const f32x4* src = (const f32x4*)(tab + (size_t)(e0 + r) * D) + F.lane;
#pragma unroll
            for (int j = 0; j < 4; ++j) v[r][j] = src[64 * j]; }
#pragma unroll
        for (int r = 0; r < 4; ++r) { float mx = 0.f;
#pragma unroll
            for (int j = 0; j < 4; ++j) mx = fmaxf(mx, fmaxf(fmaxf(fabsf(v[r][j].x), fabsf(v[r][j].y)), fmaxf(fabsf(v[r][j].z), fabsf(v[r][j].w))));
#pragma unroll
            for (int o = 1; o < 64; o <<= 1) mx = fmaxf(mx, __shfl_xor(mx, o));
            float ssq = 0.f;
#pragma unroll
            for (int j = 0; j < 4; ++j) ssq += (v[r][j].x * v[r][j].x + v[r][j].y * v[r][j].y) + (v[r][j].z * v[r][j].z + v[r][j].w * v[r][j].w);
            ssq = wave_sum(ssq);
            const float clip = fminf(mx, 2.7f * sqrtf(ssq * (1.f / D)));
            const float scale = mx > 0.f ? (isv ? mx * (1.f / 6.f) : clip * (1.f / 7.f)) : 1.f, inv = 1.f / scale;
            unsigned char* dst = a.ws + (isv ? WS_V : WS_U) + (size_t)(e0 + r) * 128 + 2 * F.lane;
#pragma unroll
            for (int j = 0; j < 4; ++j) { unsigned w;
                if (isv) { w = __builtin_amdgcn_cvt_scalef32_pk_fp4_f32(0u, v[r][j].x * inv, v[r][j].y * inv, 1.0f, 0); w = __builtin_amdgcn_cvt_scalef32_pk_fp4_f32(w, v[r][j].z * inv, v[r][j].w * inv, 1.0f, 1); }
                else { w = 0u;
#pragma unroll
                    for (int c = 0; c < 4; ++c) { const int qi = (int)fminf(fmaxf(rintf(v[r][j][c] * inv), -7.f), 7.f); w |= ((unsigned)qi & 15u) << (4 * c); } }
                *(unsigned short*)(dst + (size_t)j * (2 * MiB)) = (unsigned short)w; }
            if (F.lane == 0) ((float*)(a.ws + (isv ? WS_SV : WS_SU)))[e0 + r] = scale; }
    }
}
__device__ __forceinline__ void prep_rest(const Args& a, Frame& F) {
    LAS float* scr = (LAS float*)(F.lds + 65536 + F.wave * 8448);
    const int gw = F.bid * NWAVES + F.wave, NGW = F.G * NWAVES;
    constexpr int I_IN = (D / 64) * (NIN / 32), I_OUT = (D / 64) * (D / 32), I_Q = (D / 64) * (NQ / 32);
    for (int it = gw; it < I_IN + I_OUT + I_Q; it += NGW) {
        int r = it;
        if (r < I_IN) { transpose_item(a.w_in, D, NIN, (bf16*)(a.ws + WS_WIN), scr, r, F.lane); continue; } r -= I_IN;
        if (r < I_OUT) { transpose_item(a.w_out, D, D, (bf16*)(a.ws + WS_WOUT), scr, r, F.lane); continue; } r -= I_OUT;
        transpose_item(a.peer_wq, D, NQ, (bf16*)(a.ws + WS_WQ), scr, r, F.lane);
    }
    const size_t gtid = (size_t)F.bid * NTHREADS + F.tid, gn = (size_t)F.G * NTHREADS;
    cvt_rows(a.peer_keys, (bf16*)(a.ws + WS_KEYS), (size_t)2 * 8 * 128 * 128 / 8, gtid, gn);
    if (F.bid == 0) { for (int i = F.tid; i < 1024; i += NTHREADS) { const int h = i >> 7, dist = i & 127; int bk;
            if (dist < 16) bk = dist; else { bk = 16 + (int)(__logf((float)dist * (1.f / 16.f)) / 2.0794415416798357f * 16.f); bk = bk < 31 ? bk : 31; }
            ((float*)(a.ws + WS_BIAS))[i] = a.rel_bias[bk * 8 + h]; } }
}
template <bool ADD_DELTA>
__device__ __forceinline__ void modnorm_rows(const Args& a, Frame& F, const float* src, const float* g, int sh_off, int sc_off) {
    const int gw = F.bid * NWAVES + F.wave, NGW = F.G * NWAVES;
    const float* mod = (const float*)(a.ws + WS_MOD);
    bf16* H = (bf16*)(a.ws + WS_H);
    for (int m0 = 16 * gw; m0 < T; m0 += 16 * NGW) {
        const float* mb = mod + (size_t)(m0 / SEQ) * 6144;
        f32x4 gam[4], sh[4];
#pragma unroll
        for (int j = 0; j < 4; ++j) { const int col = 4 * F.lane + 256 * j; gam[j] = *(const f32x4*)(g + col) * (*(const f32x4*)(mb + sc_off + col) + 1.f); sh[j] = *(const f32x4*)(mb + sh_off + col); }
#pragma unroll 1
        for (int r0 = 0; r0 < 16; r0 += 4) {
            f32x4 v[4][4]; v2u dl[4][4];
#pragma unroll
            for (int r = 0; r < 4; ++r) { const f32x4* xr = (const f32x4*)(src + (size_t)(m0 + r0 + r) * D) + F.lane;
                const v2u* dr = (const v2u*)((const bf16*)(a.ws + WS_DELTA) + (size_t)(m0 + r0 + r) * D) + F.lane;
#pragma unroll
                for (int j = 0; j < 4; ++j) { v[r][j] = xr[64 * j]; if (ADD_DELTA) dl[r][j] = dr[64 * j]; } }
#pragma unroll
            for (int r = 0; r < 4; ++r) { float s = 0.f;
                if (ADD_DELTA) {
#pragma unroll
                    for (int j = 0; j < 4; ++j) { v[r][j].x += bf_lo(dl[r][j].x); v[r][j].y += bf_hi(dl[r][j].x); v[r][j].z += bf_lo(dl[r][j].y); v[r][j].w += bf_hi(dl[r][j].y); } }
#pragma unroll
                for (int j = 0; j < 4; ++j) s += (v[r][j].x * v[r][j].x + v[r][j].y * v[r][j].y) + (v[r][j].z * v[r][j].z + v[r][j].w * v[r][j].w);
                const float rstd = rsqrtf(wave_sum(s) * (1.f / D) + EPS);
                v2u* o8 = (v2u*)(H + (size_t)(m0 + r0 + r) * D) + F.lane;
                f32x4 y[4]; float am = 0.f;
#pragma unroll
                for (int j = 0; j < 4; ++j) { y[j] = v[r][j] * rstd * gam[j] + sh[j]; v2u w; w.x = pk2(y[j].x, y[j].y); w.y = pk2(y[j].z, y[j].w); o8[64 * j] = w;
                    am = fmaxf(am, fmaxf(fmaxf(fabsf(y[j].x), fabsf(y[j].y)), fmaxf(fabsf(y[j].z), fabsf(y[j].w)))); }
                if (ADD_DELTA) {
#pragma unroll
                    for (int o = 1; o < 64; o <<= 1) am = fmaxf(am, __shfl_xor(am, o));
                    const float st = am > 0.f ? am * (1.f / 7.f) : 1.f, ist = 1.f / st;
                    unsigned char* hp = a.ws + WS_H4 + (size_t)(m0 + r0 + r) * 1024 + 2 * F.lane;
#pragma unroll
                    for (int j = 0; j < 4; ++j) { unsigned w0 = 0u, w1 = 0u;
#pragma unroll
                        for (int c = 0; c < 4; ++c) { const float rr = y[j][c] * ist; const float d0 = fminf(fmaxf(rintf(rr), -7.f), 7.f); const float d1 = fminf(fmaxf(rintf((rr - d0) * 16.f), -8.f), 7.f);
                            w0 |= ((unsigned)(int)d0 & 15u) << (4 * c); w1 |= ((unsigned)(int)d1 & 15u) << (4 * c); }
                        *(unsigned short*)(hp + 128 * j) = (unsigned short)w0; *(unsigned short*)(hp + 512 + 128 * j) = (unsigned short)w1; }
                    if (F.lane == 0) ((float*)(a.ws + WS_ST))[m0 + r0 + r] = st; } }
        }
    }
}

constexpr int KS_STRIDE = 72, VT_STRIDE = 260;
constexpr int ATT_KS = 0, ATT_VT = 256 * KS_STRIDE * 2, ATT_BIAS = ATT_VT + 64 * VT_STRIDE * 2;
__device__ __forceinline__ void attn_unit(const Args& a, Frame& F, int unit, int pv = 0) {
    const int kvh = unit & 1, nb = (unit >> 1) & 31, b = unit >> 6;
    const bf16* PROJ = (const bf16*)(a.ws + WS_PROJ);
    bf16* MIX = (bf16*)(a.ws + WS_MIX);
    LAS bf16* Ks = (LAS bf16*)(F.lds + ATT_KS); LAS bf16* Vt = (LAS bf16*)(F.lds + ATT_VT); LAS float* bl = (LAS float*)(F.lds + ATT_BIAS);
    const int g = F.wave & 3, hq = kvh * 4 + g, hh = F.lane >> 5, l31 = F.lane & 31;
    v4u qraw[2][4];
#pragma unroll
    for (int qq = 0; qq < 2; ++qq) { const int qi = 32 * ((F.wave >> 2) * 2 + qq) + l31; const size_t tok = (size_t)b * SEQ + nb * 128 + qi;
#pragma unroll
        for (int ks = 0; ks < 4; ++ks) qraw[qq][ks] = *(const v4u*)(PROJ + tok * NIN + C_Q + hq * 64 + 16 * ks + 8 * hh); }
    if (pv != 2) {
        const int key = F.tid >> 1, half = F.tid & 1; const bool valid = (nb > 0) || (key >= 128);
        const size_t tok = (size_t)b * SEQ + nb * 128 - 128 + key;
        v4u kr[4], vr[4];
#pragma unroll
        for (int i = 0; i < 4; ++i) { kr[i] = (v4u){0u, 0u, 0u, 0u}; vr[i] = kr[i]; }
        if (valid) {
            const v4u* kp = (const v4u*)(PROJ + tok * NIN + C_K + kvh * 64 + 32 * half);
            const v4u* vp = (const v4u*)(PROJ + tok * NIN + C_V + kvh * 64 + 32 * half);
#pragma unroll
            for (int i = 0; i < 4; ++i) { kr[i] = kp[i]; vr[i] = vp[i]; }
        }
        float ss = 0.f;
#pragma unroll
        for (int i = 0; i < 4; ++i) {
#pragma unroll
            for (int e = 0; e < 4; ++e) { const float lo = bf_lo(kr[i][e]), hi = bf_hi(kr[i][e]); ss += lo * lo + hi * hi; } }
        ss += __shfl_xor(ss, 1);
        const float rstd = rsqrtf(ss * (1.f / 64.f) + EPS);
#pragma unroll
        for (int i = 0; i < 4; ++i) { v4u o;
#pragma unroll
            for (int e = 0; e < 4; ++e) { const int d = 32 * half + 8 * i + 2 * e;
                o[e] = pk2(bf_lo(kr[i][e]) * rstd * a.k_norm_g[d], bf_hi(kr[i][e]) * rstd * a.k_norm_g[d + 1]); }
            *(LAS v4u*)(Ks + key * KS_STRIDE + 32 * half + 8 * i) = o; }
#pragma unroll
        for (int i = 0; i < 4; ++i)
#pragma unroll
            for (int e = 0; e < 4; ++e) { const int d = 32 * half + 8 * i + 2 * e;
                Vt[d * VT_STRIDE + key] = (bf16)(vr[i][e] & 0xffffu); Vt[(d + 1) * VT_STRIDE + key] = (bf16)(vr[i][e] >> 16); }
        { const int g = F.tid >> 7, dist = F.tid & 127; bl[F.tid] = ((const float*)(a.ws + WS_BIAS))[(kvh * 4 + g) * 128 + dist]; }
        if (F.tid < 64) bl[512 + F.tid] = a.q_norm_g[F.tid]; else if (F.tid < 128) bl[512 + F.tid] = a.k_norm_g[F.tid - 64]; else if (F.tid < 384) bl[512 + F.tid] = a.attn_out_g[kvh * 256 + (F.tid - 128)];
    }
    __syncthreads();
    const float sink = a.sinks[hq];
#pragma unroll 1
    for (int qq = 0; qq < (pv == 1 ? 0 : 2); ++qq) {
        const int qt = (F.wave >> 2) * 2 + qq, qi = 32 * qt + l31;
        const size_t tok = (size_t)b * SEQ + nb * 128 + qi;
        bf16x8 qf[4];
        {
            v4u qr[4]; float ss = 0.f;
#pragma unroll
            for (int ks = 0; ks < 4; ++ks) { qr[ks] = qq ? qraw[1][ks] : qraw[0][ks];
#pragma unroll
                for (int e = 0; e < 4; ++e) { const float lo = bf_lo(qr[ks][e]), hi = bf_hi(qr[ks][e]); ss += lo * lo + hi * hi; } }
            ss += __shfl_xor(ss, 32);
            const float rstd = rsqrtf(ss * (1.f / 64.f) + EPS) * 0.125f;
#pragma unroll
            for (int ks = 0; ks < 4; ++ks) { v4u o;
#pragma unroll
                for (int e = 0; e < 4; ++e) { const int d = 16 * ks + 8 * hh + 2 * e;
                    o[e] = pk2(bf_lo(qr[ks][e]) * rstd * bl[512 + d], bf_hi(qr[ks][e]) * rstd * bl[512 + d + 1]); }
                qf[ks] = __builtin_bit_cast(bf16x8, o); }
        }
        f32x16 s[5];
#pragma unroll
        for (int k5 = 0; k5 < 5; ++k5) { const int kt = qt + k5;
            f32x16 acc;
#pragma unroll
            for (int r = 0; r < 16; ++r) acc[r] = 0.f;
#pragma unroll
            for (int ks = 0; ks < 4; ++ks) { const bf16x8 kf = *(const LAS bf16x8*)(Ks + (32 * kt + l31) * KS_STRIDE + 16 * ks + 8 * hh);
                acc = __builtin_amdgcn_mfma_f32_32x32x16_bf16(kf, qf[ks], acc, 0, 0, 0); }
            s[k5] = acc; }
        float mx = -INFINITY;
#pragma unroll
        for (int k5 = 0; k5 < 5; ++k5) { const float pen_tile = (nb == 0 && (qt + k5) < 4) ? -INFINITY : 0.f;
#pragma unroll
            for (int r = 0; r < 16; ++r) { const int kj = 32 * (qt + k5) + (r & 3) + 8 * (r >> 2) + 4 * hh; const int dist = qi + 128 - kj;
                float v = s[k5][r] + bl[g * 128 + (dist & 127)] + pen_tile;
                if (k5 == 0) v += (dist > 127) ? -INFINITY : 0.f;
                if (k5 == 4) v += (dist < 0) ? -INFINITY : 0.f;
                s[k5][r] = v; mx = fmaxf(mx, v); } }
        mx = fmaxf(mx, __shfl_xor(mx, 32)); mx = fmaxf(mx, sink);
        float ls = 0.f;
#pragma unroll
        for (int k5 = 0; k5 < 5; ++k5)
#pragma unroll
            for (int r = 0; r < 16; ++r) { const float p = __expf(s[k5][r] - mx); s[k5][r] = p; ls += p; }
        ls += __shfl_xor(ls, 32);
        const float inv = 1.f / (ls + __expf(sink - mx));
        f32x16 o[2];
#pragma unroll
        for (int dt = 0; dt < 2; ++dt)
#pragma unroll
            for (int r = 0; r < 16; ++r) o[dt][r] = 0.f;
#pragma unroll
        for (int k5 = 0; k5 < 5; ++k5)
#pragma unroll
            for (int s2 = 0; s2 < 2; ++s2) { const int kt = qt + k5;
                v4u pw; pw.x = pk2(s[k5][8 * s2 + 0], s[k5][8 * s2 + 1]); pw.y = pk2(s[k5][8 * s2 + 2], s[k5][8 * s2 + 3]); pw.z = pk2(s[k5][8 * s2 + 4], s[k5][8 * s2 + 5]); pw.w = pk2(s[k5][8 * s2 + 6], s[k5][8 * s2 + 7]);
                const bf16x8 pf = __builtin_bit_cast(bf16x8, pw);
#pragma unroll
                for (int dt = 0; dt < 2; ++dt) { const LAS bf16* vp = Vt + (32 * dt + l31) * VT_STRIDE + 32 * kt + 16 * s2 + 4 * hh;
                    const v2u v0 = *(const LAS v2u*)vp, v1 = *(const LAS v2u*)(vp + 8);
                    v4u vw; vw.x = v0.x; vw.y = v0.y; vw.z = v1.x; vw.w = v1.y;
                    o[dt] = __builtin_amdgcn_mfma_f32_32x32x16_bf16(__builtin_bit_cast(bf16x8, vw), pf, o[dt], 0, 0, 0); } }
        float ss = 0.f;
#pragma unroll
        for (int dt = 0; dt < 2; ++dt)
#pragma unroll
            for (int r = 0; r < 16; ++r) { o[dt][r] *= inv; ss += o[dt][r] * o[dt][r]; }
        ss += __shfl_xor(ss, 32);
        const float rstd = rsqrtf(ss * (1.f / 64.f) + EPS);
#pragma unroll
        for (int dt = 0; dt < 2; ++dt)
#pragma unroll
            for (int rq = 0; rq < 4; ++rq) { const int d = 32 * dt + 8 * rq + 4 * hh; const f32x4 gg = *(const LAS f32x4*)(bl + 640 + g * 64 + d);
                v2u w; w.x = pk2(o[dt][4 * rq + 0] * rstd * gg.x, o[dt][4 * rq + 1] * rstd * gg.y); w.y = pk2(o[dt][4 * rq + 2] * rstd * gg.z, o[dt][4 * rq + 3] * rstd * gg.w);
                *(v2u*)(MIX + tok * D + 512 + hq * 64 + d) = w; }
    }
    __syncthreads();
}
__device__ __forceinline__ void unpack8(const v4u r, float (&f)[8]) {
#pragma unroll
    for (int e = 0; e < 4; ++e) { f[2 * e] = bf_lo(r[e]); f[2 * e + 1] = bf_hi(r[e]); }
}
__device__ __forceinline__ void conv_unit(const Args& a, Frame& F, int unit) {
    const int nb = unit & 31, b = unit >> 5;
    const bf16* PROJ = (const bf16*)(a.ws + WS_PROJ);
    bf16* MIX = (bf16*)(a.ws + WS_MIX);
    const int ch = 8 * F.lane, pos0 = nb * 128 + 16 * F.wave;
    const size_t tok0 = (size_t)b * SEQ + pos0;
    float w0[8], w1[8], w2[8], gg[8], um2[8], um1[8];
#pragma unroll
    for (int e = 0; e < 8; ++e) { w0[e] = a.conv_w[ch + e]; w1[e] = a.conv_w[512 + ch + e]; w2[e] = a.conv_w[1024 + ch + e]; gg[e] = a.conv_out_g[ch + e]; um2[e] = 0.f; um1[e] = 0.f; }
    if (pos0 >= 2) {
        float c[8], h[8];
        unpack8(*(const v4u*)(PROJ + (tok0 - 2) * NIN + C_C + ch), c); unpack8(*(const v4u*)(PROJ + (tok0 - 2) * NIN + C_H + ch), h);
#pragma unroll
        for (int e = 0; e < 8; ++e) um2[e] = c[e] * h[e];
        unpack8(*(const v4u*)(PROJ + (tok0 - 1) * NIN + C_C + ch), c); unpack8(*(const v4u*)(PROJ + (tok0 - 1) * NIN + C_H + ch), h);
#pragma unroll
        for (int e = 0; e < 8; ++e) um1[e] = c[e] * h[e];
    }
#pragma unroll 1
    for (int i0 = 0; i0 < 16; i0 += 4) {
        v4u rb[4], rc[4], rh[4];
#pragma unroll
        for (int i = 0; i < 4; ++i) { const size_t tok = tok0 + i0 + i; rb[i] = *(const v4u*)(PROJ + tok * NIN + C_B + ch); rc[i] = *(const v4u*)(PROJ + tok * NIN + C_C + ch); rh[i] = *(const v4u*)(PROJ + tok * NIN + C_H + ch); }
#pragma unroll
        for (int i = 0; i < 4; ++i) { const size_t tok = tok0 + i0 + i;
            float bg[8], c[8], h[8], y[8]; float ss = 0.f;
            unpack8(rb[i], bg); unpack8(rc[i], c); unpack8(rh[i], h);
#pragma unroll
            for (int e = 0; e < 8; ++e) { const float u0 = c[e] * h[e]; y[e] = bg[e] * (w0[e] * um2[e] + w1[e] * um1[e] + w2[e] * u0); ss += y[e] * y[e]; um2[e] = um1[e]; um1[e] = u0; }
            ss += __shfl_xor(ss, 1); ss += __shfl_xor(ss, 2); ss += __shfl_xor(ss, 4);
            const float rstd = rsqrtf(ss * (1.f / 64.f) + EPS);
            v4u o;
#pragma unroll
            for (int e = 0; e < 4; ++e) o[e] = pk2(y[2 * e] * rstd * gg[2 * e], y[2 * e + 1] * rstd * gg[2 * e + 1]);
            *(v4u*)(MIX + tok * D + ch) = o; }
    }
}

#define CE_DESC(x, y) do { const unsigned _hi = (x) > (y) ? (x) : (y), _lo = (x) > (y) ? (y) : (x); (x) = _hi; (y) = _lo; } while (0)
__device__ __forceinline__ void sort16_desc(unsigned (&v)[16]) {
#define S16(i, j) CE_DESC(v[i], v[j]);
    S16(0, 1) S16(2, 3) S16(0, 2) S16(1, 3) S16(1, 2) S16(4, 5) S16(6, 7) S16(4, 6) S16(5, 7) S16(5, 6) S16(0, 4) S16(2, 6) S16(2, 4) S16(1, 5) S16(3, 7) S16(3, 5) S16(1, 2) S16(3, 4) S16(5, 6)
    S16(8, 9) S16(10, 11) S16(8, 10) S16(9, 11) S16(9, 10) S16(12, 13) S16(14, 15) S16(12, 14) S16(13, 15) S16(13, 14) S16(8, 12) S16(10, 14) S16(10, 12) S16(9, 13) S16(11, 15) S16(11, 13) S16(9, 10) S16(11, 12) S16(13, 14)
    S16(0, 8) S16(4, 12) S16(4, 8) S16(2, 10) S16(6, 14) S16(6, 10) S16(2, 4) S16(6, 8) S16(10, 12) S16(1, 9) S16(5, 13) S16(5, 9) S16(3, 11) S16(7, 15) S16(7, 11) S16(3, 5) S16(7, 9) S16(11, 13)
    S16(1, 2) S16(3, 4) S16(5, 6) S16(7, 8) S16(9, 10) S16(11, 12) S16(13, 14)
#undef S16
}
__device__ __forceinline__ void merge16_desc(unsigned (&x)[16], const unsigned (&y)[16]) {
#pragma unroll
    for (int i = 0; i < 16; ++i) x[i] = x[i] > y[15 - i] ? x[i] : y[15 - i];
#pragma unroll
    for (int j = 8; j > 0; j >>= 1)
#pragma unroll
        for (int i = 0; i < 16; ++i) if ((i & j) == 0) CE_DESC(x[i], x[i | j]);
}
constexpr int KEY_LDS_STRIDE = 136;
__device__ __forceinline__ void side_top16(const bf16* QP, const LAS bf16* KL, int tok0, int h, int s, int lane, unsigned (&top)[16]) {
    const int l31 = lane & 31, hh = lane >> 5;
    bf16x8 qf[8];
    const bf16* qp = QP + (size_t)(tok0 + l31) * NQ + h * 256 + s * 128 + 8 * hh;
#pragma unroll
    for (int ks = 0; ks < 8; ++ks) qf[ks] = *(const bf16x8*)(qp + 16 * ks);
    const LAS bf16* kp = KL + (s * 128 + l31) * KEY_LDS_STRIDE + 8 * hh;
#define SIDE_TILE(kt, dst) do { f32x16 acc; \
        _Pragma("unroll") for (int r = 0; r < 16; ++r) acc[r] = 0.f; \
        _Pragma("unroll") for (int ks = 0; ks < 8; ++ks) { const bf16x8 kf = *(const LAS bf16x8*)(kp + (32 * (kt)) * KEY_LDS_STRIDE + 16 * ks); \
            acc = __builtin_amdgcn_mfma_f32_32x32x16_bf16(kf, qf[ks], acc, 0, 0, 0); } \
        _Pragma("unroll") for (int r = 0; r < 16; ++r) { const int nn = 32 * (kt) + (r & 3) + 8 * (r >> 2) + 4 * hh; \
            int fx = (int)__builtin_fmaf(acc[r], 524288.f, 16777216.f); fx = fx < 0 ? 0 : (fx > (1 << 25) - 1 ? (1 << 25) - 1 : fx); \
            dst[r] = ((unsigned)fx << 7) | (unsigned)(127 - nn); } \
        sort16_desc(dst); } while (0)
    SIDE_TILE(0, top);
#pragma unroll 1
    for (int kt = 1; kt < 4; ++kt) { unsigned v[16]; SIDE_TILE(kt, v); merge16_desc(top, v); }
#undef SIDE_TILE
    unsigned oth[16];
#pragma unroll
    for (int i = 0; i < 16; ++i) oth[i] = (unsigned)__shfl_xor((int)top[i], 32);
    merge16_desc(top, oth);
}
__device__ __forceinline__ void topk_unit(const Args& a, Frame& F, int tile, int h) {
    const int tok0 = tile * 32;
    const bf16* QP = (const bf16*)(a.ws + WS_PROJ); const LAS bf16* KL = (const LAS bf16*)F.lds;
    unsigned ka[16], kb[16];
    side_top16(QP, KL, tok0, h, 0, F.lane, ka);
    side_top16(QP, KL, tok0, h, 1, F.lane, kb);
    unsigned c[4][16];
    int n = 0;
#pragma unroll
    for (int i = 0; i < 16; ++i)
#pragma unroll
        for (int j = 0; j < 16; ++j) if ((i + 1) * (j + 1) <= 16) {
            int sfx = (int)(ka[i] >> 7) + (int)(kb[j] >> 7) - (1 << 25);
            sfx = sfx < 0 ? 0 : (sfx > (1 << 23) - 1 ? (1 << 23) - 1 : sfx);
            const unsigned e = (127u - (ka[i] & 127u)) * 128u + (127u - (kb[j] & 127u));
            c[n >> 4][n & 15] = ((unsigned)(sfx >> 5) << 14) | (16383u - e); ++n; }
#pragma unroll
    for (; n < 64; ++n) c[n >> 4][n & 15] = 0u;
    sort16_desc(c[0]); sort16_desc(c[1]); sort16_desc(c[2]); CE_DESC(c[3][0], c[3][1]);
    merge16_desc(c[0], c[1]); merge16_desc(c[2], c[3]); merge16_desc(c[0], c[2]);
    float w[16]; float sum = 0.f; const float f0 = (float)(c[0][0] >> 14);
#pragma unroll
    for (int k = 0; k < 16; ++k) { w[k] = __expf(((float)(c[0][k] >> 14) - f0) * (1.f / 16384.f)); sum += w[k]; }
    const float inv = 1.f / sum;
    const int tok = tok0 + (F.lane & 31), hh = F.lane >> 5;
    int* ei = (int*)(a.ws + WS_EIDX) + (size_t)tok * 128 + h * 16 + 8 * hh;
    float* gt = (float*)(a.ws + WS_GATE) + (size_t)tok * 128 + h * 16 + 8 * hh;
    v4u e0, e1; f32x4 g0, g1;
#pragma unroll
    for (int k = 0; k < 4; ++k) { const unsigned x0 = hh ? c[0][8 + k] : c[0][k], x1 = hh ? c[0][12 + k] : c[0][4 + k];
        e0[k] = 16383u - (x0 & 16383u); e1[k] = 16383u - (x1 & 16383u);
        g0[k] = (hh ? w[8 + k] : w[k]) * inv; g1[k] = (hh ? w[12 + k] : w[4 + k]) * inv; }
    *(v4u*)ei = e0; *(v4u*)(ei + 4) = e1; *(f32x4*)gt = g0; *(f32x4*)(gt + 4) = g1;
}

__device__ __forceinline__ float gelu_tanh(float x) {
    const float u = 0.7978845608028654f * (x + 0.044715f * x * x * x);
    const float t = 1.f - 2.f / (1.f + __expf(2.f * u));
    return 0.5f * x * (1.f + t);
}
__device__ __forceinline__ void peer_coef(const Args& a, Frame& F) {
    const int gw = F.bid * NWAVES + F.wave, NGW = F.G * NWAVES, lane = F.lane;
    const float* SU = (const float*)(a.ws + WS_SU); const float* SV = (const float*)(a.ws + WS_SV);
    for (int t0 = 4 * gw; t0 < T; t0 += 4 * NGW) {
        float s0[4], s1[4], st[4]; int2 e[4]; float2 g[4]; float su0[4], su1[4], sv0[4], sv1[4];
#pragma unroll
        for (int k = 0; k < 4; ++k) { const int tok = t0 + k;
            const float* pp = (const float*)(a.ws + WS_PART) + (size_t)tok * 512 + 2 * lane;
            float2 p0 = *(const float2*)pp, p1 = *(const float2*)(pp + 128), p2 = *(const float2*)(pp + 256), p3 = *(const float2*)(pp + 384);
            s0[k] = (p0.x + p1.x) + (p2.x + p3.x); s1[k] = (p0.y + p1.y) + (p2.y + p3.y);
            e[k] = *(const int2*)((const int*)(a.ws + WS_EIDX) + (size_t)tok * 128 + 2 * lane);
            g[k] = *(const float2*)((const float*)(a.ws + WS_GATE) + (size_t)tok * 128 + 2 * lane);
            st[k] = ((const float*)(a.ws + WS_ST))[tok]; }
#pragma unroll
        for (int k = 0; k < 4; ++k) { su0[k] = SU[e[k].x]; su1[k] = SU[e[k].y]; sv0[k] = SV[e[k].x]; sv1[k] = SV[e[k].y]; }
#pragma unroll
        for (int k = 0; k < 4; ++k) { const int tok = t0 + k;
            const float r0 = g[k].x * gelu_tanh(s0[k] * (su0[k] * st[k])) * sv0[k], r1 = g[k].y * gelu_tanh(s1[k] * (su1[k] * st[k])) * sv1[k];
            if (!V_MFMA) {
                uint2 w; w.x = ((__float_as_uint(r0) + 0x2000u) & 0xffffc000u) | (unsigned)e[k].x; w.y = ((__float_as_uint(r1) + 0x2000u) & 0xffffc000u) | (unsigned)e[k].y;
                *(uint2*)((unsigned*)(a.ws + WS_PACK) + (size_t)tok * 128 + 2 * lane) = w; }
            if (V_MFMA) {
                float am = fmaxf(fabsf(r0), fabsf(r1));
#pragma unroll
                for (int o = 1; o < 64; o <<= 1) am = fmaxf(am, __shfl_xor(am, o));
                const float cs = am > 0.f ? am * (1.f / 4.5f) : 1.f, ics = 1.f / cs;
                float ra = r0 * ics, rb = r1 * ics;
                unsigned char* cp = a.ws + WS_CP + (size_t)tok * 256 + lane;
#pragma unroll
                for (int pl = 0; pl < 4; ++pl) { const float da = fminf(fmaxf(rintf(ra), -4.f), 4.f), db = fminf(fmaxf(rintf(rb), -4.f), 4.f);
                    cp[64 * pl] = (unsigned char)__builtin_amdgcn_cvt_scalef32_pk_fp4_f32(0u, da, db, 1.0f, 0);
                    ra = (ra - da) * 8.f; rb = (rb - db) * 8.f; }
                if (lane == 0) ((float*)(a.ws + WS_CS))[tok] = cs; }
        }
    }
}
typedef float f32x2 __attribute__((ext_vector_type(2)));
__device__ __forceinline__ float dpp_sum8(float s) {
    s += __builtin_bit_cast(float, __builtin_amdgcn_update_dpp(0, __builtin_bit_cast(int, s), 0xB1, 0xF, 0xF, true));
    s += __builtin_bit_cast(float, __builtin_amdgcn_update_dpp(0, __builtin_bit_cast(int, s), 0x4E, 0xF, 0xF, true));
    s += __builtin_bit_cast(float, __builtin_amdgcn_update_dpp(0, __builtin_bit_cast(int, s), 0x141, 0xF, 0xF, true));
    return s;
}
struct PTok { v4u vr[16]; v4u aux[4]; f32x4 xo, xg; };
template <bool VSIDE>
__device__ __forceinline__ void peer_issue(const unsigned char* TB, unsigned poff, const v4u (&w)[4], PTok& P, const unsigned char* sidep, const float* xop, const float* xgp) {
#pragma unroll
    for (int i = 0; i < 16; ++i) { const unsigned id = w[i >> 2][i & 3] & 0x3fffu; P.vr[i] = *(const v4u*)(TB + (id * 128u + poff)); }
    if (VSIDE) { P.xo = *(const f32x4*)xop; P.xg = *(const f32x4*)xgp; P.aux[0].x = ((const unsigned*)sidep)[0]; P.aux[0].y = ((const unsigned*)sidep)[1]; }
    else { P.aux[0] = *(const v4u*)sidep; P.aux[1] = *(const v4u*)(sidep + 512); }
}
template <bool VSIDE>
__device__ __forceinline__ void peer_compute(const PTok& P, const v4u (&w)[4], int lane, float* outp) {
    const int p = lane & 7;
    if (VSIDE) {
        f32x2 acc2[16];
#pragma unroll
        for (int j = 0; j < 16; ++j) acc2[j] = (f32x2){0.f, 0.f};
#pragma unroll
        for (int i = 0; i < 16; ++i) {
            const v2u cpair = (i & 2) ? (v2u){w[i >> 2].z, w[i >> 2].w} : (v2u){w[i >> 2].x, w[i >> 2].y};
#pragma unroll
            for (int q = 0; q < 4; ++q) { const unsigned wd = P.vr[i][q];
                const f32x2 f0 = __builtin_amdgcn_cvt_scalef32_pk_f32_fp4(wd, 1.0f, 0), f1 = __builtin_amdgcn_cvt_scalef32_pk_f32_fp4(wd, 1.0f, 1), f2 = __builtin_amdgcn_cvt_scalef32_pk_f32_fp4(wd, 1.0f, 2), f3 = __builtin_amdgcn_cvt_scalef32_pk_f32_fp4(wd, 1.0f, 3);
                if (i & 1) {
                    asm volatile("v_pk_fma_f32 %0, %1, %2, %0 op_sel:[0,1,0] op_sel_hi:[1,1,1]" : "+v"(acc2[4 * q]) : "v"(f0), "v"(cpair));
                    asm volatile("v_pk_fma_f32 %0, %1, %2, %0 op_sel:[0,1,0] op_sel_hi:[1,1,1]" : "+v"(acc2[4 * q + 1]) : "v"(f1), "v"(cpair));
                    asm volatile("v_pk_fma_f32 %0, %1, %2, %0 op_sel:[0,1,0] op_sel_hi:[1,1,1]" : "+v"(acc2[4 * q + 2]) : "v"(f2), "v"(cpair));
                    asm volatile("v_pk_fma_f32 %0, %1, %2, %0 op_sel:[0,1,0] op_sel_hi:[1,1,1]" : "+v"(acc2[4 * q + 3]) : "v"(f3), "v"(cpair));
                } else {
                    asm volatile("v_pk_fma_f32 %0, %1, %2, %0 op_sel_hi:[1,0,1]" : "+v"(acc2[4 * q]) : "v"(f0), "v"(cpair));
                    asm volatile("v_pk_fma_f32 %0, %1, %2, %0 op_sel_hi:[1,0,1]" : "+v"(acc2[4 * q + 1]) : "v"(f1), "v"(cpair));
                    asm volatile("v_pk_fma_f32 %0, %1, %2, %0 op_sel_hi:[1,0,1]" : "+v"(acc2[4 * q + 2]) : "v"(f2), "v"(cpair));
                    asm volatile("v_pk_fma_f32 %0, %1, %2, %0 op_sel_hi:[1,0,1]" : "+v"(acc2[4 * q + 3]) : "v"(f3), "v"(cpair));
                } } }
        float acc[32];
#pragma unroll
        for (int j = 0; j < 16; ++j) { acc[2 * j] = acc2[j].x; acc[2 * j + 1] = acc2[j].y; }
        const int b5 = (lane >> 5) & 1, b4 = (lane >> 4) & 1, b3 = (lane >> 3) & 1;
        float v1[16], v2[8], v3[4];
#pragma unroll
        for (int j = 0; j < 16; ++j) { const v2u r = __builtin_amdgcn_permlane32_swap(__float_as_uint(acc[j]), __float_as_uint(acc[16 + j]), false, false);
            v1[j] = __uint_as_float(r.x) + __uint_as_float(r.y); }
#pragma unroll
        for (int j = 0; j < 8; ++j) { const v2u r = __builtin_amdgcn_permlane16_swap(__float_as_uint(v1[j]), __float_as_uint(v1[8 + j]), false, false);
            v2[j] = __uint_as_float(r.x) + __uint_as_float(r.y); }
#pragma unroll
        for (int j = 0; j < 4; ++j) { const float kp = b3 ? v2[4 + j] : v2[j], sd = b3 ? v2[j] : v2[4 + j];
            v3[j] = kp + __builtin_bit_cast(float, __builtin_amdgcn_update_dpp(0, __builtin_bit_cast(int, sd), 0x128, 0xF, 0xF, true)); }
        f32x4 o; o.x = (P.xo.x + bf_lo(P.aux[0].x)) + P.xg.x * v3[0]; o.y = (P.xo.y + bf_hi(P.aux[0].x)) + P.xg.y * v3[1]; o.z = (P.xo.z + bf_lo(P.aux[0].y)) + P.xg.z * v3[2]; o.w = (P.xo.w + bf_hi(P.aux[0].y)) + P.xg.w * v3[3]; *(f32x4*)outp = o;
    } else {
        f32x2 keep = {0.f, 0.f};
#pragma unroll
        for (int i = 0; i < 16; ++i) { int s0 = 0, s1 = 0;
#pragma unroll
            for (int q = 0; q < 4; ++q) { s0 = __builtin_amdgcn_sdot8((int)P.vr[i][q], (int)P.aux[0][q], s0, false); s1 = __builtin_amdgcn_sdot8((int)P.vr[i][q], (int)P.aux[1][q], s1, false); }
            const float dt = dpp_sum8((float)s0 + (float)s1 * 0.0625f);
            if ((i >> 1) == p) { if (i & 1) keep.y = dt; else keep.x = dt; } }
        *(f32x2*)outp = keep;
    }
}
template <bool VSIDE>
__device__ __forceinline__ void peer_slice(const Args& a, Frame& F) {
    const int x = F.sl_x, wx = F.sl_rank * NWAVES + F.wave, nwx = F.sl_n * NWAVES;
    if (wx >= T) return;
    const int lane = F.lane, eg = lane >> 3, p = lane & 7;
    const unsigned char* TB = a.ws + (VSIDE ? WS_V : WS_U) + (size_t)x * (2 * MiB); const unsigned poff = 16u * (unsigned)p;
    const unsigned* Wb = (const unsigned*)(a.ws + (VSIDE ? WS_PACK : WS_EIDX)) + 16 * eg;
    const unsigned char* Hb = a.ws + WS_H4 + 128 * x + 16 * p;
    const int dcol = 256 * x + 32 * p + 16 * ((lane >> 5) & 1) + 8 * ((lane >> 4) & 1) + 4 * ((lane >> 3) & 1);
    const float* G2 = (const float*)(a.ws + WS_MOD) + 5120 + dcol;
    float* PART = (float*)(a.ws + WS_PART) + (size_t)x * 128 + 16 * eg + 2 * p;
    const float* X1 = a.x;
    const unsigned char* DLb = a.ws + WS_DELTA + 2 * dcol;
    v4u nA[4], nB[4];
    int tA = wx, tB = wx + nwx;
#define PS_LDW(dst, tok) do { const unsigned* _w = Wb + (size_t)((tok) < T ? (tok) : T - 1) * 128; _Pragma("unroll") for (int _q = 0; _q < 4; ++_q) dst[_q] = *(const v4u*)(_w + 4 * _q); } while (0)
    PS_LDW(nA, tA); PS_LDW(nB, tB);
#pragma unroll 1
    for (; tA < T; tA += 2 * nwx, tB += 2 * nwx) {
        const int tBc = tB < T ? tB : tA;
        v4u wA[4], wB[4];
#pragma unroll
        for (int q = 0; q < 4; ++q) { wA[q] = nA[q]; wB[q] = nB[q]; }
        PTok A, B;
        peer_issue<VSIDE>(TB, poff, wA, A, VSIDE ? DLb + (size_t)tA * 2048 : Hb + (size_t)tA * 1024, X1 + (size_t)tA * D + dcol, G2 + (size_t)(tA / SEQ) * 6144);
        peer_issue<VSIDE>(TB, poff, wB, B, VSIDE ? DLb + (size_t)tBc * 2048 : Hb + (size_t)tBc * 1024, X1 + (size_t)tBc * D + dcol, G2 + (size_t)(tBc / SEQ) * 6144);
        if (!VSIDE) { PS_LDW(nA, tA + 2 * nwx); PS_LDW(nB, tB + 2 * nwx); }
        peer_compute<VSIDE>(A, wA, lane, VSIDE ? a.out + (size_t)tA * D + dcol : PART + (size_t)tA * 512);
        if (VSIDE) { PS_LDW(nA, tA + 2 * nwx); PS_LDW(nB, tB + 2 * nwx); }
        if (tB < T) peer_compute<VSIDE>(B, wB, lane, VSIDE ? a.out + (size_t)tB * D + dcol : PART + (size_t)tB * 512);
    }
#undef PS_LDW
}

struct VTok { v4u vr[16]; };
struct VStr { v4u aw; f32x4 xo, xg; v2u dl; float cs; };
__device__ __forceinline__ void vmfma_issue(const unsigned char* TB, unsigned poff, const v4u (&w)[4], VTok& P) {
#pragma unroll
    for (int i = 0; i < 16; ++i) { const unsigned id = w[i >> 2][i & 3]; P.vr[i] = *(const v4u*)(TB + (id * 128u + poff)); }
}
__device__ __forceinline__ void vmfma_stream(VStr& S, const unsigned char* cpp, const float* csp, const float* xop, const float* xgp, const unsigned char* dlp) {
    S.aw = *(const v4u*)cpp; S.cs = *csp; S.xo = __builtin_nontemporal_load((const f32x4*)xop); S.xg = *(const f32x4*)xgp; S.dl = __builtin_nontemporal_load((const v2u*)dlp);
}
__device__ __forceinline__ void vmfma_compute(const VTok& P, const VStr& S, int lane, LAS unsigned char* img, float* outp, int pv = 0) {
    const int eg = lane >> 3, p = lane & 7, n = lane & 15, q = lane >> 4;
    if (pv == 1) { unsigned acc = 0;
#pragma unroll
        for (int i = 0; i < 16; ++i) acc ^= P.vr[i].x ^ P.vr[i].w;
        f32x4 o; o.x = S.xo.x + bf_lo(S.dl.x) + S.xg.x * S.cs; o.y = S.xo.y + (acc == 0x12345u ? 1.f : 0.f); o.z = S.xo.z + __uint_as_float(S.aw.x & 1u); o.w = S.xo.w; *(f32x4*)outp = o; return; }
    asm volatile("s_waitcnt lgkmcnt(0)" ::: "memory");
#pragma unroll
    for (int i = 0; i < 16; ++i) *(LAS v4u*)(img + (16 * eg + i) * 128 + 16 * (p ^ (i & 7))) = P.vr[i];
    asm volatile("s_waitcnt lgkmcnt(0)" ::: "memory");
    const unsigned rowb = (unsigned)(size_t)img + (unsigned)(32 * q + n) * 128u;
    v8i A; A[0] = (int)S.aw.x; A[1] = (int)S.aw.y; A[2] = (int)S.aw.z; A[3] = (int)S.aw.w; A[4] = 0; A[5] = 0; A[6] = 0; A[7] = 0;
    LAS float* scr = (LAS float*)(img + 16384);
#pragma unroll
    for (int hb = 0; hb < 2; ++hb) {
        v2u tr[8][2];
#pragma unroll
        for (int t2 = 0; t2 < 4; ++t2) { const unsigned a0 = rowb + 16u * (unsigned)((4 * hb + t2) ^ (n & 7));
            asm volatile("ds_read_b64_tr_b4 %0, %1" : "=v"(tr[2 * t2][0]) : "v"(a0) : "memory");
            asm volatile("ds_read_b64_tr_b4 %0, %1 offset:2048" : "=v"(tr[2 * t2][1]) : "v"(a0) : "memory");
            asm volatile("ds_read_b64_tr_b4 %0, %1 offset:8" : "=v"(tr[2 * t2 + 1][0]) : "v"(a0) : "memory");
            asm volatile("ds_read_b64_tr_b4 %0, %1 offset:2056" : "=v"(tr[2 * t2 + 1][1]) : "v"(a0) : "memory"); }
        asm volatile("s_waitcnt lgkmcnt(0)" : "+v"(tr[0][0]), "+v"(tr[0][1]), "+v"(tr[1][0]), "+v"(tr[1][1]), "+v"(tr[2][0]), "+v"(tr[2][1]), "+v"(tr[3][0]), "+v"(tr[3][1]), "+v"(tr[4][0]), "+v"(tr[4][1]), "+v"(tr[5][0]), "+v"(tr[5][1]), "+v"(tr[6][0]), "+v"(tr[6][1]), "+v"(tr[7][0]), "+v"(tr[7][1]) :: "memory");
        __builtin_amdgcn_sched_barrier(0);
#pragma unroll
        for (int t = 0; t < 8; ++t) { const int nt = 8 * hb + t; v8i B; B[0] = (int)tr[t][0].x; B[1] = (int)tr[t][0].y; B[2] = (int)tr[t][1].x; B[3] = (int)tr[t][1].y; B[4] = 0; B[5] = 0; B[6] = 0; B[7] = 0;
            f32x4 c = {0.f, 0.f, 0.f, 0.f};
            c = __builtin_amdgcn_mfma_scale_f32_16x16x128_f8f6f4(A, B, c, 4  , 4  , 0, 0, 0, 0);
            const float val = c[0] + c[1] * 0.125f + c[2] * 0.015625f + c[3] * 0.001953125f;
            if (q == 0) scr[16 * nt + n] = val; }
    }
    asm volatile("s_waitcnt lgkmcnt(0)" ::: "memory");
    const f32x4 v = *(const LAS f32x4*)(scr + 4 * lane);
    const float k = S.cs;
    f32x4 o; o.x = (S.xo.x + bf_lo(S.dl.x)) + S.xg.x * (k * v.x); o.y = (S.xo.y + bf_hi(S.dl.x)) + S.xg.y * (k * v.y); o.z = (S.xo.z + bf_lo(S.dl.y)) + S.xg.z * (k * v.z); o.w = (S.xo.w + bf_hi(S.dl.y)) + S.xg.w * (k * v.w);
    __builtin_nontemporal_store(o, (f32x4*)outp);
}
__device__ __forceinline__ void peer_vslice_mfma(const Args& a, Frame& F, int pv = 0) {
    const int x = F.sl_x, wx = F.sl_rank * NWAVES + F.wave, nwx = F.sl_n * NWAVES;
    if (wx >= T) return;
    const int lane = F.lane, eg = lane >> 3, p = lane & 7;
    const unsigned char* TB = a.ws + WS_V + (size_t)x * (2 * MiB); const unsigned poff = 16u * (unsigned)p;
    const unsigned* Wb = (const unsigned*)(a.ws + WS_EIDX) + 16 * eg;
    const unsigned char* CPb = a.ws + WS_CP + ((lane & 15) & 3) * 64 + 16 * (lane >> 4);
    const float* CSb = (const float*)(a.ws + WS_CS);
    const int dcol = 256 * x + 4 * lane;
    const float* G2 = (const float*)(a.ws + WS_MOD) + 5120 + dcol;
    const unsigned char* DLb = a.ws + WS_DELTA + 2 * dcol;
    LAS unsigned char* img = F.lds + F.wave * 17408;
    v4u nA[4], nB[4]; VStr sA, sB;
    int tA = wx, tB = wx + nwx;
#define PS_LDW(dst, tok) do { const unsigned* _w = Wb + (size_t)((tok) < T ? (tok) : T - 1) * 128; _Pragma("unroll") for (int _q = 0; _q < 4; ++_q) dst[_q] = *(const v4u*)(_w + 4 * _q); } while (0)
#define VS_STREAM(S, tok) do { const int _t = (tok) < T ? (tok) : T - 1; vmfma_stream(S, CPb + (size_t)_t * 256, CSb + _t, a.x + (size_t)_t * D + dcol, G2 + (size_t)(_t / SEQ) * 6144, DLb + (size_t)_t * 2048); } while (0)
    PS_LDW(nA, tA); PS_LDW(nB, tB); VS_STREAM(sA, tA); VS_STREAM(sB, tB);
#pragma unroll 1
    for (; tA < T; tA += 2 * nwx, tB += 2 * nwx) {
        VTok A, B;
        vmfma_issue(TB, poff, nA, A);
        vmfma_issue(TB, poff, nB, B);
        const VStr cA = sA, cB = sB;
        VS_STREAM(sA, tA + 2 * nwx); VS_STREAM(sB, tB + 2 * nwx);
        vmfma_compute(A, cA, lane, img, a.out + (size_t)tA * D + dcol, pv);
        PS_LDW(nA, tA + 2 * nwx); PS_LDW(nB, tB + 2 * nwx);
        if (tB < T) vmfma_compute(B, cB, lane, img, a.out + (size_t)tB * D + dcol, pv);
    }
#undef VS_STREAM
#undef PS_LDW
}

constexpr int N_PHASES = 11;
__global__ void __launch_bounds__(NTHREADS, 2) fwd_kernel(Args a) {
    extern __shared__ __attribute__((aligned(16))) unsigned char lds_raw[];
    Frame F; F.lds = (LAS unsigned char*)lds_raw; F.tid = threadIdx.x; F.lane = F.tid & 63; F.wave = __builtin_amdgcn_readfirstlane(F.tid >> 6); F.G = gridDim.x; F.bid = blockIdx.x;
    const int lo = a.ph_lo, hi = a.ph_hi;
    F.sl_x = F.bid & 3; F.sl_rank = F.bid >> 2; F.sl_n = (F.G - F.sl_x + 3) >> 2;
    unsigned* ctl = (unsigned*)(a.ws + WS_CTL);
    const bool census = (lo == 0 && hi == N_PHASES);
    int my_xcc = 0, my_rank = 0;
    XcdBarrier xbar; xbar.bar = ctl + 4096; xbar.x = 0; xbar.st = (volatile LAS unsigned*)(F.lds + LDS_BYTES - 32);
    if (census) {
        if (F.tid == 0) { xbar.st[0] = 0u; xbar.st[1] = 0u; }
        __syncthreads();
        xbar = xcd_barrier_post(ctl + 4096, (volatile LAS unsigned*)(F.lds + LDS_BYTES - 32));
    }
    if (census) {
        LAS volatile unsigned* top = (LAS volatile unsigned*)(F.lds + LDS_BYTES - 64);
        if (F.tid == 0) { const unsigned xcc = (unsigned)__builtin_amdgcn_s_getreg((3 << 11) | 20) & 7u;
            top[0] = xcc; top[1] = __hip_atomic_fetch_add(ctl + 64 * xcc, 1u, __ATOMIC_RELAXED, __HIP_MEMORY_SCOPE_AGENT); }
        __syncthreads();
        my_xcc = __builtin_amdgcn_readfirstlane((int)top[0]); my_rank = __builtin_amdgcn_readfirstlane((int)top[1]);
    }
#ifndef PH_MASK
#define PH_MASK 0x7ff
#endif
#define REPS(k) ((REP_PH == (k)) ? REP_N : 0)
#define IN(k) (((PH_MASK >> (k)) & 1) && lo <= (k) && (k) < hi)
#define SEAM(k) do { if (IN(k) && IN((k) + 1)) { if ((k) == 0 && USE_CG_SYNC) cg::this_grid().sync(); else xcd_barrier(xbar); } } while (0)
    const float* mod = (const float*)(a.ws + WS_MOD);
    for (int rep = 0; rep <= REPS(0); ++rep) if (IN(0)) { if (rep) xcd_barrier(xbar); for (int it = F.bid; it < 192; it += F.G) mod_item(a, F, it); prep_rest(a, F); }
    SEAM(0);
    for (int rep = 0; rep <= REPS(1); ++rep) if (IN(1)) { if (rep) xcd_barrier(xbar); modnorm_rows<false>(a, F, a.x, a.norm1_g, 0, 1024); }
    SEAM(1);
    for (int rep = 0; rep <= REPS(2); ++rep) if (IN(2)) { if (rep) xcd_barrier(xbar);
        pg8::Gemm g{(const bf16*)(a.ws + WS_H), (const bf16*)(a.ws + WS_WIN), T, NIN, D}; pg8::StaticOrder S; S.init(T, NIN, F.G, F.bid);
        pg8::EpiBf16 E{(bf16*)(a.ws + WS_PROJ), NIN};
        pg8::gemm_phase<pg8::EpiBf16, pg8::StaticOrder, true, true>(F.lds, g, S, E);
        const int extra = S.nwg % F.G;
        if (extra == 0) quant_tables(a, F, F.bid * NWAVES + F.wave, F.G * NWAVES);
        else if (F.bid >= extra) quant_tables(a, F, (F.bid - extra) * NWAVES + F.wave, (F.G - extra) * NWAVES);
    }
    SEAM(2);
    for (int rep = 0; rep <= REPS(3); ++rep) if (IN(3)) { if (rep) xcd_barrier(xbar);
        for (int u = F.bid; u < 768; u += F.G) { if (u < 512) { if (a.var != 2 && (rep == 0 || MIX_VAR != 2)) attn_unit(a, F, u, rep == 0 ? 0 : ATT_VAR); } else { if (a.var != 1 && (rep == 0 || MIX_VAR != 1)) conv_unit(a, F, u - 512); } }
    }
    SEAM(3);
    for (int rep = 0; rep <= REPS(4); ++rep) if (IN(4)) { if (rep) xcd_barrier(xbar);
        pg8::Gemm g{(const bf16*)(a.ws + WS_MIX), (const bf16*)(a.ws + WS_WOUT), T, D, D}; pg8::StaticOrder S; S.init(T, D, F.G, F.bid);
        pg8::EpiGateBf16 E{(bf16*)(a.ws + WS_DELTA), D, mod + 2048, 6144, SEQ};
        pg8::gemm_phase<pg8::EpiGateBf16, pg8::StaticOrder, true, true>(F.lds, g, S, E);
    }
    SEAM(4);
    for (int rep = 0; rep <= REPS(5); ++rep) if (IN(5)) { if (rep) xcd_barrier(xbar); modnorm_rows<true>(a, F, a.x, a.norm2_g, 3072, 4096); }
    SEAM(5);
    for (int rep = 0; rep <= REPS(6); ++rep) if (IN(6)) { if (rep) xcd_barrier(xbar);
        pg8::Gemm g{(const bf16*)(a.ws + WS_H), (const bf16*)(a.ws + WS_WQ), T, NQ, D}; pg8::StaticOrder S; S.init(T, NQ, F.G, F.bid);
        pg8::EpiBf16 E{(bf16*)(a.ws + WS_PROJ), NQ};
        pg8::gemm_phase<pg8::EpiBf16, pg8::StaticOrder, true, true>(F.lds, g, S, E);
    }
    SEAM(6);
    for (int rep = 0; rep <= REPS(7); ++rep) if (IN(7)) { if (rep) xcd_barrier(xbar);
        const int h = F.bid & 7, nbh = (F.G - h + 7) >> 3;
        { const bf16* KEYS = (const bf16*)(a.ws + WS_KEYS); LAS bf16* KL = (LAS bf16*)F.lds;
          for (int i = F.tid; i < 2 * 128 * 16; i += NTHREADS) { const int sd = i >> 11, row = (i >> 4) & 127, c16 = i & 15;
              *(LAS v4u*)(KL + (sd * 128 + row) * KEY_LDS_STRIDE + 8 * c16) = *(const v4u*)(KEYS + ((size_t)(sd * 8 + h) * 128 + row) * 128 + 8 * c16); } }
        __syncthreads();
        for (int t = (F.bid >> 3) * NWAVES + F.wave; t < T / 32; t += nbh * NWAVES) topk_unit(a, F, t, h);
        __syncthreads(); }
    SEAM(7);
    if (census) {
        unsigned sum = 0; bool ok = true; unsigned mine = 1, other = 0;
#pragma unroll
        for (int j = 0; j < 8; ++j) { const unsigned cj = __hip_atomic_load(ctl + 64 * j, __ATOMIC_RELAXED, __HIP_MEMORY_SCOPE_AGENT); sum += cj; ok = ok && (cj > 0u); if (j == my_xcc) mine = cj; if (j == (my_xcc ^ 4)) other = cj; }
        if (ok && sum == (unsigned)F.G) { F.sl_x = my_xcc & 3; F.sl_rank = my_rank + ((my_xcc & 4) ? (int)other : 0); F.sl_n = (int)(mine + other); }
    }
    for (int rep = 0; rep <= REPS(8); ++rep) if (IN(8)) { if (rep) xcd_barrier(xbar); peer_slice<false>(a, F); }
    SEAM(8);
    for (int rep = 0; rep <= REPS(9); ++rep) if (IN(9)) { if (rep) xcd_barrier(xbar); peer_coef(a, F); }
    SEAM(9);
    for (int rep = 0; rep <= REPS(10); ++rep) if (IN(10)) { if (rep) xcd_barrier(xbar); if (V_MFMA) peer_vslice_mfma(a, F, (rep >= 1 && rep < REP_N) ? VS_VAR : 0); else peer_slice<true>(a, F); }
#undef IN
#undef SEAM
}

extern "C" void kernel_launch(void* const* d_in, const int* in_sizes, int n_in, void* d_out, int out_size, void* d_ws, size_t ws_size, hipStream_t stream) {
    static int grid = 0;
    if (grid == 0) {
        if (n_in != 19 || in_sizes[0] != T * D || out_size != T * D || ws_size < WS_END) { fprintf(stderr, "kernel_launch: unexpected shapes (n_in %d, in0 %d, out %d, ws %zu)\n", n_in, n_in > 0 ? in_sizes[0] : -1, out_size, ws_size); grid = -1; return; }
        int dev = 0, cus = 0, per_cu = 0;
        hipGetDevice(&dev); hipDeviceGetAttribute(&cus, hipDeviceAttributeMultiprocessorCount, dev);
        hipFuncSetAttribute((const void*)fwd_kernel, hipFuncAttributeMaxDynamicSharedMemorySize, LDS_BYTES);
        hipOccupancyMaxActiveBlocksPerMultiprocessor(&per_cu, (const void*)fwd_kernel, NTHREADS, LDS_BYTES);
        (void)hipGetLastError();
        if (per_cu < 1) { fprintf(stderr, "kernel_launch: occupancy query says %d blocks/CU\n", per_cu); per_cu = 1; }
        grid = cus * 1;
    }
    if (grid < 0) return;
    (void)hipMemsetAsync(d_ws, 0, 32768, stream);
    Args a{};
    const float** p = (const float**)&a;
    for (int i = 0; i < 19; ++i) p[i] = (const float*)d_in[i];
    a.out = (float*)d_out; a.ws = (unsigned char*)d_ws;
#if N_LAUNCH_SPLIT
    for (int ph = 0; ph < N_PHASES; ++ph) { a.ph_lo = ph; a.ph_hi = ph + 1;
        for (int rep = 0; rep < (((REP_MASK >> ph) & 1) ? 2 : 1); ++rep) hipLaunchKernelGGL(fwd_kernel, dim3(grid), dim3(NTHREADS), LDS_BYTES, stream, a); }
    for (int ph = 0; ph < N_PHASES - 1; ++ph) if ((LATE_MASK >> ph) & 1) { a.ph_lo = ph; a.ph_hi = ph + 1; a.var = LATE_VAR; hipLaunchKernelGGL(fwd_kernel, dim3(grid), dim3(NTHREADS), LDS_BYTES, stream, a); }
#else
    a.ph_lo = 0; a.ph_hi = N_PHASES;
    void* args[] = {&a};
    hipError_t e = hipLaunchCooperativeKernel((const void*)fwd_kernel, dim3(grid), dim3(NTHREADS), args, LDS_BYTES, stream);
    if (e != hipSuccess) fprintf(stderr, "cooperative launch failed: %s (grid %d)\n", hipGetErrorString(e), grid);
#endif
}
```

```cpp
#include <hip/hip_runtime.h>
#include <hip/hip_cooperative_groups.h>
#include <cstdio>
#include <cstdint>
namespace cg = cooperative_groups;

#ifndef REP_MASK
#define REP_MASK 0
#endif
#ifndef USE_CG_SYNC
#define USE_CG_SYNC 0
#endif
#ifndef ATT_VAR
#define ATT_VAR 0
#endif
#ifndef V_MFMA
#define V_MFMA 1
#endif
#ifndef VS_VAR
#define VS_VAR 0
#endif
#ifndef MIX_VAR
#define MIX_VAR 0
#endif
#ifndef REP_PH
#define REP_PH -1
#endif
#ifndef REP_N
#define REP_N 0
#endif
#ifndef LATE_MASK
#define LATE_MASK 0
#endif
#ifndef LATE_VAR
#define LATE_VAR 0
#endif
#ifndef N_LAUNCH_SPLIT
#define N_LAUNCH_SPLIT 0
#endif

namespace pg8 {
#define PG8_LAS __attribute__((address_space(3)))
typedef unsigned short bf16_t;
typedef short bf16x8 __attribute__((ext_vector_type(8)));
typedef float f32x4 __attribute__((ext_vector_type(4)));
typedef unsigned u32x4 __attribute__((ext_vector_type(4)));
constexpr int BM = 256, BK = 64, HALF = 128, HTB = HALF * BK * 2  , STAGE_BYTES = 8 * HTB, NXCD = 8, WGM = 8;

__host__ __device__ __forceinline__ int lds_byte(int r, int c) { const int st = (r >> 4) * 2 + (c >> 5), rr = r & 15, cc = c & 31, ob = rr * 64 + cc * 2; return st * 1024 + (ob ^ (((ob >> 9) & 1) << 5)); }
__host__ __device__ __forceinline__ void stage_rc(int b, int& R, int& C) { const int st = b / 1024, sb = b % 1024, swz = sb ^ (((sb >> 9) & 1) << 5); R = (st >> 1) * 16 + swz / 64; C = (st & 1) * 32 + (swz % 64) / 2; }
__host__ __device__ __forceinline__ int perm32(int rho) { const int n = rho >> 4, i = rho & 15; return 8 * (i >> 2) + 4 * n + (i & 3); }

struct Unit { int pm, pn; };
struct Gemm { const bf16_t* A; const bf16_t* Bt; int M, N, K; };

struct StaticOrder {
    int nM, nN, nwg, G, c;
    __host__ __device__ void init(int M, int N, int G_, int c_) { nM = M / BM; nN = N / BM; nwg = nM * nN; G = G_; c = c_; }
    __host__ __device__ bool next(int i, Unit& u) const {
        const long L = (long)i * G + c; if (L >= nwg) return false;
        int wgid = (int)L; { const int q = nwg / NXCD, r = nwg % NXCD, xcd = wgid % NXCD, off = wgid / NXCD; wgid = (xcd < r ? xcd * (q + 1) : r * (q + 1) + (xcd - r) * q) + off; }
        const int nig = WGM * nN, gid = wgid / nig, fm = gid * WGM, gsz = (nM - fm) < WGM ? (nM - fm) : WGM;
        u.pm = fm + ((wgid % nig) % gsz); u.pn = (wgid % nig) / gsz; return true;
    }
    __device__ __forceinline__ void a_ready(const Unit&) const {}
    __device__ __forceinline__ void done(const Unit&) const {}
};

__device__ __forceinline__ unsigned cvt_pk_bf16(float lo, float hi) { unsigned r; asm volatile("v_cvt_pk_bf16_f32 %0, %1, %2" : "=v"(r) : "v"(lo), "v"(hi)); return r; }

struct EpiBf16 {
    static constexpr bool PERM = true, AFTER_DRAIN = false;
    bf16_t* O; int ldc;
    __device__ __forceinline__ void operator()(const f32x4 (&acc)[2][2][4][2], const Unit& u, int wr, int wc, int fr, int fq) const {
        const int row0 = u.pm * BM + wr * 64 + fr; const int col0 = u.pn * BM + wc * 32 + 8 * fq;
#pragma unroll
        for (int ai = 0; ai < 2; ++ai)
#pragma unroll
            for (int m = 0; m < 4; ++m) { bf16_t* rowp = O + (size_t)(row0 + ai * HALF + m * 16) * ldc + col0;
#pragma unroll
                for (int bj = 0; bj < 2; ++bj) { const f32x4 v0 = acc[ai][bj][m][0], v1 = acc[ai][bj][m][1];
                    u32x4 w; w.x = cvt_pk_bf16(v0[0], v0[1]); w.y = cvt_pk_bf16(v0[2], v0[3]); w.z = cvt_pk_bf16(v1[0], v1[1]); w.w = cvt_pk_bf16(v1[2], v1[3]);
                    *(u32x4*)(rowp + bj * HALF) = w; } }
    }
};
struct EpiGateBf16 {
    static constexpr bool PERM = true, AFTER_DRAIN = false;
    bf16_t* O; int ldc; const float* gate; int gstride; int rows_per_batch;
    __device__ __forceinline__ void operator()(const f32x4 (&acc)[2][2][4][2], const Unit& u, int wr, int wc, int fr, int fq) const {
        const int row0 = u.pm * BM + wr * 64 + fr; const int col0 = u.pn * BM + wc * 32 + 8 * fq;
        const float* gp = gate + (size_t)((u.pm * BM) / rows_per_batch) * gstride + col0;
        f32x4 gv[2][2];
#pragma unroll
        for (int bj = 0; bj < 2; ++bj)
#pragma unroll
            for (int n = 0; n < 2; ++n) gv[bj][n] = *(const f32x4*)(gp + bj * HALF + 4 * n);
#pragma unroll
        for (int ai = 0; ai < 2; ++ai)
#pragma unroll
            for (int m = 0; m < 4; ++m) { bf16_t* rowp = O + (size_t)(row0 + ai * HALF + m * 16) * ldc + col0;
#pragma unroll
                for (int bj = 0; bj < 2; ++bj) { const f32x4 v0 = acc[ai][bj][m][0] * gv[bj][0], v1 = acc[ai][bj][m][1] * gv[bj][1];
                    u32x4 w; w.x = cvt_pk_bf16(v0[0], v0[1]); w.y = cvt_pk_bf16(v0[2], v0[3]); w.z = cvt_pk_bf16(v1[0], v1[1]); w.w = cvt_pk_bf16(v1[2], v1[3]);
                    *(u32x4*)(rowp + bj * HALF) = w; } }
    }
};
struct EpiResid {
    static constexpr bool PERM = false, AFTER_DRAIN = false;
    const float* base; float* out; int ldc; const float* gate; int gstride; int rows_per_batch;
    __device__ __forceinline__ void operator()(const f32x4 (&acc)[2][2][4][2], const Unit& u, int wr, int wc, int fr, int fq) const {
        const int row0 = u.pm * BM + wr * 64 + fr; const int col0 = u.pn * BM + wc * 32 + 4 * fq;
        const float* gp = gate + (size_t)((u.pm * BM) / rows_per_batch) * gstride + col0;
        f32x4 gv[2][2];
#pragma unroll
        for (int bj = 0; bj < 2; ++bj)
#pragma unroll
            for (int n = 0; n < 2; ++n) gv[bj][n] = *(const f32x4*)(gp + bj * HALF + n * 16);
#pragma unroll
        for (int ai = 0; ai < 2; ++ai)
#pragma unroll
            for (int m = 0; m < 4; ++m) { const size_t off = (size_t)(row0 + ai * HALF + m * 16) * ldc + col0;
#pragma unroll
                for (int bj = 0; bj < 2; ++bj)
#pragma unroll
                    for (int n = 0; n < 2; ++n) { const f32x4 bs = *(const f32x4*)(base + off + bj * HALF + n * 16);
                        *(f32x4*)(out + off + bj * HALF + n * 16) = bs + gv[bj][n] * acc[ai][bj][m][n]; } }
    }
};

template <class Epi, class Sched, bool ALIGN_EPI = false, bool SP2 = false>
__device__ __forceinline__ void gemm_phase(PG8_LAS unsigned char* lds, const Gemm g, const Sched& S, const Epi& E) {
    const int tid = threadIdx.x, wid = __builtin_amdgcn_readfirstlane(tid >> 6), lane = tid & 63, wr = wid >> 2, wc = wid & 3, fr = lane & 15, fq = lane >> 4;
    const int K = g.K, nt = K / BK;
    unsigned voffA[2], voffB[2];
#pragma unroll
    for (int i = 0; i < 2; ++i) { int R, C; stage_rc(tid * 16 + i * 8192, R, C); const int Rb = Epi::PERM ? ((R & ~31) + perm32(R & 31)) : R;
        voffA[i] = (unsigned)(R * K + C) * 2u; voffB[i] = (unsigned)(Rb * K + C) * 2u; }
    const size_t kstep = (size_t)(BK * 2);
    const size_t hstep = (size_t)HALF * K * 2;
    const size_t tstep = 2 * hstep;
    const unsigned ldsw = (unsigned)wid * 1024u;
    const int aoff = lds_byte(wr * 64 + fr, fq * 8), boff = lds_byte(wc * 32 + fr, fq * 8);
#define PG8_SA(b, h) (((b) * 2 + (h)) * HTB)
#define PG8_SB(b, h) ((4 + (b) * 2 + (h)) * HTB)
#define PG8_STAGE(bufoff, gbase, voff) do { _Pragma("unroll") for (int _i = 0; _i < 2; ++_i) \
        __builtin_amdgcn_global_load_lds((const unsigned*)((const char*)(gbase) + (voff)[_i]), (PG8_LAS unsigned*)(lds + (bufoff) + ldsw + _i * 8192), 16, 0, 0); } while (0)
#define PG8_LDA(dst, b, h) do { _Pragma("unroll") for (int m = 0; m < 4; ++m) _Pragma("unroll") for (int k = 0; k < 2; ++k) dst[m][k] = *(const PG8_LAS bf16x8*)(lds + PG8_SA(b, h) + aoff + m * 2048 + k * 1024); } while (0)
#define PG8_LDB(dst, b, h) do { _Pragma("unroll") for (int n = 0; n < 2; ++n) _Pragma("unroll") for (int k = 0; k < 2; ++k) dst[n][k] = *(const PG8_LAS bf16x8*)(lds + PG8_SB(b, h) + boff + n * 2048 + k * 1024); } while (0)
#define PG8_MMA(ai, bj, At, Bt) do { __builtin_amdgcn_s_setprio(1); _Pragma("unroll") for (int m = 0; m < 4; ++m) _Pragma("unroll") for (int n = 0; n < 2; ++n) _Pragma("unroll") for (int k = 0; k < 2; ++k) \
        acc[ai][bj][m][n] = __builtin_amdgcn_mfma_f32_16x16x32_bf16(Bt[n][k], At[m][k], acc[ai][bj][m][n], 0, 0, 0); __builtin_amdgcn_s_setprio(0); } while (0)
#define PG8_WAIT_V(n) asm volatile("s_waitcnt vmcnt(" #n ")" ::: "memory")
#define PG8_WAIT_L(n) asm volatile("s_waitcnt lgkmcnt(" #n ")" ::: "memory")
#define PG8_BAR __builtin_amdgcn_s_barrier()
#define PG8_SCHED __builtin_amdgcn_sched_barrier(0)
    Unit cur, nxt; int ui = 0;
    if (!S.next(0, cur)) return;
    f32x4 acc[2][2][4][2];
#pragma unroll
    for (int a = 0; a < 2; ++a)
#pragma unroll
        for (int b = 0; b < 2; ++b)
#pragma unroll
            for (int m = 0; m < 4; ++m)
#pragma unroll
                for (int n = 0; n < 2; ++n) acc[a][b][m][n] = (f32x4){0.f, 0.f, 0.f, 0.f};
    bf16x8 At[4][2], B0[2][2], B1[2][2];
    const char* cA = (const char*)g.A + (size_t)cur.pm * tstep; const char* cB = (const char*)g.Bt + (size_t)cur.pn * tstep;
    S.a_ready(cur);
    if constexpr (SP2) {
        PG8_STAGE(PG8_SB(0, 0), cB, voffB); PG8_STAGE(PG8_SB(0, 1), cB + hstep, voffB); PG8_STAGE(PG8_SA(0, 0), cA, voffA); PG8_STAGE(PG8_SA(0, 1), cA + hstep, voffA);
        if (wr == 1) PG8_BAR;
        PG8_WAIT_V(2); PG8_BAR;
        PG8_STAGE(PG8_SB(1, 0), cB + kstep, voffB); PG8_STAGE(PG8_SA(1, 0), cA + kstep, voffA); PG8_STAGE(PG8_SB(1, 1), cB + hstep + kstep, voffB);
        PG8_WAIT_V(6); PG8_BAR;
    } else {
        PG8_STAGE(PG8_SB(0, 0), cB, voffB); PG8_STAGE(PG8_SA(0, 0), cA, voffA); PG8_STAGE(PG8_SB(0, 1), cB + hstep, voffB); PG8_STAGE(PG8_SA(0, 1), cA + hstep, voffA);
        if (wr == 1) PG8_BAR;
        PG8_WAIT_V(4); PG8_BAR;
        PG8_STAGE(PG8_SB(1, 0), cB + kstep, voffB); PG8_STAGE(PG8_SA(1, 0), cA + kstep, voffA); PG8_STAGE(PG8_SB(1, 1), cB + hstep + kstep, voffB);
        PG8_WAIT_V(6); PG8_BAR;
    }
    for (;;) {
        const bool has_next = S.next(ui + 1, nxt);
        const char* nA = has_next ? (const char*)g.A + (size_t)nxt.pm * tstep : cA; const char* nB = has_next ? (const char*)g.Bt + (size_t)nxt.pn * tstep : cB;
        for (int t = 0; t < nt; t += 2) {
            const bool last = (t == nt - 2);
            const char* a1 = cA + (size_t)(t + 1) * kstep;
            const char* a2 = last ? nA : cA + (size_t)(t + 2) * kstep; const char* b2 = last ? nB : cB + (size_t)(t + 2) * kstep;
            const char* a3 = a2 + kstep; const char* b3 = b2 + kstep;
            if (last && has_next) S.a_ready(nxt);
            if constexpr (SP2) {
            PG8_LDB(B0, 0, 0); PG8_LDB(B1, 0, 1); PG8_SCHED; PG8_LDA(At, 0, 0); PG8_STAGE(PG8_SA(1, 1), a1 + hstep, voffA);
            PG8_WAIT_V(8); PG8_WAIT_L(0); PG8_BAR; PG8_MMA(0, 0, At, B0); PG8_MMA(0, 1, At, B1); PG8_BAR; PG8_SCHED;
            PG8_LDA(At, 0, 1); PG8_STAGE(PG8_SB(0, 0), b2, voffB); PG8_STAGE(PG8_SB(0, 1), b2 + hstep, voffB); PG8_STAGE(PG8_SA(0, 0), a2, voffA);
            PG8_WAIT_V(8); PG8_WAIT_L(0); PG8_BAR; PG8_MMA(1, 0, At, B0); PG8_MMA(1, 1, At, B1); PG8_BAR; PG8_SCHED;
            PG8_LDB(B0, 1, 0); PG8_LDB(B1, 1, 1); PG8_SCHED; PG8_LDA(At, 1, 0); PG8_STAGE(PG8_SA(0, 1), a2 + hstep, voffA);
            PG8_WAIT_V(8); PG8_WAIT_L(0); PG8_BAR; PG8_MMA(0, 0, At, B0); PG8_MMA(0, 1, At, B1); PG8_BAR; PG8_SCHED;
            PG8_LDA(At, 1, 1); PG8_STAGE(PG8_SB(1, 0), b3, voffB); PG8_STAGE(PG8_SB(1, 1), b3 + hstep, voffB); PG8_STAGE(PG8_SA(1, 0), a3, voffA);
            PG8_WAIT_V(8); PG8_WAIT_L(0); PG8_BAR; PG8_MMA(1, 0, At, B0); PG8_MMA(1, 1, At, B1); PG8_BAR; PG8_SCHED;
            } else {
            PG8_LDB(B0, 0, 0); PG8_SCHED; PG8_LDA(At, 0, 0); PG8_STAGE(PG8_SA(1, 1), a1 + hstep, voffA);
            PG8_WAIT_L(8); PG8_BAR; PG8_WAIT_L(0); PG8_MMA(0, 0, At, B0); PG8_BAR; PG8_SCHED;
            PG8_LDB(B1, 0, 1); PG8_STAGE(PG8_SB(0, 0), b2, voffB);
            PG8_BAR; PG8_WAIT_L(0); PG8_MMA(0, 1, At, B1); PG8_BAR;
            PG8_LDA(At, 0, 1); PG8_STAGE(PG8_SA(0, 0), a2, voffA);
            PG8_BAR; PG8_WAIT_L(0); PG8_MMA(1, 0, At, B0); PG8_BAR; PG8_SCHED;
            PG8_STAGE(PG8_SB(0, 1), b2 + hstep, voffB);
            PG8_WAIT_V(6); PG8_BAR; PG8_MMA(1, 1, At, B1); PG8_BAR;
            PG8_LDB(B0, 1, 0); PG8_SCHED; PG8_LDA(At, 1, 0); PG8_STAGE(PG8_SA(0, 1), a2 + hstep, voffA);
            PG8_WAIT_L(8); PG8_BAR; PG8_WAIT_L(0); PG8_MMA(0, 0, At, B0); PG8_BAR; PG8_SCHED;
            PG8_LDB(B1, 1, 1); PG8_STAGE(PG8_SB(1, 0), b3, voffB);
            PG8_BAR; PG8_WAIT_L(0); PG8_MMA(0, 1, At, B1); PG8_BAR;
            PG8_LDA(At, 1, 1); PG8_STAGE(PG8_SA(1, 0), a3, voffA);
            PG8_BAR; PG8_WAIT_L(0); PG8_MMA(1, 0, At, B0); PG8_BAR; PG8_SCHED;
            PG8_STAGE(PG8_SB(1, 1), b3 + hstep, voffB);
            PG8_WAIT_V(6); PG8_BAR; PG8_MMA(1, 1, At, B1); PG8_BAR;
            }
        }
        if constexpr (ALIGN_EPI) { if (wr == 0) PG8_BAR; }
        if constexpr (!Epi::AFTER_DRAIN) { E(acc, cur, wr, wc, fr, fq); S.done(cur); }
        if (!has_next) break;
#pragma unroll
        for (int a = 0; a < 2; ++a)
#pragma unroll
            for (int b = 0; b < 2; ++b)
#pragma unroll
                for (int m = 0; m < 4; ++m)
#pragma unroll
                    for (int n = 0; n < 2; ++n) acc[a][b][m][n] = (f32x4){0.f, 0.f, 0.f, 0.f};
        cur = nxt; cA = nA; cB = nB; ++ui;
        if constexpr (ALIGN_EPI) { if (wr == 1) PG8_BAR; }
    }
    PG8_WAIT_V(0);
    if constexpr (!ALIGN_EPI) { if (wr == 0) PG8_BAR; }
    PG8_BAR;
#undef PG8_SA
#undef PG8_SB
#undef PG8_STAGE
#undef PG8_LDA
#undef PG8_LDB
#undef PG8_MMA
#undef PG8_WAIT_V
#undef PG8_WAIT_L
#undef PG8_BAR
#undef PG8_SCHED
}
}

constexpr int NWAVES = 8, NTHREADS = 512;
constexpr int BATCH = 8, SEQ = 4096, D = 1024, T = BATCH * SEQ;
constexpr int NIN = 2304, NQ = 2048, NEXP = 16384;
constexpr int C_B = 0, C_C = 512, C_H = 1024, C_Q = 1536, C_K = 2048, C_V = 2176;
constexpr float EPS = 1e-6f;
constexpr size_t MiB = 1u << 20;
constexpr size_t WS_CTL = 0;
constexpr size_t WS_MOD = 1 * MiB;
constexpr size_t WS_BIAS = WS_MOD + 256 * 1024;
constexpr size_t WS_WIN = 2 * MiB;
constexpr size_t WS_WOUT = 7 * MiB;
constexpr size_t WS_WQ = 9 * MiB;
constexpr size_t WS_KEYS = 13 * MiB;
constexpr size_t WS_SU = WS_MOD + 384 * 1024;
constexpr size_t WS_SV = WS_MOD + 448 * 1024;
constexpr size_t WS_U = 14 * MiB;
constexpr size_t WS_V = 30 * MiB;
constexpr size_t WS_H = 78 * MiB;
constexpr size_t WS_MIX = 142 * MiB;
constexpr size_t WS_H4 = WS_MIX + 16 * MiB;
constexpr size_t WS_ST = WS_MOD + 512 * 1024;
constexpr size_t WS_CP = WS_MIX + 48 * MiB;
constexpr size_t WS_CS = WS_MOD + 640 * 1024;
constexpr size_t WS_PACK = WS_MIX;
constexpr size_t WS_PROJ = 206 * MiB;
constexpr size_t WS_PART = WS_PROJ;
constexpr size_t WS_EIDX = 350 * MiB;
constexpr size_t WS_GATE = 366 * MiB;
constexpr size_t WS_DELTA = 382 * MiB;
constexpr size_t WS_END = 510 * MiB;

constexpr int LDS_BYTES = 147456;

#define GAS __attribute__((address_space(1)))
#define LAS __attribute__((address_space(3)))
typedef unsigned short bf16;
typedef unsigned v4u __attribute__((ext_vector_type(4)));
typedef unsigned v2u __attribute__((ext_vector_type(2)));
typedef float f32x4 __attribute__((ext_vector_type(4)));
typedef float f32x16 __attribute__((ext_vector_type(16)));
typedef short bf16x8 __attribute__((ext_vector_type(8)));
typedef int v8i __attribute__((ext_vector_type(8)));

__device__ __forceinline__ unsigned f2bf(float f) { unsigned u = __builtin_bit_cast(unsigned, f); return (u + 0x7fffu + ((u >> 16) & 1u)) >> 16; }
__device__ __forceinline__ unsigned pk2(float lo, float hi) { unsigned r; asm("v_cvt_pk_bf16_f32 %0, %1, %2" : "=v"(r) : "v"(lo), "v"(hi)); return r; }
__device__ __forceinline__ float bf_lo(unsigned w) { return __builtin_bit_cast(float, w << 16); }
__device__ __forceinline__ float bf_hi(unsigned w) { return __builtin_bit_cast(float, w & 0xffff0000u); }
__device__ __forceinline__ float wave_sum(float v) {
#pragma unroll
    for (int o = 1; o < 64; o <<= 1) v += __shfl_xor(v, o);
    return v;
}

#define XB_TMO      128
#define XB_XCNT(j)  (256  + 64 * (j))
#define XB_XSUB(j)  (1280 + 64 * (j))
#define XB_XGEN(j)  (2304 + 64 * (j))
#define XB_TOP      3328
#define XB_TOPGEN   3392
#define XCD_BAR_WORDS 3456
#define XB_SPIN_CAP (1u << 18)
__device__ __forceinline__ unsigned xb_ld(unsigned* p)              { return __hip_atomic_load(p, __ATOMIC_RELAXED, __HIP_MEMORY_SCOPE_AGENT); }
__device__ __forceinline__ unsigned xb_add(unsigned* p, unsigned v) { return __hip_atomic_fetch_add(p, v, __ATOMIC_RELAXED, __HIP_MEMORY_SCOPE_AGENT); }
__device__ __forceinline__ unsigned xb_xcc_id() { return (unsigned)__builtin_amdgcn_s_getreg((3 << 11) | 20) & 0xFu; }
#define XB_SPIN(cond, bar) do { unsigned _sp = 0; while (cond) { __builtin_amdgcn_s_sleep(1); \
    if ((++_sp & 255u) == 0u) { if (xb_ld(&(bar)[XB_TMO])) break; if (_sp > XB_SPIN_CAP) { atomicAdd(&(bar)[XB_TMO], 1u); break; } } } } while (0)
struct XcdBarrier { unsigned* bar; unsigned x; volatile LAS unsigned* st; };
__device__ __forceinline__ XcdBarrier xcd_barrier_post(unsigned* bar, volatile LAS unsigned* st) {
    XcdBarrier b; b.bar = bar; b.x = xb_xcc_id(); b.st = st;
    if (threadIdx.x == 0) (void)xb_add(&bar[XB_XCNT(b.x)], 1u);
    return b;
}
__device__ __forceinline__ void xcd_barrier_complete(unsigned* bar, unsigned x, unsigned& nloc, unsigned& nx) {
    const unsigned G = gridDim.x * gridDim.y * gridDim.z;
    unsigned sum, cnt, mine, sp = 0u;
    for (;;) {
        sum = 0u; cnt = 0u; mine = 0u;
#pragma unroll
        for (unsigned j = 0; j < 16; ++j) { const unsigned c = xb_ld(&bar[XB_XCNT(j)]); sum += c; cnt += (c > 0u) ? 1u : 0u; mine = (j == x) ? c : mine; }
        if (sum == G) break;
        __builtin_amdgcn_s_sleep(1);
        if ((++sp & 255u) == 0u) { if (xb_ld(&bar[XB_TMO])) break; if (sp > XB_SPIN_CAP) { atomicAdd(&bar[XB_TMO], 1u); break; } }
    }
    nloc = mine > 0u ? mine : 1u; nx = cnt > 0u ? cnt : 1u;
}
__device__ __forceinline__ void xcd_barrier(const XcdBarrier& b) {
    asm volatile("s_waitcnt vmcnt(0)" ::: "memory");
    __syncthreads();
    if (threadIdx.x == 0) {
        unsigned* bar = b.bar;
        __builtin_amdgcn_s_waitcnt(0);
        unsigned nloc = b.st[0], nx = b.st[1];
        if (nloc == 0u) { xcd_barrier_complete(bar, b.x, nloc, nx); b.st[0] = nloc; b.st[1] = nx; }
        const unsigned old = xb_add(&bar[XB_XSUB(b.x)], 1u);
        const unsigned gen = old / nloc;
        if (old + 1u == (gen + 1u) * nloc) {
            __builtin_amdgcn_fence(__ATOMIC_RELEASE, "agent");
            asm volatile("s_waitcnt vmcnt(0)" ::: "memory");
            const unsigned og = xb_add(&bar[XB_TOP], 1u);
            const unsigned tg = og / nx;
            if (og + 1u == (tg + 1u) * nx) xb_add(&bar[XB_TOPGEN], 1u);
            else XB_SPIN(xb_ld(&bar[XB_TOPGEN]) == tg, bar);
            __builtin_amdgcn_fence(__ATOMIC_ACQUIRE, "agent");
            xb_add(&bar[XB_XGEN(b.x)], 1u);
            asm volatile("s_waitcnt vmcnt(0)" ::: "memory");
        } else {
            XB_SPIN(xb_ld(&bar[XB_XGEN(b.x)]) == gen, bar);
            __builtin_amdgcn_fence(__ATOMIC_ACQUIRE, "agent");
            asm volatile("s_waitcnt vmcnt(0)" ::: "memory");
        }
    }
    __syncthreads();
}

struct Args {
    const float *x, *c, *w_ada, *b_ada, *norm1_g, *w_in, *conv_w, *q_norm_g, *k_norm_g, *sinks, *rel_bias, *conv_out_g, *attn_out_g, *w_out, *norm2_g, *peer_wq, *peer_keys, *peer_u, *peer_v;
    float* out; unsigned char* ws; int ph_lo, ph_hi, var, pad;
};

struct Frame {
    LAS unsigned char* lds; int tid, lane, wave, G, bid;
    int sl_x, sl_rank, sl_n;
};

__device__ __forceinline__ void mod_item(const Args& a, Frame& F, int item) {
    LAS float* sc = (LAS float*)F.lds;
    LAS float* red = (LAS float*)(F.lds + 32768);
    for (int i = F.tid; i < 8192; i += NTHREADS) { const float v = a.c[i]; sc[i] = v / (1.f + __expf(-v)); }
    __syncthreads();
    const int cl = F.tid & 31, kg = F.tid >> 5, col = item * 32 + cl;
    float acc[8];
#pragma unroll
    for (int b = 0; b < 8; ++b) acc[b] = 0.f;
#pragma unroll 8
    for (int k = kg * 64; k < kg * 64 + 64; ++k) { const float w = a.w_ada[(size_t)k * 6144 + col];
#pragma unroll
        for (int b = 0; b < 8; ++b) acc[b] += sc[b * 1024 + k] * w; }
#pragma unroll
    for (int b = 0; b < 8; ++b) red[(kg * 32 + cl) * 8 + b] = acc[b];
    __syncthreads();
    if (F.tid < 256) { const int b = F.tid >> 5; float s = 0.f;
#pragma unroll
      for (int g = 0; g < 16; ++g) s += red[(g * 32 + cl) * 8 + b];
      ((float*)(a.ws + WS_MOD))[b * 6144 + col] = s + a.b_ada[col]; }
    __syncthreads();
}
__device__ __forceinline__ void transpose_item(const float* W, int K, int N, bf16* WT, LAS float* scr, int item, int lane) {
    const int nblk = N / 32, kb = item / nblk, nb = item % nblk, k0 = 64 * kb, n0 = 32 * nb;
#pragma unroll 8
    for (int i = 0; i < 32; ++i) { const int kk = 2 * i + (lane >> 5); scr[kk * 33 + (lane & 31)] = W[(size_t)(k0 + kk) * N + n0 + (lane & 31)]; }
    asm volatile("s_waitcnt lgkmcnt(0)" ::: "memory");
    const int c = lane & 7;
#pragma unroll
    for (int j = 0; j < 4; ++j) { const int n = (lane >> 3) + 8 * j; const LAS float* s = scr + (8 * c) * 33 + n;
        v4u o; o.x = pk2(s[0 * 33], s[1 * 33]); o.y = pk2(s[2 * 33], s[3 * 33]); o.z = pk2(s[4 * 33], s[5 * 33]); o.w = pk2(s[6 * 33], s[7 * 33]);
        *(v4u*)(WT + (size_t)(n0 + n) * K + k0 + 8 * c) = o; }
    asm volatile("s_waitcnt lgkmcnt(0)" ::: "memory");
}
__device__ __forceinline__ void cvt_rows(const float* src, bf16* dst, size_t n8, size_t gtid, size_t gn) {
    for (size_t i = gtid; i < n8; i += gn) { const f32x4 a = ((const f32x4*)src)[2 * i], b = ((const f32x4*)src)[2 * i + 1];
        v4u o; o.x = pk2(a.x, a.y); o.y = pk2(a.z, a.w); o.z = pk2(b.x, b.y); o.w = pk2(b.z, b.w); ((v4u*)dst)[i] = o; }
}
__device__ __forceinline__ void quant_tables(const Args& a, Frame& F, int widx, int nw) {
    for (int r0 = 4 * widx; r0 < 2 * NEXP; r0 += 4 * nw) {
        const bool isv = r0 >= NEXP; const int e0 = isv ? r0 - NEXP : r0;
        const float* tab = isv ? a.peer_v : a.peer_u;
        f32x4 v[4][4];
#pragma unroll
        for (int r = 0; r < 4; ++r) { const f32x4* src = (const f32x4*)(tab + (size_t)(e0 + r) * D) + F.lane;
#pragma unroll
            for (int j = 0; j < 4; ++j) v[r][j] = src[64 * j]; }
#pragma unroll
        for (int r = 0; r < 4; ++r) { float mx = 0.f;
#pragma unroll
            for (int j = 0; j < 4; ++j) mx = fmaxf(mx, fmaxf(fmaxf(fabsf(v[r][j].x), fabsf(v[r][j].y)), fmaxf(fabsf(v[r][j].z), fabsf(v[r][j].w))));
#pragma unroll
            for (int o = 1; o < 64; o <<= 1) mx = fmaxf(mx, __shfl_xor(mx, o));
            float ssq = 0.f;
#pragma unroll
            for (int j = 0; j < 4; ++j) ssq += (v[r][j].x * v[r][j].x + v[r][j].y * v[r][j].y) + (v[r][j].z * v[r][j].z + v[r][j].w * v[r][j].w);
            ssq = wave_sum(ssq);
            const float clip = fminf(mx, 2.7f * sqrtf(ssq * (1.f / D)));
            const float scale = mx > 0.f ? (isv ? mx * (1.f / 6.f) : clip * (1.f / 7.f)) : 1.f, inv = 1.f / scale;
            unsigned char* dst = a.ws + (isv ? WS_V : WS_U) + (size_t)(e0 + r) * 128 + 2 * F.lane;
#pragma unroll
            for (int j = 0; j < 4; ++j) { unsigned w;
                if (isv) { w = __builtin_amdgcn_cvt_scalef32_pk_fp4_f32(0u, v[r][j].x * inv, v[r][j].y * inv, 1.0f, 0); w = __builtin_amdgcn_cvt_scalef32_pk_fp4_f32(w, v[r][j].z * inv, v[r][j].w * inv, 1.0f, 1); }
                else { w = 0u;
#pragma unroll
                    for (int c = 0; c < 4; ++c) { const int qi = (int)fminf(fmaxf(rintf(v[r][j][c] * inv), -7.f), 7.f); w |= ((unsigned)qi & 15u) << (4 * c); } }
                *(unsigned short*)(dst + (size_t)j * (2 * MiB)) = (unsigned short)w; }
            if (F.lane == 0) ((float*)(a.ws + (isv ? WS_SV : WS_SU)))[e0 + r] = scale; }
    }
}
__device__ __forceinline__ void prep_rest(const Args& a, Frame& F) {
    LAS float* scr = (LAS float*)(F.lds + 65536 + F.wave * 8448);
    const int gw = F.bid * NWAVES + F.wave, NGW = F.G * NWAVES;
    constexpr int I_IN = (D / 64) * (NIN / 32), I_OUT = (D / 64) * (D / 32), I_Q = (D / 64) * (NQ / 32);
    for (int it = gw; it < I_IN + I_OUT + I_Q; it += NGW) {
        int r = it;
        if (r < I_IN) { transpose_item(a.w_in, D, NIN, (bf16*)(a.ws + WS_WIN), scr, r, F.lane); continue; } r -= I_IN;
        if (r < I_OUT) { transpose_item(a.w_out, D, D, (bf16*)(a.ws + WS_WOUT), scr, r, F.lane); continue; } r -= I_OUT;
        transpose_item(a.peer_wq, D, NQ, (bf16*)(a.ws + WS_WQ), scr, r, F.lane);
    }
    const size_t gtid = (size_t)F.bid * NTHREADS + F.tid, gn = (size_t)F.G * NTHREADS;
    cvt_rows(a.peer_keys, (bf16*)(a.ws + WS_KEYS), (size_t)2 * 8 * 128 * 128 / 8, gtid, gn);
    if (F.bid == 0) { for (int i = F.tid; i < 1024; i += NTHREADS) { const int h = i >> 7, dist = i & 127; int bk;
            if (dist < 16) bk = dist; else { bk = 16 + (int)(__logf((float)dist * (1.f / 16.f)) / 2.0794415416798357f * 16.f); bk = bk < 31 ? bk : 31; }
            ((float*)(a.ws + WS_BIAS))[i] = a.rel_bias[bk * 8 + h]; } }
}
template <bool ADD_DELTA>
__device__ __forceinline__ void modnorm_rows(const Args& a, Frame& F, const float* src, const float* g, int sh_off, int sc_off) {
    const int gw = F.bid * NWAVES + F.wave, NGW = F.G * NWAVES;
    const float* mod = (const float*)(a.ws + WS_MOD);
    bf16* H = (bf16*)(a.ws + WS_H);
    for (int m0 = 16 * gw; m0 < T; m0 += 16 * NGW) {
        const float* mb = mod + (size_t)(m0 / SEQ) * 6144;
        f32x4 gam[4], sh[4];
#pragma unroll
        for (int j = 0; j < 4; ++j) { const int col = 4 * F.lane + 256 * j; gam[j] = *(const f32x4*)(g + col) * (*(const f32x4*)(mb + sc_off + col) + 1.f); sh[j] = *(const f32x4*)(mb + sh_off + col); }
#pragma unroll 1
        for (int r0 = 0; r0 < 16; r0 += 4) {
            f32x4 v[4][4]; v2u dl[4][4];
#pragma unroll
            for (int r = 0; r < 4; ++r) { const f32x4* xr = (const f32x4*)(src + (size_t)(m0 + r0 + r) * D) + F.lane;
                const v2u* dr = (const v2u*)((const bf16*)(a.ws + WS_DELTA) + (size_t)(m0 + r0 + r) * D) + F.lane;
#pragma unroll
                for (int j = 0; j < 4; ++j) { v[r][j] = xr[64 * j]; if (ADD_DELTA) dl[r][j] = dr[64 * j]; } }
#pragma unroll
            for (int r = 0; r < 4; ++r) { float s = 0.f;
                if (ADD_DELTA) {
#pragma unroll
                    for (int j = 0; j < 4; ++j) { v[r][j].x += bf_lo(dl[r][j].x); v[r][j].y += bf_hi(dl[r][j].x); v[r][j].z += bf_lo(dl[r][j].y); v[r][j].w += bf_hi(dl[r][j].y); } }
#pragma unroll
                for (int j = 0; j < 4; ++j) s += (v[r][j].x * v[r][j].x + v[r][j].y * v[r][j].y) + (v[r][j].z * v[r][j].z + v[r][j].w * v[r][j].w);
                const float rstd = rsqrtf(wave_sum(s) * (1.f / D) + EPS);
                v2u* o8 = (v2u*)(H + (size_t)(m0 + r0 + r) * D) + F.lane;
                f32x4 y[4]; float am = 0.f;
#pragma unroll
                for (int j = 0; j < 4; ++j) { y[j] = v[r][j] * rstd * gam[j] + sh[j]; v2u w; w.x = pk2(y[j].x, y[j].y); w.y = pk2(y[j].z, y[j].w); o8[64 * j] = w;
                    am = fmaxf(am, fmaxf(fmaxf(fabsf(y[j].x), fabsf(y[j].y)), fmaxf(fabsf(y[j].z), fabsf(y[j].w)))); }
                if (ADD_DELTA) {
#pragma unroll
                    for (int o = 1; o < 64; o <<= 1) am = fmaxf(am, __shfl_xor(am, o));
                    const float st = am > 0.f ? am * (1.f / 7.f) : 1.f, ist = 1.f / st;
                    unsigned char* hp = a.ws + WS_H4 + (size_t)(m0 + r0 + r) * 1024 + 2 * F.lane;
#pragma unroll
                    for (int j = 0; j < 4; ++j) { unsigned w0 = 0u, w1 = 0u;
#pragma unroll
                        for (int c = 0; c < 4; ++c) { const float rr = y[j][c] * ist; const float d0 = fminf(fmaxf(rintf(rr), -7.f), 7.f); const float d1 = fminf(fmaxf(rintf((rr - d0) * 16.f), -8.f), 7.f);
                            w0 |= ((unsigned)(int)d0 & 15u) << (4 * c); w1 |= ((unsigned)(int)d1 & 15u) << (4 * c); }
                        *(unsigned short*)(hp + 128 * j) = (unsigned short)w0; *(unsigned short*)(hp + 512 + 128 * j) = (unsigned short)w1; }
                    if (F.lane == 0) ((float*)(a.ws + WS_ST))[m0 + r0 + r] = st; } }
        }
    }
}

constexpr int KS_STRIDE = 72, VT_STRIDE = 260;
constexpr int ATT_KS = 0, ATT_VT = 256 * KS_STRIDE * 2, ATT_BIAS = ATT_VT + 64 * VT_STRIDE * 2;
__device__ __forceinline__ void attn_unit(const Args& a, Frame& F, int unit, int pv = 0) {
    const int kvh = unit & 1, nb = (unit >> 1) & 31, b = unit >> 6;
    const bf16* PROJ = (const bf16*)(a.ws + WS_PROJ);
    bf16* MIX = (bf16*)(a.ws + WS_MIX);
    LAS bf16* Ks = (LAS bf16*)(F.lds + ATT_KS); LAS bf16* Vt = (LAS bf16*)(F.lds + ATT_VT); LAS float* bl = (LAS float*)(F.lds + ATT_BIAS);
    const int g = F.wave & 3, hq = kvh * 4 + g, hh = F.lane >> 5, l31 = F.lane & 31;
    v4u qraw[2][4];
#pragma unroll
    for (int qq = 0; qq < 2; ++qq) { const int qi = 32 * ((F.wave >> 2) * 2 + qq) + l31; const size_t tok = (size_t)b * SEQ + nb * 128 + qi;
#pragma unroll
        for (int ks = 0; ks < 4; ++ks) qraw[qq][ks] = *(const v4u*)(PROJ + tok * NIN + C_Q + hq * 64 + 16 * ks + 8 * hh); }
    if (pv != 2) {
        const int key = F.tid >> 1, half = F.tid & 1; const bool valid = (nb > 0) || (key >= 128);
        const size_t tok = (size_t)b * SEQ + nb * 128 - 128 + key;
        v4u kr[4], vr[4];
#pragma unroll
        for (int i = 0; i < 4; ++i) { kr[i] = (v4u){0u, 0u, 0u, 0u}; vr[i] = kr[i]; }
        if (valid) {
            const v4u* kp = (const v4u*)(PROJ + tok * NIN + C_K + kvh * 64 + 32 * half);
            const v4u* vp = (const v4u*)(PROJ + tok * NIN + C_V + kvh * 64 + 32 * half);
#pragma unroll
            for (int i = 0; i < 4; ++i) { kr[i] = kp[i]; vr[i] = vp[i]; }
        }
        float ss = 0.f;
#pragma unroll
        for (int i = 0; i < 4; ++i) {
#pragma unroll
            for (int e = 0; e < 4; ++e) { const float lo = bf_lo(kr[i][e]), hi = bf_hi(kr[i][e]); ss += lo * lo + hi * hi; } }
        ss += __shfl_xor(ss, 1);
        const float rstd = rsqrtf(ss * (1.f / 64.f) + EPS);
#pragma unroll
        for (int i = 0; i < 4; ++i) { v4u o;
#pragma unroll
            for (int e = 0; e < 4; ++e) { const int d = 32 * half + 8 * i + 2 * e;
                o[e] = pk2(bf_lo(kr[i][e]) * rstd * a.k_norm_g[d], bf_hi(kr[i][e]) * rstd * a.k_norm_g[d + 1]); }
            *(LAS v4u*)(Ks + key * KS_STRIDE + 32 * half + 8 * i) = o; }
#pragma unroll
        for (int i = 0; i < 4; ++i)
#pragma unroll
            for (int e = 0; e < 4; ++e) { const int d = 32 * half + 8 * i + 2 * e;
                Vt[d * VT_STRIDE + key] = (bf16)(vr[i][e] & 0xffffu); Vt[(d + 1) * VT_STRIDE + key] = (bf16)(vr[i][e] >> 16); }
        { const int g = F.tid >> 7, dist = F.tid & 127; bl[F.tid] = ((const float*)(a.ws + WS_BIAS))[(kvh * 4 + g) * 128 + dist]; }
        if (F.tid < 64) bl[512 + F.tid] = a.q_norm_g[F.tid]; else if (F.tid < 128) bl[512 + F.tid] = a.k_norm_g[F.tid - 64]; else if (F.tid < 384) bl[512 + F.tid] = a.attn_out_g[kvh * 256 + (F.tid - 128)];
    }
    __syncthreads();
    const float sink = a.sinks[hq];
#pragma unroll 1
    for (int qq = 0; qq < (pv == 1 ? 0 : 2); ++qq) {
        const int qt = (F.wave >> 2) * 2 + qq, qi = 32 * qt + l31;
        const size_t tok = (size_t)b * SEQ + nb * 128 + qi;
        bf16x8 qf[4];
        {
            v4u qr[4]; float ss = 0.f;
#pragma unroll
            for (int ks = 0; ks < 4; ++ks) { qr[ks] = qq ? qraw[1][ks] : qraw[0][ks];
#pragma unroll
                for (int e = 0; e < 4; ++e) { const float lo = bf_lo(qr[ks][e]), hi = bf_hi(qr[ks][e]); ss += lo * lo + hi * hi; } }
            ss += __shfl_xor(ss, 32);
            const float rstd = rsqrtf(ss * (1.f / 64.f) + EPS) * 0.125f;
#pragma unroll
            for (int ks = 0; ks < 4; ++ks) { v4u o;
#pragma unroll
                for (int e = 0; e < 4; ++e) { const int d = 16 * ks + 8 * hh + 2 * e;
                    o[e] = pk2(bf_lo(qr[ks][e]) * rstd * bl[512 + d], bf_hi(qr[ks][e]) * rstd * bl[512 + d + 1]); }
                qf[ks] = __builtin_bit_cast(bf16x8, o); }
        }
        f32x16 s[5];
#pragma unroll
        for (int k5 = 0; k5 < 5; ++k5) { const int kt = qt + k5;
            f32x16 acc;
#pragma unroll
            for (int r = 0; r < 16; ++r) acc[r] = 0.f;
#pragma unroll
            for (int ks = 0; ks < 4; ++ks) { const bf16x8 kf = *(const LAS bf16x8*)(Ks + (32 * kt + l31) * KS_STRIDE + 16 * ks + 8 * hh);
                acc = __builtin_amdgcn_mfma_f32_32x32x16_bf16(kf, qf[ks], acc, 0, 0, 0); }
            s[k5] = acc; }
        float mx = -INFINITY;
#pragma unroll
        for (int k5 = 0; k5 < 5; ++k5) { const float pen_tile = (nb == 0 && (qt + k5) < 4) ? -INFINITY : 0.f;
#pragma unroll
            for (int r = 0; r < 16; ++r) { const int kj = 32 * (qt + k5) + (r & 3) + 8 * (r >> 2) + 4 * hh; const int dist = qi + 128 - kj;
                float v = s[k5][r] + bl[g * 128 + (dist & 127)] + pen_tile;
                if (k5 == 0) v += (dist > 127) ? -INFINITY : 0.f;
                if (k5 == 4) v += (dist < 0) ? -INFINITY : 0.f;
                s[k5][r] = v; mx = fmaxf(mx, v); } }
        mx = fmaxf(mx, __shfl_xor(mx, 32)); mx = fmaxf(mx, sink);
        float ls = 0.f;
#pragma unroll
        for (int k5 = 0; k5 < 5; ++k5)
#pragma unroll
            for (int r = 0; r < 16; ++r) { const float p = __expf(s[k5][r] - mx); s[k5][r] = p; ls += p; }
        ls += __shfl_xor(ls, 32);
        const float inv = 1.f / (ls + __expf(sink - mx));
        f32x16 o[2];
#pragma unroll
        for (int dt = 0; dt < 2; ++dt)
#pragma unroll
            for (int r = 0; r < 16; ++r) o[dt][r] = 0.f;
#pragma unroll
        for (int k5 = 0; k5 < 5; ++k5)
#pragma unroll
            for (int s2 = 0; s2 < 2; ++s2) { const int kt = qt + k5;
                v4u pw; pw.x = pk2(s[k5][8 * s2 + 0], s[k5][8 * s2 + 1]); pw.y = pk2(s[k5][8 * s2 + 2], s[k5][8 * s2 + 3]); pw.z = pk2(s[k5][8 * s2 + 4], s[k5][8 * s2 + 5]); pw.w = pk2(s[k5][8 * s2 + 6], s[k5][8 * s2 + 7]);
                const bf16x8 pf = __builtin_bit_cast(bf16x8, pw);
#pragma unroll
                for (int dt = 0; dt < 2; ++dt) { const LAS bf16* vp = Vt + (32 * dt + l31) * VT_STRIDE + 32 * kt + 16 * s2 + 4 * hh;
                    const v2u v0 = *(const LAS v2u*)vp, v1 = *(const LAS v2u*)(vp + 8);
                    v4u vw; vw.x = v0.x; vw.y = v0.y; vw.z = v1.x; vw.w = v1.y;
                    o[dt] = __builtin_amdgcn_mfma_f32_32x32x16_bf16(__builtin_bit_cast(bf16x8, vw), pf, o[dt], 0, 0, 0); } }
        float ss = 0.f;
#pragma unroll
        for (int dt = 0; dt < 2; ++dt)
#pragma unroll
            for (int r = 0; r < 16; ++r) { o[dt][r] *= inv; ss += o[dt][r] * o[dt][r]; }
        ss += __shfl_xor(ss, 32);
        const float rstd = rsqrtf(ss * (1.f / 64.f) + EPS);
#pragma unroll
        for (int dt = 0; dt < 2; ++dt)
#pragma unroll
            for (int rq = 0; rq < 4; ++rq) { const int d = 32 * dt + 8 * rq + 4 * hh; const f32x4 gg = *(const LAS f32x4*)(bl + 640 + g * 64 + d);
                v2u w; w.x = pk2(o[dt][4 * rq + 0] * rstd * gg.x, o[dt][4 * rq + 1] * rstd * gg.y); w.y = pk2(o[dt][4 * rq + 2] * rstd * gg.z, o[dt][4 * rq + 3] * rstd * gg.w);
                *(v2u*)(MIX + tok * D + 512 + hq * 64 + d) = w; }
    }
    __syncthreads();
}
__device__ __forceinline__ void unpack8(const v4u r, float (&f)[8]) {
#pragma unroll
    for (int e = 0; e < 4; ++e) { f[2 * e] = bf_lo(r[e]); f[2 * e + 1] = bf_hi(r[e]); }
}
__device__ __forceinline__ void conv_unit(const Args& a, Frame& F, int unit) {
    const int nb = unit & 31, b = unit >> 5;
    const bf16* PROJ = (const bf16*)(a.ws + WS_PROJ);
    bf16* MIX = (bf16*)(a.ws + WS_MIX);
    const int ch = 8 * F.lane, pos0 = nb * 128 + 16 * F.wave;
    const size_t tok0 = (size_t)b * SEQ + pos0;
    float w0[8], w1[8], w2[8], gg[8], um2[8], um1[8];
#pragma unroll
    for (int e = 0; e < 8; ++e) { w0[e] = a.conv_w[ch + e]; w1[e] = a.conv_w[512 + ch + e]; w2[e] = a.conv_w[1024 + ch + e]; gg[e] = a.conv_out_g[ch + e]; um2[e] = 0.f; um1[e] = 0.f; }
    if (pos0 >= 2) {
        float c[8], h[8];
        unpack8(*(const v4u*)(PROJ + (tok0 - 2) * NIN + C_C + ch), c); unpack8(*(const v4u*)(PROJ + (tok0 - 2) * NIN + C_H + ch), h);
#pragma unroll
        for (int e = 0; e < 8; ++e) um2[e] = c[e] * h[e];
        unpack8(*(const v4u*)(PROJ + (tok0 - 1) * NIN + C_C + ch), c); unpack8(*(const v4u*)(PROJ + (tok0 - 1) * NIN + C_H + ch), h);
#pragma unroll
        for (int e = 0; e < 8; ++e) um1[e] = c[e] * h[e];
    }
#pragma unroll 1
    for (int i0 = 0; i0 < 16; i0 += 4) {
        v4u rb[4], rc[4], rh[4];
#pragma unroll
        for (int i = 0; i < 4; ++i) { const size_t tok = tok0 + i0 + i; rb[i] = *(const v4u*)(PROJ + tok * NIN + C_B + ch); rc[i] = *(const v4u*)(PROJ + tok * NIN + C_C + ch); rh[i] = *(const v4u*)(PROJ + tok * NIN + C_H + ch); }
#pragma unroll
        for (int i = 0; i < 4; ++i) { const size_t tok = tok0 + i0 + i;
            float bg[8], c[8], h[8], y[8]; float ss = 0.f;
            unpack8(rb[i], bg); unpack8(rc[i], c); unpack8(rh[i], h);
#pragma unroll
            for (int e = 0; e < 8; ++e) { const float u0 = c[e] * h[e]; y[e] = bg[e] * (w0[e] * um2[e] + w1[e] * um1[e] + w2[e] * u0); ss += y[e] * y[e]; um2[e] = um1[e]; um1[e] = u0; }
            ss += __shfl_xor(ss, 1); ss += __shfl_xor(ss, 2); ss += __shfl_xor(ss, 4);
            const float rstd = rsqrtf(ss * (1.f / 64.f) + EPS);
            v4u o;
#pragma unroll
            for (int e = 0; e < 4; ++e) o[e] = pk2(y[2 * e] * rstd * gg[2 * e], y[2 * e + 1] * rstd * gg[2 * e + 1]);
            *(v4u*)(MIX + tok * D + ch) = o; }
    }
}

#define CE_DESC(x, y) do { const unsigned _hi = (x) > (y) ? (x) : (y), _lo = (x) > (y) ? (y) : (x); (x) = _hi; (y) = _lo; } while (0)
__device__ __forceinline__ void sort16_desc(unsigned (&v)[16]) {
#define S16(i, j) CE_DESC(v[i], v[j]);
    S16(0, 1) S16(2, 3) S16(0, 2) S16(1, 3) S16(1, 2) S16(4, 5) S16(6, 7) S16(4, 6) S16(5, 7) S16(5, 6) S16(0, 4) S16(2, 6) S16(2, 4) S16(1, 5) S16(3, 7) S16(3, 5) S16(1, 2) S16(3, 4) S16(5, 6)
    S16(8, 9) S16(10, 11) S16(8, 10) S16(9, 11) S16(9, 10) S16(12, 13) S16(14, 15) S16(12, 14) S16(13, 15) S16(13, 14) S16(8, 12) S16(10, 14) S16(10, 12) S16(9, 13) S16(11, 15) S16(11, 13) S16(9, 10) S16(11, 12) S16(13, 14)
    S16(0, 8) S16(4, 12) S16(4, 8) S16(2, 10) S16(6, 14) S16(6, 10) S16(2, 4) S16(6, 8) S16(10, 12) S16(1, 9) S16(5, 13) S16(5, 9) S16(3, 11) S16(7, 15) S16(7, 11) S16(3, 5) S16(7, 9) S16(11, 13)
    S16(1, 2) S16(3, 4) S16(5, 6) S16(7, 8) S16(9, 10) S16(11, 12) S16(13, 14)
#undef S16
}
__device__ __forceinline__ void merge16_desc(unsigned (&x)[16], const unsigned (&y)[16]) {
#pragma unroll
    for (int i = 0; i < 16; ++i) x[i] = x[i] > y[15 - i] ? x[i] : y[15 - i];
#pragma unroll
    for (int j = 8; j > 0; j >>= 1)
#pragma unroll
        for (int i = 0; i < 16; ++i) if ((i & j) == 0) CE_DESC(x[i], x[i | j]);
}
constexpr int KEY_LDS_STRIDE = 136;
__device__ __forceinline__ void side_top16(const bf16* QP, const LAS bf16* KL, int tok0, int h, int s, int lane, unsigned (&top)[16]) {
    const int l31 = lane & 31, hh = lane >> 5;
    bf16x8 qf[8];
    const bf16* qp = QP + (size_t)(tok0 + l31) * NQ + h * 256 + s * 128 + 8 * hh;
#pragma unroll
    for (int ks = 0; ks < 8; ++ks) qf[ks] = *(const bf16x8*)(qp + 16 * ks);
    const LAS bf16* kp = KL + (s * 128 + l31) * KEY_LDS_STRIDE + 8 * hh;
#define SIDE_TILE(kt, dst) do { f32x16 acc; \
        _Pragma("unroll") for (int r = 0; r < 16; ++r) acc[r] = 0.f; \
        _Pragma("unroll") for (int ks = 0; ks < 8; ++ks) { const bf16x8 kf = *(const LAS bf16x8*)(kp + (32 * (kt)) * KEY_LDS_STRIDE + 16 * ks); \
            acc = __builtin_amdgcn_mfma_f32_32x32x16_bf16(kf, qf[ks], acc, 0, 0, 0); } \
        _Pragma("unroll") for (int r = 0; r < 16; ++r) { const int nn = 32 * (kt) + (r & 3) + 8 * (r >> 2) + 4 * hh; \
            int fx = (int)__builtin_fmaf(acc[r], 524288.f, 16777216.f); fx = fx < 0 ? 0 : (fx > (1 << 25) - 1 ? (1 << 25) - 1 : fx); \
            dst[r] = ((unsigned)fx << 7) | (unsigned)(127 - nn); } \
        sort16_desc(dst); } while (0)
    SIDE_TILE(0, top);
#pragma unroll 1
    for (int kt = 1; kt < 4; ++kt) { unsigned v[16]; SIDE_TILE(kt, v); merge16_desc(top, v); }
#undef SIDE_TILE
    unsigned oth[16];
#pragma unroll
    for (int i = 0; i < 16; ++i) oth[i] = (unsigned)__shfl_xor((int)top[i], 32);
    merge16_desc(top, oth);
}
__device__ __forceinline__ void topk_unit(const Args& a, Frame& F, int tile, int h) {
    const int tok0 = tile * 32;
    const bf16* QP = (const bf16*)(a.ws + WS_PROJ); const LAS bf16* KL = (const LAS bf16*)F.lds;
    unsigned ka[16], kb[16];
    side_top16(QP, KL, tok0, h, 0, F.lane, ka);
    side_top16(QP, KL, tok0, h, 1, F.lane, kb);
    unsigned c[4][16];
    int n = 0;
#pragma unroll
    for (int i = 0; i < 16; ++i)
#pragma unroll
        for (int j = 0; j < 16; ++j) if ((i + 1) * (j + 1) <= 16) {
            int sfx = (int)(ka[i] >> 7) + (int)(kb[j] >> 7) - (1 << 25);
            sfx = sfx < 0 ? 0 : (sfx > (1 << 23) - 1 ? (1 << 23) - 1 : sfx);
            const unsigned e = (127u - (ka[i] & 127u)) * 128u + (127u - (kb[j] & 127u));
            c[n >> 4][n & 15] = ((unsigned)(sfx >> 5) << 14) | (16383u - e); ++n; }
#pragma unroll
    for (; n < 64; ++n) c[n >> 4][n & 15] = 0u;
    sort16_desc(c[0]); sort16_desc(c[1]); sort16_desc(c[2]); CE_DESC(c[3][0], c[3][1]);
    merge16_desc(c[0], c[1]); merge16_desc(c[2], c[3]); merge16_desc(c[0], c[2]);
    float w[16]; float sum = 0.f; const float f0 = (float)(c[0][0] >> 14);
#pragma unroll
    for (int k = 0; k < 16; ++k) { w[k] = __expf(((float)(c[0][k] >> 14) - f0) * (1.f / 16384.f)); sum += w[k]; }
    const float inv = 1.f / sum;
    const int tok = tok0 + (F.lane & 31), hh = F.lane >> 5;
    int* ei = (int*)(a.ws + WS_EIDX) + (size_t)tok * 128 + h * 16 + 8 * hh;
    float* gt = (float*)(a.ws + WS_GATE) + (size_t)tok * 128 + h * 16 + 8 * hh;
    v4u e0, e1; f32x4 g0, g1;
#pragma unroll
    for (int k = 0; k < 4; ++k) { const unsigned x0 = hh ? c[0][8 + k] : c[0][k], x1 = hh ? c[0][12 + k] : c[0][4 + k];
        e0[k] = 16383u - (x0 & 16383u); e1[k] = 16383u - (x1 & 16383u);
        g0[k] = (hh ? w[8 + k] : w[k]) * inv; g1[k] = (hh ? w[12 + k] : w[4 + k]) * inv; }
    *(v4u*)ei = e0; *(v4u*)(ei + 4) = e1; *(f32x4*)gt = g0; *(f32x4*)(gt + 4) = g1;
}

__device__ __forceinline__ float gelu_tanh(float x) {
    const float u = 0.7978845608028654f * (x + 0.044715f * x * x * x);
    const float t = 1.f - 2.f / (1.f + __expf(2.f * u));
    return 0.5f * x * (1.f + t);
}
__device__ __forceinline__ void peer_coef(const Args& a, Frame& F) {
    const int gw = F.bid * NWAVES + F.wave, NGW = F.G * NWAVES, lane = F.lane;
    const float* SU = (const float*)(a.ws + WS_SU); const float* SV = (const float*)(a.ws + WS_SV);
    for (int t0 = 4 * gw; t0 < T; t0 += 4 * NGW) {
        float s0[4], s1[4], st[4]; int2 e[4]; float2 g[4]; float su0[4], su1[4], sv0[4], sv1[4];
#pragma unroll
        for (int k = 0; k < 4; ++k) { const int tok = t0 + k;
            const float* pp = (const float*)(a.ws + WS_PART) + (size_t)tok * 512 + 2 * lane;
            float2 p0 = *(const float2*)pp, p1 = *(const float2*)(pp + 128), p2 = *(const float2*)(pp + 256), p3 = *(const float2*)(pp + 384);
            s0[k] = (p0.x + p1.x) + (p2.x + p3.x); s1[k] = (p0.y + p1.y) + (p2.y + p3.y);
            e[k] = *(const int2*)((const int*)(a.ws + WS_EIDX) + (size_t)tok * 128 + 2 * lane);
            g[k] = *(const float2*)((const float*)(a.ws + WS_GATE) + (size_t)tok * 128 + 2 * lane);
            st[k] = ((const float*)(a.ws + WS_ST))[tok]; }
#pragma unroll
        for (int k = 0; k < 4; ++k) { su0[k] = SU[e[k].x]; su1[k] = SU[e[k].y]; sv0[k] = SV[e[k].x]; sv1[k] = SV[e[k].y]; }
#pragma unroll
        for (int k = 0; k < 4; ++k) { const int tok = t0 + k;
            const float r0 = g[k].x * gelu_tanh(s0[k] * (su0[k] * st[k])) * sv0[k], r1 = g[k].y * gelu_tanh(s1[k] * (su1[k] * st[k])) * sv1[k];
            if (!V_MFMA) {
                uint2 w; w.x = ((__float_as_uint(r0) + 0x2000u) & 0xffffc000u) | (unsigned)e[k].x; w.y = ((__float_as_uint(r1) + 0x2000u) & 0xffffc000u) | (unsigned)e[k].y;
                *(uint2*)((unsigned*)(a.ws + WS_PACK) + (size_t)tok * 128 + 2 * lane) = w; }
            if (V_MFMA) {
                float am = fmaxf(fabsf(r0), fabsf(r1));
#pragma unroll
                for (int o = 1; o < 64; o <<= 1) am = fmaxf(am, __shfl_xor(am, o));
                const float cs = am > 0.f ? am * (1.f / 4.5f) : 1.f, ics = 1.f / cs;
                float ra = r0 * ics, rb = r1 * ics;
                unsigned char* cp = a.ws + WS_CP + (size_t)tok * 256 + lane;
#pragma unroll
                for (int pl = 0; pl < 4; ++pl) { const float da = fminf(fmaxf(rintf(ra), -4.f), 4.f), db = fminf(fmaxf(rintf(rb), -4.f), 4.f);
                    cp[64 * pl] = (unsigned char)__builtin_amdgcn_cvt_scalef32_pk_fp4_f32(0u, da, db, 1.0f, 0);
                    ra = (ra - da) * 8.f; rb = (rb - db) * 8.f; }
                if (lane == 0) ((float*)(a.ws + WS_CS))[tok] = cs; }
        }
    }
}
typedef float f32x2 __attribute__((ext_vector_type(2)));
__device__ __forceinline__ float dpp_sum8(float s) {
    s += __builtin_bit_cast(float, __builtin_amdgcn_update_dpp(0, __builtin_bit_cast(int, s), 0xB1, 0xF, 0xF, true));
    s += __builtin_bit_cast(float, __builtin_amdgcn_update_dpp(0, __builtin_bit_cast(int, s), 0x4E, 0xF, 0xF, true));
    s += __builtin_bit_cast(float, __builtin_amdgcn_update_dpp(0, __builtin_bit_cast(int, s), 0x141, 0xF, 0xF, true));
    return s;
}
struct PTok { v4u vr[16]; v4u aux[4]; f32x4 xo, xg; };
template <bool VSIDE>
__device__ __forceinline__ void peer_issue(const unsigned char* TB, unsigned poff, const v4u (&w)[4], PTok& P, const unsigned char* sidep, const float* xop, const float* xgp) {
#pragma unroll
    for (int i = 0; i < 16; ++i) { const unsigned id = w[i >> 2][i & 3] & 0x3fffu; P.vr[i] = *(const v4u*)(TB + (id * 128u + poff)); }
    if (VSIDE) { P.xo = *(const f32x4*)xop; P.xg = *(const f32x4*)xgp; P.aux[0].x = ((const unsigned*)sidep)[0]; P.aux[0].y = ((const unsigned*)sidep)[1]; }
    else { (void)sidep; }
}
template <bool VSIDE>
__device__ __forceinline__ void peer_compute(const PTok& P, const v4u (&w)[4], int lane, float* outp) {
    const int p = lane & 7;
    if (VSIDE) {
        f32x2 acc2[16];
#pragma unroll
        for (int j = 0; j < 16; ++j) acc2[j] = (f32x2){0.f, 0.f};
#pragma unroll
        for (int i = 0; i < 16; ++i) {
            const v2u cpair = (i & 2) ? (v2u){w[i >> 2].z, w[i >> 2].w} : (v2u){w[i >> 2].x, w[i >> 2].y};
#pragma unroll
            for (int q = 0; q < 4; ++q) { const unsigned wd = P.vr[i][q];
                const f32x2 f0 = __builtin_amdgcn_cvt_scalef32_pk_f32_fp4(wd, 1.0f, 0), f1 = __builtin_amdgcn_cvt_scalef32_pk_f32_fp4(wd, 1.0f, 1), f2 = __builtin_amdgcn_cvt_scalef32_pk_f32_fp4(wd, 1.0f, 2), f3 = __builtin_amdgcn_cvt_scalef32_pk_f32_fp4(wd, 1.0f, 3);
                if (i & 1) {
                    asm volatile("v_pk_fma_f32 %0, %1, %2, %0 op_sel:[0,1,0] op_sel_hi:[1,1,1]" : "+v"(acc2[4 * q]) : "v"(f0), "v"(cpair));
                    asm volatile("v_pk_fma_f32 %0, %1, %2, %0 op_sel:[0,1,0] op_sel_hi:[1,1,1]" : "+v"(acc2[4 * q + 1]) : "v"(f1), "v"(cpair));
                    asm volatile("v_pk_fma_f32 %0, %1, %2, %0 op_sel:[0,1,0] op_sel_hi:[1,1,1]" : "+v"(acc2[4 * q + 2]) : "v"(f2), "v"(cpair));
                    asm volatile("v_pk_fma_f32 %0, %1, %2, %0 op_sel:[0,1,0] op_sel_hi:[1,1,1]" : "+v"(acc2[4 * q + 3]) : "v"(f3), "v"(cpair));
                } else {
                    asm volatile("v_pk_fma_f32 %0, %1, %2, %0 op_sel_hi:[1,0,1]" : "+v"(acc2[4 * q]) : "v"(f0), "v"(cpair));
                    asm volatile("v_pk_fma_f32 %0, %1, %2, %0 op_sel_hi:[1,0,1]" : "+v"(acc2[4 * q + 1]) : "v"(f1), "v"(cpair));
                    asm volatile("v_pk_fma_f32 %0, %1, %2, %0 op_sel_hi:[1,0,1]" : "+v"(acc2[4 * q + 2]) : "v"(f2), "v"(cpair));
                    asm volatile("v_pk_fma_f32 %0, %1, %2, %0 op_sel_hi:[1,0,1]" : "+v"(acc2[4 * q + 3]) : "v"(f3), "v"(cpair));
                } } }
        float acc[32];
#pragma unroll
        for (int j = 0; j < 16; ++j) { acc[2 * j] = acc2[j].x; acc[2 * j + 1] = acc2[j].y; }
        const int b5 = (lane >> 5) & 1, b4 = (lane >> 4) & 1, b3 = (lane >> 3) & 1;
        float v1[16], v2[8], v3[4];
#pragma unroll
        for (int j = 0; j < 16; ++j) { const v2u r = __builtin_amdgcn_permlane32_swap(__float_as_uint(acc[j]), __float_as_uint(acc[16 + j]), false, false);
            v1[j] = __uint_as_float(r.x) + __uint_as_float(r.y); }
#pragma unroll
        for (int j = 0; j < 8; ++j) { const v2u r = __builtin_amdgcn_permlane16_swap(__float_as_uint(v1[j]), __float_as_uint(v1[8 + j]), false, false);
            v2[j] = __uint_as_float(r.x) + __uint_as_float(r.y); }
#pragma unroll
        for (int j = 0; j < 4; ++j) { const float kp = b3 ? v2[4 + j] : v2[j], sd = b3 ? v2[j] : v2[4 + j];
            v3[j] = kp + __builtin_bit_cast(float, __builtin_amdgcn_update_dpp(0, __builtin_bit_cast(int, sd), 0x128, 0xF, 0xF, true)); }
        f32x4 o; o.x = (P.xo.x + bf_lo(P.aux[0].x)) + P.xg.x * v3[0]; o.y = (P.xo.y + bf_hi(P.aux[0].x)) + P.xg.y * v3[1]; o.z = (P.xo.z + bf_lo(P.aux[0].y)) + P.xg.z * v3[2]; o.w = (P.xo.w + bf_hi(P.aux[0].y)) + P.xg.w * v3[3]; *(f32x4*)outp = o;
    } else {
        f32x2 keep = {0.f, 0.f};
#pragma unroll
        for (int i = 0; i < 16; ++i) { int s0 = 0, s1 = 0;
#pragma unroll
            for (int q = 0; q < 4; ++q) { s0 = __builtin_amdgcn_sdot8((int)P.vr[i][q], (int)P.aux[0][q], s0, false); s1 = __builtin_amdgcn_sdot8((int)P.vr[i][q], (int)P.aux[1][q], s1, false); }
            const float dt = dpp_sum8((float)s0 + (float)s1 * 0.0625f);
            if ((i >> 1) == p) { if (i & 1) keep.y = dt; else keep.x = dt; } }
        *(f32x2*)outp = keep;
    }
}
template <bool VSIDE>
__device__ __forceinline__ void peer_slice(const Args& a, Frame& F) {
    const int x = F.sl_x, wx = F.sl_rank * NWAVES + F.wave, nwx = F.sl_n * NWAVES;
    if (wx >= T) return;
    const int lane = F.lane, eg = lane >> 3, p = lane & 7;
    const unsigned char* TB = a.ws + (VSIDE ? WS_V : WS_U) + (size_t)x * (2 * MiB); const unsigned poff = 16u * (unsigned)p;
    const unsigned* Wb = (const unsigned*)(a.ws + (VSIDE ? WS_PACK : WS_EIDX)) + 16 * eg;
    const unsigned char* Hb = a.ws + WS_H4 + 128 * x + 16 * p;
    const int dcol = 256 * x + 32 * p + 16 * ((lane >> 5) & 1) + 8 * ((lane >> 4) & 1) + 4 * ((lane >> 3) & 1);
    const float* G2 = (const float*)(a.ws + WS_MOD) + 5120 + dcol;
    float* PART = (float*)(a.ws + WS_PART) + (size_t)x * 128 + 16 * eg + 2 * p;
    const float* X1 = a.x;
    const unsigned char* DLb = a.ws + WS_DELTA + 2 * dcol;
    v4u nA[4], nB[4];
    int tA = wx, tB = wx + nwx;
#define PS_LDW(dst, tok) do { const unsigned* _w = Wb + (size_t)((tok) < T ? (tok) : T - 1) * 128; _Pragma("unroll") for (int _q = 0; _q < 4; ++_q) dst[_q] = *(const v4u*)(_w + 4 * _q); } while (0)
    PS_LDW(nA, tA); PS_LDW(nB, tB);
    v4u hA[2], hB[2];
    if (!VSIDE) { const int tb0 = tB < T ? tB : tA; hA[0] = *(const v4u*)(Hb + (size_t)tA * 1024); hA[1] = *(const v4u*)(Hb + (size_t)tA * 1024 + 512); hB[0] = *(const v4u*)(Hb + (size_t)tb0 * 1024); hB[1] = *(const v4u*)(Hb + (size_t)tb0 * 1024 + 512); }
#pragma unroll 1
    for (; tA < T; tA += 2 * nwx, tB += 2 * nwx) {
        const int tBc = tB < T ? tB : tA;
        v4u wA[4], wB[4];
#pragma unroll
        for (int q = 0; q < 4; ++q) { wA[q] = nA[q]; wB[q] = nB[q]; }
        PTok A, B;
        peer_issue<VSIDE>(TB, poff, wA, A, VSIDE ? DLb + (size_t)tA * 2048 : Hb + (size_t)tA * 1024, X1 + (size_t)tA * D + dcol, G2 + (size_t)(tA / SEQ) * 6144);
        peer_issue<VSIDE>(TB, poff, wB, B, VSIDE ? DLb + (size_t)tBc * 2048 : Hb + (size_t)tBc * 1024, X1 + (size_t)tBc * D + dcol, G2 + (size_t)(tBc / SEQ) * 6144);
        if (!VSIDE) {
            A.aux[0] = hA[0]; A.aux[1] = hA[1]; B.aux[0] = hB[0]; B.aux[1] = hB[1];
            { const int t2 = tA + 2 * nwx < T ? tA + 2 * nwx : T - 1, t3 = tB + 2 * nwx < T ? tB + 2 * nwx : T - 1;
              hA[0] = *(const v4u*)(Hb + (size_t)t2 * 1024); hA[1] = *(const v4u*)(Hb + (size_t)t2 * 1024 + 512); hB[0] = *(const v4u*)(Hb + (size_t)t3 * 1024); hB[1] = *(const v4u*)(Hb + (size_t)t3 * 1024 + 512); }
            PS_LDW(nA, tA + 2 * nwx); PS_LDW(nB, tB + 2 * nwx); }
        peer_compute<VSIDE>(A, wA, lane, VSIDE ? a.out + (size_t)tA * D + dcol : PART + (size_t)tA * 512);
        if (VSIDE) { PS_LDW(nA, tA + 2 * nwx); PS_LDW(nB, tB + 2 * nwx); }
        if (tB < T) peer_compute<VSIDE>(B, wB, lane, VSIDE ? a.out + (size_t)tB * D + dcol : PART + (size_t)tB * 512);
    }
#undef PS_LDW
}

struct VTok { v4u vr[16]; };
struct VStr { v4u aw; f32x4 xo, xg; v2u dl; float cs; };
__device__ __forceinline__ void vmfma_issue(const unsigned char* TB, unsigned poff, const v4u (&w)[4], VTok& P) {
#pragma unroll
    for (int i = 0; i < 16; ++i) { const unsigned id = w[i >> 2][i & 3]; P.vr[i] = *(const v4u*)(TB + (id * 128u + poff)); }
}
__device__ __forceinline__ void vmfma_stream(VStr& S, const unsigned char* cpp, const float* csp, const float* xop, const float* xgp, const unsigned char* dlp) {
    S.aw = *(const v4u*)cpp; S.cs = *csp; S.xo = __builtin_nontemporal_load((const f32x4*)xop); S.xg = *(const f32x4*)xgp; S.dl = __builtin_nontemporal_load((const v2u*)dlp);
}
__device__ __forceinline__ void vmfma_compute(const VTok& P, const VStr& S, int lane, LAS unsigned char* img, float* outp, int pv = 0) {
    const int eg = lane >> 3, p = lane & 7, n = lane & 15, q = lane >> 4;
    if (pv == 1) { unsigned acc = 0;
#pragma unroll
        for (int i = 0; i < 16; ++i) acc ^= P.vr[i].x ^ P.vr[i].w;
        f32x4 o; o.x = S.xo.x + bf_lo(S.dl.x) + S.xg.x * S.cs; o.y = S.xo.y + (acc == 0x12345u ? 1.f : 0.f); o.z = S.xo.z + __uint_as_float(S.aw.x & 1u); o.w = S.xo.w; *(f32x4*)outp = o; return; }
    asm volatile("s_waitcnt lgkmcnt(0)" ::: "memory");
#pragma unroll
    for (int i = 0; i < 16; ++i) *(LAS v4u*)(img + (16 * eg + i) * 128 + 16 * (p ^ (i & 7))) = P.vr[i];
    asm volatile("s_waitcnt lgkmcnt(0)" ::: "memory");
    const unsigned rowb = (unsigned)(size_t)img + (unsigned)(32 * q + n) * 128u;
    v8i A; A[0] = (int)S.aw.x; A[1] = (int)S.aw.y; A[2] = (int)S.aw.z; A[3] = (int)S.aw.w; A[4] = 0; A[5] = 0; A[6] = 0; A[7] = 0;
    LAS float* scr = (LAS float*)(img + 16384);
#pragma unroll
    for (int hb = 0; hb < 2; ++hb) {
        v2u tr[8][2];
#pragma unroll
        for (int t2 = 0; t2 < 4; ++t2) { const unsigned a0 = rowb + 16u * (unsigned)((4 * hb + t2) ^ (n & 7));
            asm volatile("ds_read_b64_tr_b4 %0, %1" : "=v"(tr[2 * t2][0]) : "v"(a0) : "memory");
            asm volatile("ds_read_b64_tr_b4 %0, %1 offset:2048" : "=v"(tr[2 * t2][1]) : "v"(a0) : "memory");
            asm volatile("ds_read_b64_tr_b4 %0, %1 offset:8" : "=v"(tr[2 * t2 + 1][0]) : "v"(a0) : "memory");
            asm volatile("ds_read_b64_tr_b4 %0, %1 offset:2056" : "=v"(tr[2 * t2 + 1][1]) : "v"(a0) : "memory"); }
        asm volatile("s_waitcnt lgkmcnt(0)" : "+v"(tr[0][0]), "+v"(tr[0][1]), "+v"(tr[1][0]), "+v"(tr[1][1]), "+v"(tr[2][0]), "+v"(tr[2][1]), "+v"(tr[3][0]), "+v"(tr[3][1]), "+v"(tr[4][0]), "+v"(tr[4][1]), "+v"(tr[5][0]), "+v"(tr[5][1]), "+v"(tr[6][0]), "+v"(tr[6][1]), "+v"(tr[7][0]), "+v"(tr[7][1]) :: "memory");
        __builtin_amdgcn_sched_barrier(0);
#pragma unroll
        for (int t = 0; t < 8; ++t) { const int nt = 8 * hb + t; v8i B; B[0] = (int)tr[t][0].x; B[1] = (int)tr[t][0].y; B[2] = (int)tr[t][1].x; B[3] = (int)tr[t][1].y; B[4] = 0; B[5] = 0; B[6] = 0; B[7] = 0;
            f32x4 c = {0.f, 0.f, 0.f, 0.f};
            c = __builtin_amdgcn_mfma_scale_f32_16x16x128_f8f6f4(A, B, c, 4  , 4  , 0, 0, 0, 0);
            const float val = c[0] + c[1] * 0.125f + c[2] * 0.015625f + c[3] * 0.001953125f;
            if (q == 0) scr[16 * nt + n] = val; }
    }
    asm volatile("s_waitcnt lgkmcnt(0)" ::: "memory");
    const f32x4 v = *(const LAS f32x4*)(scr + 4 * lane);
    const float k = S.cs;
    f32x4 o; o.x = (S.xo.x + bf_lo(S.dl.x)) + S.xg.x * (k * v.x); o.y = (S.xo.y + bf_hi(S.dl.x)) + S.xg.y * (k * v.y); o.z = (S.xo.z + bf_lo(S.dl.y)) + S.xg.z * (k * v.z); o.w = (S.xo.w + bf_hi(S.dl.y)) + S.xg.w * (k * v.w);
    __builtin_nontemporal_store(o, (f32x4*)outp);
}
__device__ __forceinline__ void peer_vslice_mfma(const Args& a, Frame& F, int pv = 0) {
    const int x = F.sl_x, wx = F.sl_rank * NWAVES + F.wave, nwx = F.sl_n * NWAVES;
    if (wx >= T) return;
    const int lane = F.lane, eg = lane >> 3, p = lane & 7;
    const unsigned char* TB = a.ws + WS_V + (size_t)x * (2 * MiB); const unsigned poff = 16u * (unsigned)p;
    const unsigned* Wb = (const unsigned*)(a.ws + WS_EIDX) + 16 * eg;
    const unsigned char* CPb = a.ws + WS_CP + ((lane & 15) & 3) * 64 + 16 * (lane >> 4);
    const float* CSb = (const float*)(a.ws + WS_CS);
    const int dcol = 256 * x + 4 * lane;
    const float* G2 = (const float*)(a.ws + WS_MOD) + 5120 + dcol;
    const unsigned char* DLb = a.ws + WS_DELTA + 2 * dcol;
    LAS unsigned char* img = F.lds + F.wave * 17408;
    v4u nA[4], nB[4]; VStr sA, sB;
    int tA = wx, tB = wx + nwx;
#define PS_LDW(dst, tok) do { const unsigned* _w = Wb + (size_t)((tok) < T ? (tok) : T - 1) * 128; _Pragma("unroll") for (int _q = 0; _q < 4; ++_q) dst[_q] = *(const v4u*)(_w + 4 * _q); } while (0)
#define VS_STREAM(S, tok) do { const int _t = (tok) < T ? (tok) : T - 1; vmfma_stream(S, CPb + (size_t)_t * 256, CSb + _t, a.x + (size_t)_t * D + dcol, G2 + (size_t)(_t / SEQ) * 6144, DLb + (size_t)_t * 2048); } while (0)
    PS_LDW(nA, tA); PS_LDW(nB, tB); VS_STREAM(sA, tA); VS_STREAM(sB, tB);
#pragma unroll 1
    for (; tA < T; tA += 2 * nwx, tB += 2 * nwx) {
        VTok A, B;
        vmfma_issue(TB, poff, nA, A);
        vmfma_issue(TB, poff, nB, B);
        const VStr cA = sA, cB = sB;
        VS_STREAM(sA, tA + 2 * nwx); VS_STREAM(sB, tB + 2 * nwx);
        vmfma_compute(A, cA, lane, img, a.out + (size_t)tA * D + dcol, pv);
        PS_LDW(nA, tA + 2 * nwx); PS_LDW(nB, tB + 2 * nwx);
        if (tB < T) vmfma_compute(B, cB, lane, img, a.out + (size_t)tB * D + dcol, pv);
    }
#undef VS_STREAM
#undef PS_LDW
}

constexpr int N_PHASES = 11;
__global__ void __launch_bounds__(NTHREADS, 2) fwd_kernel(Args a) {
    extern __shared__ __attribute__((aligned(16))) unsigned char lds_raw[];
    Frame F; F.lds = (LAS unsigned char*)lds_raw; F.tid = threadIdx.x; F.lane = F.tid & 63; F.wave = __builtin_amdgcn_readfirstlane(F.tid >> 6); F.G = gridDim.x; F.bid = blockIdx.x;
    const int lo = a.ph_lo, hi = a.ph_hi;
    F.sl_x = F.bid & 3; F.sl_rank = F.bid >> 2; F.sl_n = (F.G - F.sl_x + 3) >> 2;
    unsigned* ctl = (unsigned*)(a.ws + WS_CTL);
    const bool census = (lo == 0 && hi == N_PHASES);
    int my_xcc = 0, my_rank = 0;
    XcdBarrier xbar; xbar.bar = ctl + 4096; xbar.x = 0; xbar.st = (volatile LAS unsigned*)(F.lds + LDS_BYTES - 32);
    if (census) {
        if (F.tid == 0) { xbar.st[0] = 0u; xbar.st[1] = 0u; }
        __syncthreads();
        xbar = xcd_barrier_post(ctl + 4096, (volatile LAS unsigned*)(F.lds + LDS_BYTES - 32));
    }
    if (census) {
        LAS volatile unsigned* top = (LAS volatile unsigned*)(F.lds + LDS_BYTES - 64);
        if (F.tid == 0) { const unsigned xcc = (unsigned)__builtin_amdgcn_s_getreg((3 << 11) | 20) & 7u;
            top[0] = xcc; top[1] = __hip_atomic_fetch_add(ctl + 64 * xcc, 1u, __ATOMIC_RELAXED, __HIP_MEMORY_SCOPE_AGENT); }
        __syncthreads();
        my_xcc = __builtin_amdgcn_readfirstlane((int)top[0]); my_rank = __builtin_amdgcn_readfirstlane((int)top[1]);
    }
#ifndef PH_MASK
#define PH_MASK 0x7ff
#endif
#define REPS(k) ((REP_PH == (k)) ? REP_N : 0)
#define IN(k) (((PH_MASK >> (k)) & 1) && lo <= (k) && (k) < hi)
#define SEAM(k) do { if (IN(k) && IN((k) + 1)) { if ((k) == 0 && USE_CG_SYNC) cg::this_grid().sync(); else xcd_barrier(xbar); } } while (0)
    const float* mod = (const float*)(a.ws + WS_MOD);
    for (int rep = 0; rep <= REPS(0); ++rep) if (IN(0)) { if (rep) xcd_barrier(xbar); for (int it = F.bid; it < 192; it += F.G) mod_item(a, F, it); prep_rest(a, F); }
    SEAM(0);
    for (int rep = 0; rep <= REPS(1); ++rep) if (IN(1)) { if (rep) xcd_barrier(xbar); modnorm_rows<false>(a, F, a.x, a.norm1_g, 0, 1024); }
    SEAM(1);
    for (int rep = 0; rep <= REPS(2); ++rep) if (IN(2)) { if (rep) xcd_barrier(xbar);
        pg8::Gemm g{(const bf16*)(a.ws + WS_H), (const bf16*)(a.ws + WS_WIN), T, NIN, D}; pg8::StaticOrder S; S.init(T, NIN, F.G, F.bid);
        pg8::EpiBf16 E{(bf16*)(a.ws + WS_PROJ), NIN};
        pg8::gemm_phase<pg8::EpiBf16, pg8::StaticOrder, true, true>(F.lds, g, S, E);
        const int extra = S.nwg % F.G;
        if (extra == 0) quant_tables(a, F, F.bid * NWAVES + F.wave, F.G * NWAVES);
        else if (F.bid >= extra) quant_tables(a, F, (F.bid - extra) * NWAVES + F.wave, (F.G - extra) * NWAVES);
    }
    SEAM(2);
    for (int rep = 0; rep <= REPS(3); ++rep) if (IN(3)) { if (rep) xcd_barrier(xbar);
        for (int u = F.bid; u < 768; u += F.G) { if (u < 512) { if (a.var != 2 && (rep == 0 || MIX_VAR != 2)) attn_unit(a, F, u, rep == 0 ? 0 : ATT_VAR); } else { if (a.var != 1 && (rep == 0 || MIX_VAR != 1)) conv_unit(a, F, u - 512); } }
    }
    SEAM(3);
    for (int rep = 0; rep <= REPS(4); ++rep) if (IN(4)) { if (rep) xcd_barrier(xbar);
        pg8::Gemm g{(const bf16*)(a.ws + WS_MIX), (const bf16*)(a.ws + WS_WOUT), T, D, D}; pg8::StaticOrder S; S.init(T, D, F.G, F.bid);
        pg8::EpiGateBf16 E{(bf16*)(a.ws + WS_DELTA), D, mod + 2048, 6144, SEQ};
        pg8::gemm_phase<pg8::EpiGateBf16, pg8::StaticOrder, true, true>(F.lds, g, S, E);
    }
    SEAM(4);
    for (int rep = 0; rep <= REPS(5); ++rep) if (IN(5)) { if (rep) xcd_barrier(xbar); modnorm_rows<true>(a, F, a.x, a.norm2_g, 3072, 4096); }
    SEAM(5);
    for (int rep = 0; rep <= REPS(6); ++rep) if (IN(6)) { if (rep) xcd_barrier(xbar);
        pg8::Gemm g{(const bf16*)(a.ws + WS_H), (const bf16*)(a.ws + WS_WQ), T, NQ, D}; pg8::StaticOrder S; S.init(T, NQ, F.G, F.bid);
        pg8::EpiBf16 E{(bf16*)(a.ws + WS_PROJ), NQ};
        pg8::gemm_phase<pg8::EpiBf16, pg8::StaticOrder, true, true>(F.lds, g, S, E);
    }
    SEAM(6);
    for (int rep = 0; rep <= REPS(7); ++rep) if (IN(7)) { if (rep) xcd_barrier(xbar);
        const int h = F.bid & 7, nbh = (F.G - h + 7) >> 3;
        { const bf16* KEYS = (const bf16*)(a.ws + WS_KEYS); LAS bf16* KL = (LAS bf16*)F.lds;
          for (int i = F.tid; i < 2 * 128 * 16; i += NTHREADS) { const int sd = i >> 11, row = (i >> 4) & 127, c16 = i & 15;
              *(LAS v4u*)(KL + (sd * 128 + row) * KEY_LDS_STRIDE + 8 * c16) = *(const v4u*)(KEYS + ((size_t)(sd * 8 + h) * 128 + row) * 128 + 8 * c16); } }
        __syncthreads();
        for (int t = (F.bid >> 3) * NWAVES + F.wave; t < T / 32; t += nbh * NWAVES) topk_unit(a, F, t, h);
        __syncthreads(); }
    SEAM(7);
    if (census) {
        unsigned sum = 0; bool ok = true; unsigned mine = 1, other = 0;
#pragma unroll
        for (int j = 0; j < 8; ++j) { const unsigned cj = __hip_atomic_load(ctl + 64 * j, __ATOMIC_RELAXED, __HIP_MEMORY_SCOPE_AGENT); sum += cj; ok = ok && (cj > 0u); if (j == my_xcc) mine = cj; if (j == (my_xcc ^ 4)) other = cj; }
        if (ok && sum == (unsigned)F.G) { F.sl_x = my_xcc & 3; F.sl_rank = my_rank + ((my_xcc & 4) ? (int)other : 0); F.sl_n = (int)(mine + other); }
    }
    for (int rep = 0; rep <= REPS(8); ++rep) if (IN(8)) { if (rep) xcd_barrier(xbar); peer_slice<false>(a, F); }
    SEAM(8);
    for (int rep = 0; rep <= REPS(9); ++rep) if (IN(9)) { if (rep) xcd_barrier(xbar); peer_coef(a, F); }
    SEAM(9);
    for (int rep = 0; rep <= REPS(10); ++rep) if (IN(10)) { if (rep) xcd_barrier(xbar); if (V_MFMA) peer_vslice_mfma(a, F, (rep >= 1 && rep < REP_N) ? VS_VAR : 0); else peer_slice<true>(a, F); }
#undef IN
#undef SEAM
}

extern "C" void kernel_launch(void* const* d_in, const int* in_sizes, int n_in, void* d_out, int out_size, void* d_ws, size_t ws_size, hipStream_t stream) {
    static int grid = 0;
    if (grid == 0) {
        if (n_in != 19 || in_sizes[0] != T * D || out_size != T * D || ws_size < WS_END) { fprintf(stderr, "kernel_launch: unexpected shapes (n_in %d, in0 %d, out %d, ws %zu)\n", n_in, n_in > 0 ? in_sizes[0] : -1, out_size, ws_size); grid = -1; return; }
        int dev = 0, cus = 0, per_cu = 0;
        hipGetDevice(&dev); hipDeviceGetAttribute(&cus, hipDeviceAttributeMultiprocessorCount, dev);
        hipFuncSetAttribute((const void*)fwd_kernel, hipFuncAttributeMaxDynamicSharedMemorySize, LDS_BYTES);
        hipOccupancyMaxActiveBlocksPerMultiprocessor(&per_cu, (const void*)fwd_kernel, NTHREADS, LDS_BYTES);
        (void)hipGetLastError();
        if (per_cu < 1) { fprintf(stderr, "kernel_launch: occupancy query says %d blocks/CU\n", per_cu); per_cu = 1; }
        grid = cus * 1;
    }
    if (grid < 0) return;
    (void)hipMemsetAsync(d_ws, 0, 32768, stream);
    Args a{};
    const float** p = (const float**)&a;
    for (int i = 0; i < 19; ++i) p[i] = (const float*)d_in[i];
    a.out = (float*)d_out; a.ws = (unsigned char*)d_ws;
#if N_LAUNCH_SPLIT
    for (int ph = 0; ph < N_PHASES; ++ph) { a.ph_lo = ph; a.ph_hi = ph + 1;
        for (int rep = 0; rep < (((REP_MASK >> ph) & 1) ? 2 : 1); ++rep) hipLaunchKernelGGL(fwd_kernel, dim3(grid), dim3(NTHREADS), LDS_BYTES, stream, a); }
    for (int ph = 0; ph < N_PHASES - 1; ++ph) if ((LATE_MASK >> ph) & 1) { a.ph_lo = ph; a.ph_hi = ph + 1; a.var = LATE_VAR; hipLaunchKernelGGL(fwd_kernel, dim3(grid), dim3(NTHREADS), LDS_BYTES, stream, a); }
#else
    a.ph_lo = 0; a.ph_hi = N_PHASES;
    void* args[] = {&a};
    hipError_t e = hipLaunchCooperativeKernel((const void*)fwd_kernel, dim3(grid), dim3(NTHREADS), args, LDS_BYTES, stream);
    if (e != hipSuccess) fprintf(stderr, "cooperative launch failed: %s (grid %d)\n", hipGetErrorString(e), grid);
#endif
}
```

```cpp
#include <hip/hip_runtime.h>
#include <hip/hip_cooperative_groups.h>
#include <cstdio>
#include <cstdint>
namespace cg = cooperative_groups;

#ifndef REP_MASK
#define REP_MASK 0
#endif
#ifndef USE_CG_SYNC
#define USE_CG_SYNC 0
#endif
#ifndef ATT_VAR
#define ATT_VAR 0
#endif
#ifndef V_MFMA
#define V_MFMA 1
#endif
#ifndef VS_VAR
#define VS_VAR 0
#endif
#ifndef MIX_VAR
#define MIX_VAR 0
#endif
#ifndef REP_PH
#define REP_PH -1
#endif
#ifndef REP_N
#define REP_N 0
#endif
#ifndef LATE_MASK
#define LATE_MASK 0
#endif
#ifndef LATE_VAR
#define LATE_VAR 0
#endif
#ifndef N_LAUNCH_SPLIT
#define N_LAUNCH_SPLIT 0
#endif

namespace pg8 {
#define PG8_LAS __attribute__((address_space(3)))
typedef unsigned short bf16_t;
typedef short bf16x8 __attribute__((ext_vector_type(8)));
typedef float f32x4 __attribute__((ext_vector_type(4)));
typedef unsigned u32x4 __attribute__((ext_vector_type(4)));
constexpr int BM = 256, BK = 64, HALF = 128, HTB = HALF * BK * 2  , STAGE_BYTES = 8 * HTB, NXCD = 8, WGM = 8;

__host__ __device__ __forceinline__ int lds_byte(int r, int c) { const int st = (r >> 4) * 2 + (c >> 5), rr = r & 15, cc = c & 31, ob = rr * 64 + cc * 2; return st * 1024 + (ob ^ (((ob >> 9) & 1) << 5)); }
__host__ __device__ __forceinline__ void stage_rc(int b, int& R, int& C) { const int st = b / 1024, sb = b % 1024, swz = sb ^ (((sb >> 9) & 1) << 5); R = (st >> 1) * 16 + swz / 64; C = (st & 1) * 32 + (swz % 64) / 2; }
__host__ __device__ __forceinline__ int perm32(int rho) { const int n = rho >> 4, i = rho & 15; return 8 * (i >> 2) + 4 * n + (i & 3); }

struct Unit { int pm, pn; };
struct Gemm { const bf16_t* A; const bf16_t* Bt; int M, N, K; };

struct StaticOrder {
    int nM, nN, nwg, G, c;
    __host__ __device__ void init(int M, int N, int G_, int c_) { nM = M / BM; nN = N / BM; nwg = nM * nN; G = G_; c = c_; }
    __host__ __device__ bool next(int i, Unit& u) const {
        const long L = (long)i * G + c; if (L >= nwg) return false;
        int wgid = (int)L; { const int q = nwg / NXCD, r = nwg % NXCD, xcd = wgid % NXCD, off = wgid / NXCD; wgid = (xcd < r ? xcd * (q + 1) : r * (q + 1) + (xcd - r) * q) + off; }
        const int nig = WGM * nN, gid = wgid / nig, fm = gid * WGM, gsz = (nM - fm) < WGM ? (nM - fm) : WGM;
        u.pm = fm + ((wgid % nig) % gsz); u.pn = (wgid % nig) / gsz; return true;
    }
    __device__ __forceinline__ void a_ready(const Unit&) const {}
    __device__ __forceinline__ void done(const Unit&) const {}
};

__device__ __forceinline__ unsigned cvt_pk_bf16(float lo, float hi) { unsigned r; asm volatile("v_cvt_pk_bf16_f32 %0, %1, %2" : "=v"(r) : "v"(lo), "v"(hi)); return r; }

struct EpiBf16 {
    static constexpr bool PERM = true, AFTER_DRAIN = false;
    bf16_t* O; int ldc;
    __device__ __forceinline__ void operator()(const f32x4 (&acc)[2][2][4][2], const Unit& u, int wr, int wc, int fr, int fq) const {
        const int row0 = u.pm * BM + wr * 64 + fr; const int col0 = u.pn * BM + wc * 32 + 8 * fq;
#pragma unroll
        for (int ai = 0; ai < 2; ++ai)
#pragma unroll
            for (int m = 0; m < 4; ++m) { bf16_t* rowp = O + (size_t)(row0 + ai * HALF + m * 16) * ldc + col0;
#pragma unroll
                for (int bj = 0; bj < 2; ++bj) { const f32x4 v0 = acc[ai][bj][m][0], v1 = acc[ai][bj][m][1];
                    u32x4 w; w.x = cvt_pk_bf16(v0[0], v0[1]); w.y = cvt_pk_bf16(v0[2], v0[3]); w.z = cvt_pk_bf16(v1[0], v1[1]); w.w = cvt_pk_bf16(v1[2], v1[3]);
                    *(u32x4*)(rowp + bj * HALF) = w; } }
    }
};
struct EpiGateBf16 {
    static constexpr bool PERM = true, AFTER_DRAIN = false;
    bf16_t* O; int ldc; const float* gate; int gstride; int rows_per_batch;
    __device__ __forceinline__ void operator()(const f32x4 (&acc)[2][2][4][2], const Unit& u, int wr, int wc, int fr, int fq) const {
        const int row0 = u.pm * BM + wr * 64 + fr; const int col0 = u.pn * BM + wc * 32 + 8 * fq;
        const float* gp = gate + (size_t)((u.pm * BM) / rows_per_batch) * gstride + col0;
        f32x4 gv[2][2];
#pragma unroll
        for (int bj = 0; bj < 2; ++bj)
#pragma unroll
            for (int n = 0; n < 2; ++n) gv[bj][n] = *(const f32x4*)(gp + bj * HALF + 4 * n);
#pragma unroll
        for (int ai = 0; ai < 2; ++ai)
#pragma unroll
            for (int m = 0; m < 4; ++m) { bf16_t* rowp = O + (size_t)(row0 + ai * HALF + m * 16) * ldc + col0;
#pragma unroll
                for (int bj = 0; bj < 2; ++bj) { const f32x4 v0 = acc[ai][bj][m][0] * gv[bj][0], v1 = acc[ai][bj][m][1] * gv[bj][1];
                    u32x4 w; w.x = cvt_pk_bf16(v0[0], v0[1]); w.y = cvt_pk_bf16(v0[2], v0[3]); w.z = cvt_pk_bf16(v1[0], v1[1]); w.w = cvt_pk_bf16(v1[2], v1[3]);
                    *(u32x4*)(rowp + bj * HALF) = w; } }
    }
};
struct EpiResid {
    static constexpr bool PERM = false, AFTER_DRAIN = false;
    const float* base; float* out; int ldc; const float* gate; int gstride; int rows_per_batch;
    __device__ __forceinline__ void operator()(const f32x4 (&acc)[2][2][4][2], const Unit& u, int wr, int wc, int fr, int fq) const {
        const int row0 = u.pm * BM + wr * 64 + fr; const int col0 = u.pn * BM + wc * 32 + 4 * fq;
        const float* gp = gate + (size_t)((u.pm * BM) / rows_per_batch) * gstride + col0;
        f32x4 gv[2][2];
#pragma unroll
        for (int bj = 0; bj < 2; ++bj)
#pragma unroll
            for (int n = 0; n < 2; ++n) gv[bj][n] = *(const f32x4*)(gp + bj * HALF + n * 16);
#pragma unroll
        for (int ai = 0; ai < 2; ++ai)
#pragma unroll
            for (int m = 0; m < 4; ++m) { const size_t off = (size_t)(row0 + ai * HALF + m * 16) * ldc + col0;
#pragma unroll
                for (int bj = 0; bj < 2; ++bj)
#pragma unroll
                    for (int n = 0; n < 2; ++n) { const f32x4 bs = *(const f32x4*)(base + off + bj * HALF + n * 16);
                        *(f32x4*)(out + off + bj * HALF + n * 16) = bs + gv[bj][n] * acc[ai][bj][m][n]; } }
    }
};

template <class Epi, class Sched, bool ALIGN_EPI = false, bool SP2 = false>
__device__ __forceinline__ void gemm_phase(PG8_LAS unsigned char* lds, const Gemm g, const Sched& S, const Epi& E) {
    const int tid = threadIdx.x, wid = __builtin_amdgcn_readfirstlane(tid >> 6), lane = tid & 63, wr = wid >> 2, wc = wid & 3, fr = lane & 15, fq = lane >> 4;
    const int K = g.K, nt = K / BK;
    unsigned voffA[2], voffB[2];
#pragma unroll
    for (int i = 0; i < 2; ++i) { int R, C; stage_rc(tid * 16 + i * 8192, R, C); const int Rb = Epi::PERM ? ((R & ~31) + perm32(R & 31)) : R;
        voffA[i] = (unsigned)(R * K + C) * 2u; voffB[i] = (unsigned)(Rb * K + C) * 2u; }
    const size_t kstep = (size_t)(BK * 2);
    const size_t hstep = (size_t)HALF * K * 2;
    const size_t tstep = 2 * hstep;
    const unsigned ldsw = (unsigned)wid * 1024u;
    const int aoff = lds_byte(wr * 64 + fr, fq * 8), boff = lds_byte(wc * 32 + fr, fq * 8);
#define PG8_SA(b, h) (((b) * 2 + (h)) * HTB)
#define PG8_SB(b, h) ((4 + (b) * 2 + (h)) * HTB)
#define PG8_STAGE(bufoff, gbase, voff) do { _Pragma("unroll") for (int _i = 0; _i < 2; ++_i) \
        __builtin_amdgcn_global_load_lds((const unsigned*)((const char*)(gbase) + (voff)[_i]), (PG8_LAS unsigned*)(lds + (bufoff) + ldsw + _i * 8192), 16, 0, 0); } while (0)
#define PG8_LDA(dst, b, h) do { _Pragma("unroll") for (int m = 0; m < 4; ++m) _Pragma("unroll") for (int k = 0; k < 2; ++k) dst[m][k] = *(const PG8_LAS bf16x8*)(lds + PG8_SA(b, h) + aoff + m * 2048 + k * 1024); } while (0)
#define PG8_LDB(dst, b, h) do { _Pragma("unroll") for (int n = 0; n < 2; ++n) _Pragma("unroll") for (int k = 0; k < 2; ++k) dst[n][k] = *(const PG8_LAS bf16x8*)(lds + PG8_SB(b, h) + boff + n * 2048 + k * 1024); } while (0)
#define PG8_MMA(ai, bj, At, Bt) do { __builtin_amdgcn_s_setprio(1); _Pragma("unroll") for (int m = 0; m < 4; ++m) _Pragma("unroll") for (int n = 0; n < 2; ++n) _Pragma("unroll") for (int k = 0; k < 2; ++k) \
        acc[ai][bj][m][n] = __builtin_amdgcn_mfma_f32_16x16x32_bf16(Bt[n][k], At[m][k], acc[ai][bj][m][n], 0, 0, 0); __builtin_amdgcn_s_setprio(0); } while (0)
#define PG8_WAIT_V(n) asm volatile("s_waitcnt vmcnt(" #n ")" ::: "memory")
#define PG8_WAIT_L(n) asm volatile("s_waitcnt lgkmcnt(" #n ")" ::: "memory")
#define PG8_BAR __builtin_amdgcn_s_barrier()
#define PG8_SCHED __builtin_amdgcn_sched_barrier(0)
    Unit cur, nxt; int ui = 0;
    if (!S.next(0, cur)) return;
    f32x4 acc[2][2][4][2];
#pragma unroll
    for (int a = 0; a < 2; ++a)
#pragma unroll
        for (int b = 0; b < 2; ++b)
#pragma unroll
            for (int m = 0; m < 4; ++m)
#pragma unroll
                for (int n = 0; n < 2; ++n) acc[a][b][m][n] = (f32x4){0.f, 0.f, 0.f, 0.f};
    bf16x8 At[4][2], B0[2][2], B1[2][2];
    const char* cA = (const char*)g.A + (size_t)cur.pm * tstep; const char* cB = (const char*)g.Bt + (size_t)cur.pn * tstep;
    S.a_ready(cur);
    if constexpr (SP2) {
        PG8_STAGE(PG8_SB(0, 0), cB, voffB); PG8_STAGE(PG8_SB(0, 1), cB + hstep, voffB); PG8_STAGE(PG8_SA(0, 0), cA, voffA); PG8_STAGE(PG8_SA(0, 1), cA + hstep, voffA);
        if (wr == 1) PG8_BAR;
        PG8_WAIT_V(2); PG8_BAR;
        PG8_STAGE(PG8_SB(1, 0), cB + kstep, voffB); PG8_STAGE(PG8_SA(1, 0), cA + kstep, voffA); PG8_STAGE(PG8_SB(1, 1), cB + hstep + kstep, voffB);
        PG8_WAIT_V(6); PG8_BAR;
    } else {
        PG8_STAGE(PG8_SB(0, 0), cB, voffB); PG8_STAGE(PG8_SA(0, 0), cA, voffA); PG8_STAGE(PG8_SB(0, 1), cB + hstep, voffB); PG8_STAGE(PG8_SA(0, 1), cA + hstep, voffA);
        if (wr == 1) PG8_BAR;
        PG8_WAIT_V(4); PG8_BAR;
        PG8_STAGE(PG8_SB(1, 0), cB + kstep, voffB); PG8_STAGE(PG8_SA(1, 0), cA + kstep, voffA); PG8_STAGE(PG8_SB(1, 1), cB + hstep + kstep, voffB);
        PG8_WAIT_V(6); PG8_BAR;
    }
    for (;;) {
        const bool has_next = S.next(ui + 1, nxt);
        const char* nA = has_next ? (const char*)g.A + (size_t)nxt.pm * tstep : cA; const char* nB = has_next ? (const char*)g.Bt + (size_t)nxt.pn * tstep : cB;
        for (int t = 0; t < nt; t += 2) {
            const bool last = (t == nt - 2);
            const char* a1 = cA + (size_t)(t + 1) * kstep;
            const char* a2 = last ? nA : cA + (size_t)(t + 2) * kstep; const char* b2 = last ? nB : cB + (size_t)(t + 2) * kstep;
            const char* a3 = a2 + kstep; const char* b3 = b2 + kstep;
            if (last && has_next) S.a_ready(nxt);
            if constexpr (SP2) {
            PG8_LDB(B0, 0, 0); PG8_LDB(B1, 0, 1); PG8_SCHED; PG8_LDA(At, 0, 0); PG8_STAGE(PG8_SA(1, 1), a1 + hstep, voffA);
            PG8_WAIT_V(8); PG8_WAIT_L(0); PG8_BAR; PG8_MMA(0, 0, At, B0); PG8_MMA(0, 1, At, B1); PG8_BAR; PG8_SCHED;
            PG8_LDA(At, 0, 1); PG8_STAGE(PG8_SB(0, 0), b2, voffB); PG8_STAGE(PG8_SB(0, 1), b2 + hstep, voffB); PG8_STAGE(PG8_SA(0, 0), a2, voffA);
            PG8_WAIT_V(8); PG8_WAIT_L(0); PG8_BAR; PG8_MMA(1, 0, At, B0); PG8_MMA(1, 1, At, B1); PG8_BAR; PG8_SCHED;
            PG8_LDB(B0, 1, 0); PG8_LDB(B1, 1, 1); PG8_SCHED; PG8_LDA(At, 1, 0); PG8_STAGE(PG8_SA(0, 1), a2 + hstep, voffA);
            PG8_WAIT_V(8); PG8_WAIT_L(0); PG8_BAR; PG8_MMA(0, 0, At, B0); PG8_MMA(0, 1, At, B1); PG8_BAR; PG8_SCHED;
            PG8_LDA(At, 1, 1); PG8_STAGE(PG8_SB(1, 0), b3, voffB); PG8_STAGE(PG8_SB(1, 1), b3 + hstep, voffB); PG8_STAGE(PG8_SA(1, 0), a3, voffA);
            PG8_WAIT_V(8); PG8_WAIT_L(0); PG8_BAR; PG8_MMA(1, 0, At, B0); PG8_MMA(1, 1, At, B1); PG8_BAR; PG8_SCHED;
            } else {
            PG8_LDB(B0, 0, 0); PG8_SCHED; PG8_LDA(At, 0, 0); PG8_STAGE(PG8_SA(1, 1), a1 + hstep, voffA);
            PG8_WAIT_L(8); PG8_BAR; PG8_WAIT_L(0); PG8_MMA(0, 0, At, B0); PG8_BAR; PG8_SCHED;
            PG8_LDB(B1, 0, 1); PG8_STAGE(PG8_SB(0, 0), b2, voffB);
            PG8_BAR; PG8_WAIT_L(0); PG8_MMA(0, 1, At, B1); PG8_BAR;
            PG8_LDA(At, 0, 1); PG8_STAGE(PG8_SA(0, 0), a2, voffA);
            PG8_BAR; PG8_WAIT_L(0); PG8_MMA(1, 0, At, B0); PG8_BAR; PG8_SCHED;
            PG8_STAGE(PG8_SB(0, 1), b2 + hstep, voffB);
            PG8_WAIT_V(6); PG8_BAR; PG8_MMA(1, 1, At, B1); PG8_BAR;
            PG8_LDB(B0, 1, 0); PG8_SCHED; PG8_LDA(At, 1, 0); PG8_STAGE(PG8_SA(0, 1), a2 + hstep, voffA);
            PG8_WAIT_L(8); PG8_BAR; PG8_WAIT_L(0); PG8_MMA(0, 0, At, B0); PG8_BAR; PG8_SCHED;
            PG8_LDB(B1, 1, 1); PG8_STAGE(PG8_SB(1, 0), b3, voffB);
            PG8_BAR; PG8_WAIT_L(0); PG8_MMA(0, 1, At, B1); PG8_BAR;
            PG8_LDA(At, 1, 1); PG8_STAGE(PG8_SA(1, 0), a3, voffA);
            PG8_BAR; PG8_WAIT_L(0); PG8_MMA(1, 0, At, B0); PG8_BAR; PG8_SCHED;
            PG8_STAGE(PG8_SB(1, 1), b3 + hstep, voffB);
            PG8_WAIT_V(6); PG8_BAR; PG8_MMA(1, 1, At, B1); PG8_BAR;
            }
        }
        if constexpr (ALIGN_EPI) { if (wr == 0) PG8_BAR; }
        if constexpr (!Epi::AFTER_DRAIN) { E(acc, cur, wr, wc, fr, fq); S.done(cur); }
        if (!has_next) break;
#pragma unroll
        for (int a = 0; a < 2; ++a)
#pragma unroll
            for (int b = 0; b < 2; ++b)
#pragma unroll
                for (int m = 0; m < 4; ++m)
#pragma unroll
                    for (int n = 0; n < 2; ++n) acc[a][b][m][n] = (f32x4){0.f, 0.f, 0.f, 0.f};
        cur = nxt; cA = nA; cB = nB; ++ui;
        if constexpr (ALIGN_EPI) { if (wr == 1) PG8_BAR; }
    }
    PG8_WAIT_V(0);
    if constexpr (!ALIGN_EPI) { if (wr == 0) PG8_BAR; }
    PG8_BAR;
#undef PG8_SA
#undef PG8_SB
#undef PG8_STAGE
#undef PG8_LDA
#undef PG8_LDB
#undef PG8_MMA
#undef PG8_WAIT_V
#undef PG8_WAIT_L
#undef PG8_BAR
#undef PG8_SCHED
}
}

constexpr int NWAVES = 8, NTHREADS = 512;
constexpr int BATCH = 8, SEQ = 4096, D = 1024, T = BATCH * SEQ;
constexpr int NIN = 2304, NQ = 2048, NEXP = 16384;
constexpr int C_B = 0, C_C = 512, C_H = 1024, C_Q = 1536, C_K = 2048, C_V = 2176;
constexpr float EPS = 1e-6f;
constexpr size_t MiB = 1u << 20;
constexpr size_t WS_CTL = 0;
constexpr size_t WS_MOD = 1 * MiB;
constexpr size_t WS_BIAS = WS_MOD + 256 * 1024;
constexpr size_t WS_WIN = 2 * MiB;
constexpr size_t WS_WOUT = 7 * MiB;
constexpr size_t WS_WQ = 9 * MiB;
constexpr size_t WS_KEYS = 13 * MiB;
constexpr size_t WS_SU = WS_MOD + 384 * 1024;
constexpr size_t WS_SV = WS_MOD + 448 * 1024;
constexpr size_t WS_U = 14 * MiB;
constexpr size_t WS_V = 30 * MiB;
constexpr size_t WS_H = 78 * MiB;
constexpr size_t WS_MIX = 142 * MiB;
constexpr size_t WS_H4 = WS_MIX + 16 * MiB;
constexpr size_t WS_ST = WS_MOD + 512 * 1024;
constexpr size_t WS_CP = WS_MIX + 48 * MiB;
constexpr size_t WS_CS = WS_MOD + 640 * 1024;
constexpr size_t WS_PACK = WS_MIX;
constexpr size_t WS_PROJ = 206 * MiB;
constexpr size_t WS_PART = WS_PROJ;
constexpr size_t WS_EIDX = 350 * MiB;
constexpr size_t WS_GATE = 366 * MiB;
constexpr size_t WS_DELTA = 382 * MiB;
constexpr size_t WS_END = 510 * MiB;

constexpr int LDS_BYTES = 147456;

#define GAS __attribute__((address_space(1)))
#define LAS __attribute__((address_space(3)))
typedef unsigned short bf16;
typedef unsigned v4u __attribute__((ext_vector_type(4)));
typedef unsigned v2u __attribute__((ext_vector_type(2)));
typedef float f32x4 __attribute__((ext_vector_type(4)));
typedef float f32x16 __attribute__((ext_vector_type(16)));
typedef short bf16x8 __attribute__((ext_vector_type(8)));
typedef int v8i __attribute__((ext_vector_type(8)));

__device__ __forceinline__ unsigned f2bf(float f) { unsigned u = __builtin_bit_cast(unsigned, f); return (u + 0x7fffu + ((u >> 16) & 1u)) >> 16; }
__device__ __forceinline__ unsigned pk2(float lo, float hi) { unsigned r; asm("v_cvt_pk_bf16_f32 %0, %1, %2" : "=v"(r) : "v"(lo), "v"(hi)); return r; }
__device__ __forceinline__ float bf_lo(unsigned w) { return __builtin_bit_cast(float, w << 16); }
__device__ __forceinline__ float bf_hi(unsigned w) { return __builtin_bit_cast(float, w & 0xffff0000u); }
__device__ __forceinline__ float wave_sum(float v) {
#pragma unroll
    for (int o = 1; o < 64; o <<= 1) v += __shfl_xor(v, o);
    return v;
}

#define XB_TMO      128
#define XB_XCNT(j)  (256  + 64 * (j))
#define XB_XSUB(j)  (1280 + 64 * (j))
#define XB_XGEN(j)  (2304 + 64 * (j))
#define XB_TOP      3328
#define XB_TOPGEN   3392
#define XCD_BAR_WORDS 3456
#define XB_SPIN_CAP (1u << 18)
__device__ __forceinline__ unsigned xb_ld(unsigned* p)              { return __hip_atomic_load(p, __ATOMIC_RELAXED, __HIP_MEMORY_SCOPE_AGENT); }
__device__ __forceinline__ unsigned xb_add(unsigned* p, unsigned v) { return __hip_atomic_fetch_add(p, v, __ATOMIC_RELAXED, __HIP_MEMORY_SCOPE_AGENT); }
__device__ __forceinline__ unsigned xb_xcc_id() { return (unsigned)__builtin_amdgcn_s_getreg((3 << 11) | 20) & 0xFu; }
#define XB_SPIN(cond, bar) do { unsigned _sp = 0; while (cond) { __builtin_amdgcn_s_sleep(1); \
    if ((++_sp & 255u) == 0u) { if (xb_ld(&(bar)[XB_TMO])) break; if (_sp > XB_SPIN_CAP) { atomicAdd(&(bar)[XB_TMO], 1u); break; } } } } while (0)
struct XcdBarrier { unsigned* bar; unsigned x; volatile LAS unsigned* st; };
__device__ __forceinline__ XcdBarrier xcd_barrier_post(unsigned* bar, volatile LAS unsigned* st) {
    XcdBarrier b; b.bar = bar; b.x = xb_xcc_id(); b.st = st;
    if (threadIdx.x == 0) (void)xb_add(&bar[XB_XCNT(b.x)], 1u);
    return b;
}
__device__ __forceinline__ void xcd_barrier_complete(unsigned* bar, unsigned x, unsigned& nloc, unsigned& nx) {
    const unsigned G = gridDim.x * gridDim.y * gridDim.z;
    unsigned sum, cnt, mine, sp = 0u;
    for (;;) {
        sum = 0u; cnt = 0u; mine = 0u;
#pragma unroll
        for (unsigned j = 0; j < 16; ++j) { const unsigned c = xb_ld(&bar[XB_XCNT(j)]); sum += c; cnt += (c > 0u) ? 1u : 0u; mine = (j == x) ? c : mine; }
        if (sum == G) break;
        __builtin_amdgcn_s_sleep(1);
        if ((++sp & 255u) == 0u) { if (xb_ld(&bar[XB_TMO])) break; if (sp > XB_SPIN_CAP) { atomicAdd(&bar[XB_TMO], 1u); break; } }
    }
    nloc = mine > 0u ? mine : 1u; nx = cnt > 0u ? cnt : 1u;
}
__device__ __forceinline__ void xcd_barrier(const XcdBarrier& b) {
    asm volatile("s_waitcnt vmcnt(0)" ::: "memory");
    __syncthreads();
    if (threadIdx.x == 0) {
        unsigned* bar = b.bar;
        __builtin_amdgcn_s_waitcnt(0);
        unsigned nloc = b.st[0], nx = b.st[1];
        if (nloc == 0u) { xcd_barrier_complete(bar, b.x, nloc, nx); b.st[0] = nloc; b.st[1] = nx; }
        const unsigned old = xb_add(&bar[XB_XSUB(b.x)], 1u);
        const unsigned gen = old / nloc;
        if (old + 1u == (gen + 1u) * nloc) {
            __builtin_amdgcn_fence(__ATOMIC_RELEASE, "agent");
            asm volatile("s_waitcnt vmcnt(0)" ::: "memory");
            const unsigned og = xb_add(&bar[XB_TOP], 1u);
            const unsigned tg = og / nx;
            if (og + 1u == (tg + 1u) * nx) xb_add(&bar[XB_TOPGEN], 1u);
            else XB_SPIN(xb_ld(&bar[XB_TOPGEN]) == tg, bar);
            __builtin_amdgcn_fence(__ATOMIC_ACQUIRE, "agent");
            xb_add(&bar[XB_XGEN(b.x)], 1u);
            asm volatile("s_waitcnt vmcnt(0)" ::: "memory");
        } else {
            XB_SPIN(xb_ld(&bar[XB_XGEN(b.x)]) == gen, bar);
            __builtin_amdgcn_fence(__ATOMIC_ACQUIRE, "agent");
            asm volatile("s_waitcnt vmcnt(0)" ::: "memory");
        }
    }
    __syncthreads();
}

struct Args {
    const float *x, *c, *w_ada, *b_ada, *norm1_g, *w_in, *conv_w, *q_norm_g, *k_norm_g, *sinks, *rel_bias, *conv_out_g, *attn_out_g, *w_out, *norm2_g, *peer_wq, *peer_keys, *peer_u, *peer_v;
    float* out; unsigned char* ws; int ph_lo, ph_hi, var, pad;
};

struct Frame {
    LAS unsigned char* lds; int tid, lane, wave, G, bid;
    int sl_x, sl_rank, sl_n;
};

__device__ __forceinline__ void mod_item(const Args& a, Frame& F, int item) {
    LAS float* sc = (LAS float*)F.lds;
    LAS float* red = (LAS float*)(F.lds + 32768);
    for (int i = F.tid; i < 8192; i += NTHREADS) { const float v = a.c[i]; sc[i] = v / (1.f + __expf(-v)); }
    __syncthreads();
    const int cl = F.tid & 31, kg = F.tid >> 5, col = item * 32 + cl;
    float acc[8];
#pragma unroll
    for (int b = 0; b < 8; ++b) acc[b] = 0.f;
#pragma unroll 1
    for (int k0 = kg * 64; k0 < kg * 64 + 64; k0 += 32) { float w[32];
#pragma unroll
        for (int i = 0; i < 32; ++i) w[i] = a.w_ada[(size_t)(k0 + i) * 6144 + col];
#pragma unroll
        for (int i = 0; i < 32; ++i)
#pragma unroll
            for (int b = 0; b < 8; ++b) acc[b] += sc[b * 1024 + k0 + i] * w[i]; }
#pragma unroll
    for (int b = 0; b < 8; ++b) red[(kg * 32 + cl) * 8 + b] = acc[b];
    __syncthreads();
    if (F.tid < 256) { const int b = F.tid >> 5; float s = 0.f;
#pragma unroll
      for (int g = 0; g < 16; ++g) s += red[(g * 32 + cl) * 8 + b];
      ((float*)(a.ws + WS_MOD))[b * 6144 + col] = s + a.b_ada[col]; }
    __syncthreads();
}
__device__ __forceinline__ void transpose_item(const float* W, int K, int N, bf16* WT, LAS float* scr, int item, int lane) {
    const int nblk = N / 32, kb = item / nblk, nb = item % nblk, k0 = 64 * kb, n0 = 32 * nb;
    { float wv[32];
#pragma unroll
      for (int i = 0; i < 32; ++i) wv[i] = W[(size_t)(k0 + 2 * i + (lane >> 5)) * N + n0 + (lane & 31)];
#pragma unroll
      for (int i = 0; i < 32; ++i) scr[(2 * i + (lane >> 5)) * 33 + (lane & 31)] = wv[i]; }
    asm volatile("s_waitcnt lgkmcnt(0)" ::: "memory");
    const int c = lane & 7;
#pragma unroll
    for (int j = 0; j < 4; ++j) { const int n = (lane >> 3) + 8 * j; const LAS float* s = scr + (8 * c) * 33 + n;
        v4u o; o.x = pk2(s[0 * 33], s[1 * 33]); o.y = pk2(s[2 * 33], s[3 * 33]); o.z = pk2(s[4 * 33], s[5 * 33]); o.w = pk2(s[6 * 33], s[7 * 33]);
        *(v4u*)(WT + (size_t)(n0 + n) * K + k0 + 8 * c) = o; }
    asm volatile("s_waitcnt lgkmcnt(0)" ::: "memory");
}
__device__ __forceinline__ void cvt_rows(const float* src, bf16* dst, size_t n8, size_t gtid, size_t gn) {
    for (size_t i = gtid; i < n8; i += gn) { const f32x4 a = ((const f32x4*)src)[2 * i], b = ((const f32x4*)src)[2 * i + 1];
        v4u o; o.x = pk2(a.x, a.y); o.y = pk2(a.z, a.w); o.z = pk2(b.x, b.y); o.w = pk2(b.z, b.w); ((v4u*)dst)[i] = o; }
}
__device__ __forceinline__ void quant_tables(const Args& a, Frame& F, int widx, int nw) {
    for (int r0 = 4 * widx; r0 < 2 * NEXP; r0 += 4 * nw) {
        const bool isv = r0 >= NEXP; const int e0 = isv ? r0 - NEXP : r0;
        const float* tab = isv ? a.peer_v : a.peer_u;
        f32x4 v[4][4];
#pragma unroll
        for (int r = 0; r < 4; ++r) { const f32x4* src = (const f32x4*)(tab + (size_t)(e0 + r) * D) + F.lane;
#pragma unroll
            for (int j = 0; j < 4; ++j) v[r][j] = src[64 * j]; }
#pragma unroll
        for (int r = 0; r < 4; ++r) { float mx = 0.f;
#pragma unroll
            for (int j = 0; j < 4; ++j) mx = fmaxf(mx, fmaxf(fmaxf(fabsf(v[r][j].x), fabsf(v[r][j].y)), fmaxf(fabsf(v[r][j].z), fabsf(v[r][j].w))));
#pragma unroll
            for (int o = 1; o < 64; o <<= 1) mx = fmaxf(mx, __shfl_xor(mx, o));
            float ssq = 0.f;
#pragma unroll
            for (int j = 0; j < 4; ++j) ssq += (v[r][j].x * v[r][j].x + v[r][j].y * v[r][j].y) + (v[r][j].z * v[r][j].z + v[r][j].w * v[r][j].w);
            ssq = wave_sum(ssq);
            const float rms = sqrtf(ssq * (1.f / D));
            const float scale = mx > 0.f ? (isv ? fminf(mx, 3.0f * rms) * (1.f / 6.f) : fminf(mx, 2.5f * rms) * (1.f / 7.f)) : 1.f, inv = 1.f / scale;
            unsigned char* dst = a.ws + (isv ? WS_V : WS_U) + (size_t)(e0 + r) * 128 + 2 * F.lane;
#pragma unroll
            for (int j = 0; j < 4; ++j) { unsigned w;
                if (isv) { const float y0 = fminf(fmaxf(v[r][j].x * inv, -6.f), 6.f), y1 = fminf(fmaxf(v[r][j].y * inv, -6.f), 6.f), y2 = fminf(fmaxf(v[r][j].z * inv, -6.f), 6.f), y3 = fminf(fmaxf(v[r][j].w * inv, -6.f), 6.f);
                    w = __builtin_amdgcn_cvt_scalef32_pk_fp4_f32(0u, y0, y1, 1.0f, 0); w = __builtin_amdgcn_cvt_scalef32_pk_fp4_f32(w, y2, y3, 1.0f, 1); }
                else { w = 0u;
#pragma unroll
                    for (int c = 0; c < 4; ++c) { const int qi = (int)fminf(fmaxf(rintf(v[r][j][c] * inv), -7.f), 7.f); w |= ((unsigned)qi & 15u) << (4 * c); } }
                *(unsigned short*)(dst + (size_t)j * (2 * MiB)) = (unsigned short)w; }
            if (F.lane == 0) ((float*)(a.ws + (isv ? WS_SV : WS_SU)))[e0 + r] = scale; }
    }
}
__device__ __forceinline__ void prep_rest(const Args& a, Frame& F) {
    LAS float* scr = (LAS float*)(F.lds + 65536 + F.wave * 8448);
    const int gw = F.bid * NWAVES + F.wave, NGW = F.G * NWAVES;
    constexpr int I_IN = (D / 64) * (NIN / 32), I_OUT = (D / 64) * (D / 32), I_Q = (D / 64) * (NQ / 32);
    for (int it = gw; it < I_IN + I_OUT + I_Q; it += NGW) {
        int r = it;
        if (r < I_IN) { transpose_item(a.w_in, D, NIN, (bf16*)(a.ws + WS_WIN), scr, r, F.lane); continue; } r -= I_IN;
        if (r < I_OUT) { transpose_item(a.w_out, D, D, (bf16*)(a.ws + WS_WOUT), scr, r, F.lane); continue; } r -= I_OUT;
        transpose_item(a.peer_wq, D, NQ, (bf16*)(a.ws + WS_WQ), scr, r, F.lane);
    }
    const size_t gtid = (size_t)F.bid * NTHREADS + F.tid, gn = (size_t)F.G * NTHREADS;
    cvt_rows(a.peer_keys, (bf16*)(a.ws + WS_KEYS), (size_t)2 * 8 * 128 * 128 / 8, gtid, gn);
    if (F.bid == 0) { for (int i = F.tid; i < 1024; i += NTHREADS) { const int h = i >> 7, dist = i & 127; int bk;
            if (dist < 16) bk = dist; else { bk = 16 + (int)(__logf((float)dist * (1.f / 16.f)) / 2.0794415416798357f * 16.f); bk = bk < 31 ? bk : 31; }
            ((float*)(a.ws + WS_BIAS))[i] = a.rel_bias[bk * 8 + h]; } }
}
template <bool ADD_DELTA, int RIF>
__device__ __forceinline__ void modnorm_rows(const Args& a, Frame& F, const float* src, const float* g, int sh_off, int sc_off) {
    const int gw = F.bid * NWAVES + F.wave, NGW = F.G * NWAVES;
    const float* mod = (const float*)(a.ws + WS_MOD);
    bf16* H = (bf16*)(a.ws + WS_H);
    for (int m0 = 16 * gw; m0 < T; m0 += 16 * NGW) {
        const float* mb = mod + (size_t)(m0 / SEQ) * 6144;
        f32x4 gam[4], sh[4];
#pragma unroll
        for (int j = 0; j < 4; ++j) { const int col = 4 * F.lane + 256 * j; gam[j] = *(const f32x4*)(g + col) * (*(const f32x4*)(mb + sc_off + col) + 1.f); sh[j] = *(const f32x4*)(mb + sh_off + col); }
#pragma unroll 1
        for (int r0 = 0; r0 < 16; r0 += RIF) {
            f32x4 v[RIF][4]; v2u dl[RIF][4];
#pragma unroll
            for (int r = 0; r < RIF; ++r) { const f32x4* xr = (const f32x4*)(src + (size_t)(m0 + r0 + r) * D) + F.lane;
                const v2u* dr = (const v2u*)((const bf16*)(a.ws + WS_DELTA) + (size_t)(m0 + r0 + r) * D) + F.lane;
#pragma unroll
                for (int j = 0; j < 4; ++j) { v[r][j] = xr[64 * j]; if (ADD_DELTA) dl[r][j] = dr[64 * j]; } }
#pragma unroll
            for (int r = 0; r < RIF; ++r) { float s = 0.f;
                if (ADD_DELTA) {
#pragma unroll
                    for (int j = 0; j < 4; ++j) { v[r][j].x += bf_lo(dl[r][j].x); v[r][j].y += bf_hi(dl[r][j].x); v[r][j].z += bf_lo(dl[r][j].y); v[r][j].w += bf_hi(dl[r][j].y); } }
#pragma unroll
                for (int j = 0; j < 4; ++j) s += (v[r][j].x * v[r][j].x + v[r][j].y * v[r][j].y) + (v[r][j].z * v[r][j].z + v[r][j].w * v[r][j].w);
                const float rstd = rsqrtf(wave_sum(s) * (1.f / D) + EPS);
                v2u* o8 = (v2u*)(H + (size_t)(m0 + r0 + r) * D) + F.lane;
                f32x4 y[4]; float am = 0.f;
#pragma unroll
                for (int j = 0; j < 4; ++j) { y[j] = v[r][j] * rstd * gam[j] + sh[j]; v2u w; w.x = pk2(y[j].x, y[j].y); w.y = pk2(y[j].z, y[j].w); o8[64 * j] = w;
                    am = fmaxf(am, fmaxf(fmaxf(fabsf(y[j].x), fabsf(y[j].y)), fmaxf(fabsf(y[j].z), fabsf(y[j].w)))); }
                if (ADD_DELTA) {
#pragma unroll
                    for (int o = 1; o < 64; o <<= 1) am = fmaxf(am, __shfl_xor(am, o));
                    const float st = am > 0.f ? am * (1.f / 7.f) : 1.f, ist = 1.f / st;
                    unsigned char* hp = a.ws + WS_H4 + (size_t)(m0 + r0 + r) * 1024 + 2 * F.lane;
#pragma unroll
                    for (int j = 0; j < 4; ++j) { unsigned w0 = 0u, w1 = 0u;
#pragma unroll
                        for (int c = 0; c < 4; ++c) { const float rr = y[j][c] * ist; const float d0 = fminf(fmaxf(rintf(rr), -7.f), 7.f); const float d1 = fminf(fmaxf(rintf((rr - d0) * 16.f), -8.f), 7.f);
                            w0 |= ((unsigned)(int)d0 & 15u) << (4 * c); w1 |= ((unsigned)(int)d1 & 15u) << (4 * c); }
                        *(unsigned short*)(hp + 128 * j) = (unsigned short)w0; *(unsigned short*)(hp + 512 + 128 * j) = (unsigned short)w1; }
                    if (F.lane == 0) ((float*)(a.ws + WS_ST))[m0 + r0 + r] = st; } }
        }
    }
}

constexpr int KS_STRIDE = 72, VT_STRIDE = 260;
constexpr int ATT_KS = 0, ATT_VT = 256 * KS_STRIDE * 2, ATT_BIAS = ATT_VT + 64 * VT_STRIDE * 2;
__device__ __forceinline__ void attn_unit(const Args& a, Frame& F, int unit, int pv = 0) {
    const int kvh = unit & 1, nb = (unit >> 1) & 31, b = unit >> 6;
    const bf16* PROJ = (const bf16*)(a.ws + WS_PROJ);
    bf16* MIX = (bf16*)(a.ws + WS_MIX);
    LAS bf16* Ks = (LAS bf16*)(F.lds + ATT_KS); LAS bf16* Vt = (LAS bf16*)(F.lds + ATT_VT); LAS float* bl = (LAS float*)(F.lds + ATT_BIAS);
    const int g = F.wave & 3, hq = kvh * 4 + g, hh = F.lane >> 5, l31 = F.lane & 31;
    v4u qraw[2][4];
#pragma unroll
    for (int qq = 0; qq < 2; ++qq) { const int qi = 32 * ((F.wave >> 2) * 2 + qq) + l31; const size_t tok = (size_t)b * SEQ + nb * 128 + qi;
#pragma unroll
        for (int ks = 0; ks < 4; ++ks) qraw[qq][ks] = *(const v4u*)(PROJ + tok * NIN + C_Q + hq * 64 + 16 * ks + 8 * hh); }
    if (pv != 2) {
        const int key = F.tid >> 1, half = F.tid & 1; const bool valid = (nb > 0) || (key >= 128);
        const size_t tok = (size_t)b * SEQ + nb * 128 - 128 + key;
        v4u kr[4], vr[4];
#pragma unroll
        for (int i = 0; i < 4; ++i) { kr[i] = (v4u){0u, 0u, 0u, 0u}; vr[i] = kr[i]; }
        if (valid) {
            const v4u* kp = (const v4u*)(PROJ + tok * NIN + C_K + kvh * 64 + 32 * half);
            const v4u* vp = (const v4u*)(PROJ + tok * NIN + C_V + kvh * 64 + 32 * half);
#pragma unroll
            for (int i = 0; i < 4; ++i) { kr[i] = kp[i]; vr[i] = vp[i]; }
        }
        float ss = 0.f;
#pragma unroll
        for (int i = 0; i < 4; ++i) {
#pragma unroll
            for (int e = 0; e < 4; ++e) { const float lo = bf_lo(kr[i][e]), hi = bf_hi(kr[i][e]); ss += lo * lo + hi * hi; } }
        ss += __shfl_xor(ss, 1);
        const float rstd = rsqrtf(ss * (1.f / 64.f) + EPS);
#pragma unroll
        for (int i = 0; i < 4; ++i) { v4u o;
#pragma unroll
            for (int e = 0; e < 4; ++e) { const int d = 32 * half + 8 * i + 2 * e;
                o[e] = pk2(bf_lo(kr[i][e]) * rstd * a.k_norm_g[d], bf_hi(kr[i][e]) * rstd * a.k_norm_g[d + 1]); }
            *(LAS v4u*)(Ks + key * KS_STRIDE + 32 * half + 8 * i) = o; }
#pragma unroll
        for (int i = 0; i < 4; ++i)
#pragma unroll
            for (int e = 0; e < 4; ++e) { const int d = 32 * half + 8 * i + 2 * e;
                Vt[d * VT_STRIDE + key] = (bf16)(vr[i][e] & 0xffffu); Vt[(d + 1) * VT_STRIDE + key] = (bf16)(vr[i][e] >> 16); }
        { const int g = F.tid >> 7, dist = F.tid & 127; bl[F.tid] = ((const float*)(a.ws + WS_BIAS))[(kvh * 4 + g) * 128 + dist]; }
        if (F.tid < 64) bl[512 + F.tid] = a.q_norm_g[F.tid]; else if (F.tid < 128) bl[512 + F.tid] = a.k_norm_g[F.tid - 64]; else if (F.tid < 384) bl[512 + F.tid] = a.attn_out_g[kvh * 256 + (F.tid - 128)];
    }
    __syncthreads();
    const float sink = a.sinks[hq];
#pragma unroll 1
    for (int qq = 0; qq < (pv == 1 ? 0 : 2); ++qq) {
        const int qt = (F.wave >> 2) * 2 + qq, qi = 32 * qt + l31;
        const size_t tok = (size_t)b * SEQ + nb * 128 + qi;
        bf16x8 qf[4];
        {
            v4u qr[4]; float ss = 0.f;
#pragma unroll
            for (int ks = 0; ks < 4; ++ks) { qr[ks] = qq ? qraw[1][ks] : qraw[0][ks];
#pragma unroll
                for (int e = 0; e < 4; ++e) { const float lo = bf_lo(qr[ks][e]), hi = bf_hi(qr[ks][e]); ss += lo * lo + hi * hi; } }
            ss += __shfl_xor(ss, 32);
            const float rstd = rsqrtf(ss * (1.f / 64.f) + EPS) * 0.125f;
#pragma unroll
            for (int ks = 0; ks < 4; ++ks) { v4u o;
#pragma unroll
                for (int e = 0; e < 4; ++e) { const int d = 16 * ks + 8 * hh + 2 * e;
                    o[e] = pk2(bf_lo(qr[ks][e]) * rstd * bl[512 + d], bf_hi(qr[ks][e]) * rstd * bl[512 + d + 1]); }
                qf[ks] = __builtin_bit_cast(bf16x8, o); }
        }
        f32x16 s[5];
#pragma unroll
        for (int k5 = 0; k5 < 5; ++k5) { const int kt = qt + k5;
            f32x16 acc;
#pragma unroll
            for (int r = 0; r < 16; ++r) acc[r] = 0.f;
#pragma unroll
            for (int ks = 0; ks < 4; ++ks) { const bf16x8 kf = *(const LAS bf16x8*)(Ks + (32 * kt + l31) * KS_STRIDE + 16 * ks + 8 * hh);
                acc = __builtin_amdgcn_mfma_f32_32x32x16_bf16(kf, qf[ks], acc, 0, 0, 0); }
            s[k5] = acc; }
        float mx = -INFINITY;
#pragma unroll
        for (int k5 = 0; k5 < 5; ++k5) { const float pen_tile = (nb == 0 && (qt + k5) < 4) ? -INFINITY : 0.f;
#pragma unroll
            for (int r = 0; r < 16; ++r) { const int kj = 32 * (qt + k5) + (r & 3) + 8 * (r >> 2) + 4 * hh; const int dist = qi + 128 - kj;
                float v = s[k5][r] + bl[g * 128 + (dist & 127)] + pen_tile;
                if (k5 == 0) v += (dist > 127) ? -INFINITY : 0.f;
                if (k5 == 4) v += (dist < 0) ? -INFINITY : 0.f;
                s[k5][r] = v; mx = fmaxf(mx, v); } }
        mx = fmaxf(mx, __shfl_xor(mx, 32)); mx = fmaxf(mx, sink);
        float ls = 0.f;
#pragma unroll
        for (int k5 = 0; k5 < 5; ++k5)
#pragma unroll
            for (int r = 0; r < 16; ++r) { const float p = __expf(s[k5][r] - mx); s[k5][r] = p; ls += p; }
        ls += __shfl_xor(ls, 32);
        const float inv = 1.f / (ls + __expf(sink - mx));
        f32x16 o[2];
#pragma unroll
        for (int dt = 0; dt < 2; ++dt)
#pragma unroll
            for (int r = 0; r < 16; ++r) o[dt][r] = 0.f;
#pragma unroll
        for (int k5 = 0; k5 < 5; ++k5)
#pragma unroll
            for (int s2 = 0; s2 < 2; ++s2) { const int kt = qt + k5;
                v4u pw; pw.x = pk2(s[k5][8 * s2 + 0], s[k5][8 * s2 + 1]); pw.y = pk2(s[k5][8 * s2 + 2], s[k5][8 * s2 + 3]); pw.z = pk2(s[k5][8 * s2 + 4], s[k5][8 * s2 + 5]); pw.w = pk2(s[k5][8 * s2 + 6], s[k5][8 * s2 + 7]);
                const bf16x8 pf = __builtin_bit_cast(bf16x8, pw);
#pragma unroll
                for (int dt = 0; dt < 2; ++dt) { const LAS bf16* vp = Vt + (32 * dt + l31) * VT_STRIDE + 32 * kt + 16 * s2 + 4 * hh;
                    const v2u v0 = *(const LAS v2u*)vp, v1 = *(const LAS v2u*)(vp + 8);
                    v4u vw; vw.x = v0.x; vw.y = v0.y; vw.z = v1.x; vw.w = v1.y;
                    o[dt] = __builtin_amdgcn_mfma_f32_32x32x16_bf16(__builtin_bit_cast(bf16x8, vw), pf, o[dt], 0, 0, 0); } }
        float ss = 0.f;
#pragma unroll
        for (int dt = 0; dt < 2; ++dt)
#pragma unroll
            for (int r = 0; r < 16; ++r) { o[dt][r] *= inv; ss += o[dt][r] * o[dt][r]; }
        ss += __shfl_xor(ss, 32);
        const float rstd = rsqrtf(ss * (1.f / 64.f) + EPS);
#pragma unroll
        for (int dt = 0; dt < 2; ++dt)
#pragma unroll
            for (int rq = 0; rq < 4; ++rq) { const int d = 32 * dt + 8 * rq + 4 * hh; const f32x4 gg = *(const LAS f32x4*)(bl + 640 + g * 64 + d);
                v2u w; w.x = pk2(o[dt][4 * rq + 0] * rstd * gg.x, o[dt][4 * rq + 1] * rstd * gg.y); w.y = pk2(o[dt][4 * rq + 2] * rstd * gg.z, o[dt][4 * rq + 3] * rstd * gg.w);
                *(v2u*)(MIX + tok * D + 512 + hq * 64 + d) = w; }
    }
    __syncthreads();
}
__device__ __forceinline__ void unpack8(const v4u r, float (&f)[8]) {
#pragma unroll
    for (int e = 0; e < 4; ++e) { f[2 * e] = bf_lo(r[e]); f[2 * e + 1] = bf_hi(r[e]); }
}
__device__ __forceinline__ void conv_unit(const Args& a, Frame& F, int unit) {
    const int nb = unit & 31, b = unit >> 5;
    const bf16* PROJ = (const bf16*)(a.ws + WS_PROJ);
    bf16* MIX = (bf16*)(a.ws + WS_MIX);
    const int ch = 8 * F.lane, pos0 = nb * 128 + 16 * F.wave;
    const size_t tok0 = (size_t)b * SEQ + pos0;
    float w0[8], w1[8], w2[8], gg[8], um2[8], um1[8];
#pragma unroll
    for (int e = 0; e < 8; ++e) { w0[e] = a.conv_w[ch + e]; w1[e] = a.conv_w[512 + ch + e]; w2[e] = a.conv_w[1024 + ch + e]; gg[e] = a.conv_out_g[ch + e]; um2[e] = 0.f; um1[e] = 0.f; }
    if (pos0 >= 2) {
        float c[8], h[8];
        unpack8(*(const v4u*)(PROJ + (tok0 - 2) * NIN + C_C + ch), c); unpack8(*(const v4u*)(PROJ + (tok0 - 2) * NIN + C_H + ch), h);
#pragma unroll
        for (int e = 0; e < 8; ++e) um2[e] = c[e] * h[e];
        unpack8(*(const v4u*)(PROJ + (tok0 - 1) * NIN + C_C + ch), c); unpack8(*(const v4u*)(PROJ + (tok0 - 1) * NIN + C_H + ch), h);
#pragma unroll
        for (int e = 0; e < 8; ++e) um1[e] = c[e] * h[e];
    }
#pragma unroll 1
    for (int i0 = 0; i0 < 16; i0 += 4) {
        v4u rb[4], rc[4], rh[4];
#pragma unroll
        for (int i = 0; i < 4; ++i) { const size_t tok = tok0 + i0 + i; rb[i] = *(const v4u*)(PROJ + tok * NIN + C_B + ch); rc[i] = *(const v4u*)(PROJ + tok * NIN + C_C + ch); rh[i] = *(const v4u*)(PROJ + tok * NIN + C_H + ch); }
#pragma unroll
        for (int i = 0; i < 4; ++i) { const size_t tok = tok0 + i0 + i;
            float bg[8], c[8], h[8], y[8]; float ss = 0.f;
            unpack8(rb[i], bg); unpack8(rc[i], c); unpack8(rh[i], h);
#pragma unroll
            for (int e = 0; e < 8; ++e) { const float u0 = c[e] * h[e]; y[e] = bg[e] * (w0[e] * um2[e] + w1[e] * um1[e] + w2[e] * u0); ss += y[e] * y[e]; um2[e] = um1[e]; um1[e] = u0; }
            ss += __shfl_xor(ss, 1); ss += __shfl_xor(ss, 2); ss += __shfl_xor(ss, 4);
            const float rstd = rsqrtf(ss * (1.f / 64.f) + EPS);
            v4u o;
#pragma unroll
            for (int e = 0; e < 4; ++e) o[e] = pk2(y[2 * e] * rstd * gg[2 * e], y[2 * e + 1] * rstd * gg[2 * e + 1]);
            *(v4u*)(MIX + tok * D + ch) = o; }
    }
}

#define CE_DESC(x, y) do { const unsigned _hi = (x) > (y) ? (x) : (y), _lo = (x) > (y) ? (y) : (x); (x) = _hi; (y) = _lo; } while (0)
__device__ __forceinline__ void sort16_desc(unsigned (&v)[16]) {
#define S16(i, j) CE_DESC(v[i], v[j]);
    S16(0, 1) S16(2, 3) S16(0, 2) S16(1, 3) S16(1, 2) S16(4, 5) S16(6, 7) S16(4, 6) S16(5, 7) S16(5, 6) S16(0, 4) S16(2, 6) S16(2, 4) S16(1, 5) S16(3, 7) S16(3, 5) S16(1, 2) S16(3, 4) S16(5, 6)
    S16(8, 9) S16(10, 11) S16(8, 10) S16(9, 11) S16(9, 10) S16(12, 13) S16(14, 15) S16(12, 14) S16(13, 15) S16(13, 14) S16(8, 12) S16(10, 14) S16(10, 12) S16(9, 13) S16(11, 15) S16(11, 13) S16(9, 10) S16(11, 12) S16(13, 14)
    S16(0, 8) S16(4, 12) S16(4, 8) S16(2, 10) S16(6, 14) S16(6, 10) S16(2, 4) S16(6, 8) S16(10, 12) S16(1, 9) S16(5, 13) S16(5, 9) S16(3, 11) S16(7, 15) S16(7, 11) S16(3, 5) S16(7, 9) S16(11, 13)
    S16(1, 2) S16(3, 4) S16(5, 6) S16(7, 8) S16(9, 10) S16(11, 12) S16(13, 14)
#undef S16
}
__device__ __forceinline__ void merge16_desc(unsigned (&x)[16], const unsigned (&y)[16]) {
#pragma unroll
    for (int i = 0; i < 16; ++i) x[i] = x[i] > y[15 - i] ? x[i] : y[15 - i];
#pragma unroll
    for (int j = 8; j > 0; j >>= 1)
#pragma unroll
        for (int i = 0; i < 16; ++i) if ((i & j) == 0) CE_DESC(x[i], x[i | j]);
}
constexpr int KEY_LDS_STRIDE = 136;
__device__ __forceinline__ void side_top16(const bf16* QP, const LAS bf16* KL, int tok0, int h, int s, int lane, unsigned (&top)[16]) {
    const int l31 = lane & 31, hh = lane >> 5;
    bf16x8 qf[8];
    const bf16* qp = QP + (size_t)(tok0 + l31) * NQ + h * 256 + s * 128 + 8 * hh;
#pragma unroll
    for (int ks = 0; ks < 8; ++ks) qf[ks] = *(const bf16x8*)(qp + 16 * ks);
    const LAS bf16* kp = KL + (s * 128 + l31) * KEY_LDS_STRIDE + 8 * hh;
#define SIDE_TILE(kt, dst) do { f32x16 acc; \
        _Pragma("unroll") for (int r = 0; r < 16; ++r) acc[r] = 0.f; \
        _Pragma("unroll") for (int ks = 0; ks < 8; ++ks) { const bf16x8 kf = *(const LAS bf16x8*)(kp + (32 * (kt)) * KEY_LDS_STRIDE + 16 * ks); \
            acc = __builtin_amdgcn_mfma_f32_32x32x16_bf16(kf, qf[ks], acc, 0, 0, 0); } \
        _Pragma("unroll") for (int r = 0; r < 16; ++r) { const int nn = 32 * (kt) + (r & 3) + 8 * (r >> 2) + 4 * hh; \
            int fx = (int)__builtin_fmaf(acc[r], 524288.f, 16777216.f); fx = fx < 0 ? 0 : (fx > (1 << 25) - 1 ? (1 << 25) - 1 : fx); \
            dst[r] = ((unsigned)fx << 7) | (unsigned)(127 - nn); } \
        sort16_desc(dst); } while (0)
    SIDE_TILE(0, top);
#pragma unroll 1
    for (int kt = 1; kt < 4; ++kt) { unsigned v[16]; SIDE_TILE(kt, v); merge16_desc(top, v); }
#undef SIDE_TILE
    unsigned oth[16];
#pragma unroll
    for (int i = 0; i < 16; ++i) oth[i] = (unsigned)__shfl_xor((int)top[i], 32);
    merge16_desc(top, oth);
}
__device__ __forceinline__ void topk_unit(const Args& a, Frame& F, int tile, int h) {
    const int tok0 = tile * 32;
    const bf16* QP = (const bf16*)(a.ws + WS_PROJ); const LAS bf16* KL = (const LAS bf16*)F.lds;
    unsigned ka[16], kb[16];
    side_top16(QP, KL, tok0, h, 0, F.lane, ka);
    side_top16(QP, KL, tok0, h, 1, F.lane, kb);
    unsigned c[4][16];
    int n = 0;
#pragma unroll
    for (int i = 0; i < 16; ++i)
#pragma unroll
        for (int j = 0; j < 16; ++j) if ((i + 1) * (j + 1) <= 16) {
            int sfx = (int)(ka[i] >> 7) + (int)(kb[j] >> 7) - (1 << 25);
            sfx = sfx < 0 ? 0 : (sfx > (1 << 23) - 1 ? (1 << 23) - 1 : sfx);
            const unsigned e = (127u - (ka[i] & 127u)) * 128u + (127u - (kb[j] & 127u));
            c[n >> 4][n & 15] = ((unsigned)(sfx >> 5) << 14) | (16383u - e); ++n; }
#pragma unroll
    for (; n < 64; ++n) c[n >> 4][n & 15] = 0u;
    sort16_desc(c[0]); sort16_desc(c[1]); sort16_desc(c[2]); CE_DESC(c[3][0], c[3][1]);
    merge16_desc(c[0], c[1]); merge16_desc(c[2], c[3]); merge16_desc(c[0], c[2]);
    float w[16]; float sum = 0.f; const float f0 = (float)(c[0][0] >> 14);
#pragma unroll
    for (int k = 0; k < 16; ++k) { w[k] = __expf(((float)(c[0][k] >> 14) - f0) * (1.f / 16384.f)); sum += w[k]; }
    const float inv = 1.f / sum;
    const int tok = tok0 + (F.lane & 31), hh = F.lane >> 5;
    int* ei = (int*)(a.ws + WS_EIDX) + (size_t)tok * 128 + h * 16 + 8 * hh;
    float* gt = (float*)(a.ws + WS_GATE) + (size_t)tok * 128 + h * 16 + 8 * hh;
    v4u e0, e1; f32x4 g0, g1;
#pragma unroll
    for (int k = 0; k < 4; ++k) { const unsigned x0 = hh ? c[0][8 + k] : c[0][k], x1 = hh ? c[0][12 + k] : c[0][4 + k];
        e0[k] = 16383u - (x0 & 16383u); e1[k] = 16383u - (x1 & 16383u);
        g0[k] = (hh ? w[8 + k] : w[k]) * inv; g1[k] = (hh ? w[12 + k] : w[4 + k]) * inv; }
    *(v4u*)ei = e0; *(v4u*)(ei + 4) = e1; *(f32x4*)gt = g0; *(f32x4*)(gt + 4) = g1;
}

__device__ __forceinline__ float gelu_tanh(float x) {
    const float u = 0.7978845608028654f * (x + 0.044715f * x * x * x);
    const float t = 1.f - 2.f / (1.f + __expf(2.f * u));
    return 0.5f * x * (1.f + t);
}
__device__ __forceinline__ void peer_coef(const Args& a, Frame& F) {
    const int gw = F.bid * NWAVES + F.wave, NGW = F.G * NWAVES, lane = F.lane;
    const float* SU = (const float*)(a.ws + WS_SU); const float* SV = (const float*)(a.ws + WS_SV);
    for (int t0 = 4 * gw; t0 < T; t0 += 4 * NGW) {
        float s0[4], s1[4], st[4]; int2 e[4]; float2 g[4]; float su0[4], su1[4], sv0[4], sv1[4];
#pragma unroll
        for (int k = 0; k < 4; ++k) { const int tok = t0 + k;
            const float* pp = (const float*)(a.ws + WS_PART) + (size_t)tok * 512 + 2 * lane;
            float2 p0 = *(const float2*)pp, p1 = *(const float2*)(pp + 128), p2 = *(const float2*)(pp + 256), p3 = *(const float2*)(pp + 384);
            s0[k] = (p0.x + p1.x) + (p2.x + p3.x); s1[k] = (p0.y + p1.y) + (p2.y + p3.y);
            e[k] = *(const int2*)((const int*)(a.ws + WS_EIDX) + (size_t)tok * 128 + 2 * lane);
            g[k] = *(const float2*)((const float*)(a.ws + WS_GATE) + (size_t)tok * 128 + 2 * lane);
            st[k] = ((const float*)(a.ws + WS_ST))[tok]; }
#pragma unroll
        for (int k = 0; k < 4; ++k) { su0[k] = SU[e[k].x]; su1[k] = SU[e[k].y]; sv0[k] = SV[e[k].x]; sv1[k] = SV[e[k].y]; }
#pragma unroll
        for (int k = 0; k < 4; ++k) { const int tok = t0 + k;
            const float r0 = g[k].x * gelu_tanh(s0[k] * (su0[k] * st[k])) * sv0[k], r1 = g[k].y * gelu_tanh(s1[k] * (su1[k] * st[k])) * sv1[k];
            if (!V_MFMA) {
                uint2 w; w.x = ((__float_as_uint(r0) + 0x2000u) & 0xffffc000u) | (unsigned)e[k].x; w.y = ((__float_as_uint(r1) + 0x2000u) & 0xffffc000u) | (unsigned)e[k].y;
                *(uint2*)((unsigned*)(a.ws + WS_PACK) + (size_t)tok * 128 + 2 * lane) = w; }
            if (V_MFMA) {
                float am = fmaxf(fabsf(r0), fabsf(r1));
#pragma unroll
                for (int o = 1; o < 64; o <<= 1) am = fmaxf(am, __shfl_xor(am, o));
                const float cs = am > 0.f ? am * (1.f / 4.5f) : 1.f, ics = 1.f / cs;
                float ra = r0 * ics, rb = r1 * ics;
                unsigned char* cp = a.ws + WS_CP + (size_t)tok * 256 + lane;
#pragma unroll
                for (int pl = 0; pl < 4; ++pl) { const float da = fminf(fmaxf(rintf(ra), -4.f), 4.f), db = fminf(fmaxf(rintf(rb), -4.f), 4.f);
                    cp[64 * pl] = (unsigned char)__builtin_amdgcn_cvt_scalef32_pk_fp4_f32(0u, da, db, 1.0f, 0);
                    ra = (ra - da) * 8.f; rb = (rb - db) * 8.f; }
                if (lane == 0) ((float*)(a.ws + WS_CS))[tok] = cs; }
        }
    }
}
typedef float f32x2 __attribute__((ext_vector_type(2)));
__device__ __forceinline__ float dpp_sum8(float s) {
    s += __builtin_bit_cast(float, __builtin_amdgcn_update_dpp(0, __builtin_bit_cast(int, s), 0xB1, 0xF, 0xF, true));
    s += __builtin_bit_cast(float, __builtin_amdgcn_update_dpp(0, __builtin_bit_cast(int, s), 0x4E, 0xF, 0xF, true));
    s += __builtin_bit_cast(float, __builtin_amdgcn_update_dpp(0, __builtin_bit_cast(int, s), 0x141, 0xF, 0xF, true));
    return s;
}
struct PTok { v4u vr[16]; v4u aux[4]; f32x4 xo, xg; };
template <bool VSIDE>
__device__ __forceinline__ void peer_issue(const unsigned char* TB, unsigned poff, const v4u (&w)[4], PTok& P, const unsigned char* sidep, const float* xop, const float* xgp) {
#pragma unroll
    for (int i = 0; i < 16; ++i) { const unsigned id = w[i >> 2][i & 3] & 0x3fffu; P.vr[i] = *(const v4u*)(TB + (id * 128u + poff)); }
    if (VSIDE) { P.xo = *(const f32x4*)xop; P.xg = *(const f32x4*)xgp; P.aux[0].x = ((const unsigned*)sidep)[0]; P.aux[0].y = ((const unsigned*)sidep)[1]; }
    else { (void)sidep; }
}
template <bool VSIDE>
__device__ __forceinline__ void peer_compute(const PTok& P, const v4u (&w)[4], int lane, float* outp) {
    const int p = lane & 7;
    if (VSIDE) {
        f32x2 acc2[16];
#pragma unroll
        for (int j = 0; j < 16; ++j) acc2[j] = (f32x2){0.f, 0.f};
#pragma unroll
        for (int i = 0; i < 16; ++i) {
            const v2u cpair = (i & 2) ? (v2u){w[i >> 2].z, w[i >> 2].w} : (v2u){w[i >> 2].x, w[i >> 2].y};
#pragma unroll
            for (int q = 0; q < 4; ++q) { const unsigned wd = P.vr[i][q];
                const f32x2 f0 = __builtin_amdgcn_cvt_scalef32_pk_f32_fp4(wd, 1.0f, 0), f1 = __builtin_amdgcn_cvt_scalef32_pk_f32_fp4(wd, 1.0f, 1), f2 = __builtin_amdgcn_cvt_scalef32_pk_f32_fp4(wd, 1.0f, 2), f3 = __builtin_amdgcn_cvt_scalef32_pk_f32_fp4(wd, 1.0f, 3);
                if (i & 1) {
                    asm volatile("v_pk_fma_f32 %0, %1, %2, %0 op_sel:[0,1,0] op_sel_hi:[1,1,1]" : "+v"(acc2[4 * q]) : "v"(f0), "v"(cpair));
                    asm volatile("v_pk_fma_f32 %0, %1, %2, %0 op_sel:[0,1,0] op_sel_hi:[1,1,1]" : "+v"(acc2[4 * q + 1]) : "v"(f1), "v"(cpair));
                    asm volatile("v_pk_fma_f32 %0, %1, %2, %0 op_sel:[0,1,0] op_sel_hi:[1,1,1]" : "+v"(acc2[4 * q + 2]) : "v"(f2), "v"(cpair));
                    asm volatile("v_pk_fma_f32 %0, %1, %2, %0 op_sel:[0,1,0] op_sel_hi:[1,1,1]" : "+v"(acc2[4 * q + 3]) : "v"(f3), "v"(cpair));
                } else {
                    asm volatile("v_pk_fma_f32 %0, %1, %2, %0 op_sel_hi:[1,0,1]" : "+v"(acc2[4 * q]) : "v"(f0), "v"(cpair));
                    asm volatile("v_pk_fma_f32 %0, %1, %2, %0 op_sel_hi:[1,0,1]" : "+v"(acc2[4 * q + 1]) : "v"(f1), "v"(cpair));
                    asm volatile("v_pk_fma_f32 %0, %1, %2, %0 op_sel_hi:[1,0,1]" : "+v"(acc2[4 * q + 2]) : "v"(f2), "v"(cpair));
                    asm volatile("v_pk_fma_f32 %0, %1, %2, %0 op_sel_hi:[1,0,1]" : "+v"(acc2[4 * q + 3]) : "v"(f3), "v"(cpair));
                } } }
        float acc[32];
#pragma unroll
        for (int j = 0; j < 16; ++j) { acc[2 * j] = acc2[j].x; acc[2 * j + 1] = acc2[j].y; }
        const int b5 = (lane >> 5) & 1, b4 = (lane >> 4) & 1, b3 = (lane >> 3) & 1;
        float v1[16], v2[8], v3[4];
#pragma unroll
        for (int j = 0; j < 16; ++j) { const v2u r = __builtin_amdgcn_permlane32_swap(__float_as_uint(acc[j]), __float_as_uint(acc[16 + j]), false, false);
            v1[j] = __uint_as_float(r.x) + __uint_as_float(r.y); }
#pragma unroll
        for (int j = 0; j < 8; ++j) { const v2u r = __builtin_amdgcn_permlane16_swap(__float_as_uint(v1[j]), __float_as_uint(v1[8 + j]), false, false);
            v2[j] = __uint_as_float(r.x) + __uint_as_float(r.y); }
#pragma unroll
        for (int j = 0; j < 4; ++j) { const float kp = b3 ? v2[4 + j] : v2[j], sd = b3 ? v2[j] : v2[4 + j];
            v3[j] = kp + __builtin_bit_cast(float, __builtin_amdgcn_update_dpp(0, __builtin_bit_cast(int, sd), 0x128, 0xF, 0xF, true)); }
        f32x4 o; o.x = (P.xo.x + bf_lo(P.aux[0].x)) + P.xg.x * v3[0]; o.y = (P.xo.y + bf_hi(P.aux[0].x)) + P.xg.y * v3[1]; o.z = (P.xo.z + bf_lo(P.aux[0].y)) + P.xg.z * v3[2]; o.w = (P.xo.w + bf_hi(P.aux[0].y)) + P.xg.w * v3[3]; *(f32x4*)outp = o;
    } else {
        f32x2 keep = {0.f, 0.f};
#pragma unroll
        for (int i = 0; i < 16; ++i) { int s0 = 0, s1 = 0;
#pragma unroll
            for (int q = 0; q < 4; ++q) { s0 = __builtin_amdgcn_sdot8((int)P.vr[i][q], (int)P.aux[0][q], s0, false); s1 = __builtin_amdgcn_sdot8((int)P.vr[i][q], (int)P.aux[1][q], s1, false); }
            const float dt = dpp_sum8((float)s0 + (float)s1 * 0.0625f);
            if ((i >> 1) == p) { if (i & 1) keep.y = dt; else keep.x = dt; } }
        *(f32x2*)outp = keep;
    }
}
template <bool VSIDE>
__device__ __forceinline__ void peer_slice(const Args& a, Frame& F) {
    const int x = F.sl_x, wx = F.sl_rank * NWAVES + F.wave, nwx = F.sl_n * NWAVES;
    if (wx >= T) return;
    const int lane = F.lane, eg = lane >> 3, p = lane & 7;
    const unsigned char* TB = a.ws + (VSIDE ? WS_V : WS_U) + (size_t)x * (2 * MiB); const unsigned poff = 16u * (unsigned)p;
    const unsigned* Wb = (const unsigned*)(a.ws + (VSIDE ? WS_PACK : WS_EIDX)) + 16 * eg;
    const unsigned char* Hb = a.ws + WS_H4 + 128 * x + 16 * p;
    const int dcol = 256 * x + 32 * p + 16 * ((lane >> 5) & 1) + 8 * ((lane >> 4) & 1) + 4 * ((lane >> 3) & 1);
    const float* G2 = (const float*)(a.ws + WS_MOD) + 5120 + dcol;
    float* PART = (float*)(a.ws + WS_PART) + (size_t)x * 128 + 16 * eg + 2 * p;
    const float* X1 = a.x;
    const unsigned char* DLb = a.ws + WS_DELTA + 2 * dcol;
    v4u nA[4], nB[4];
    int tA = wx, tB = wx + nwx;
#define PS_LDW(dst, tok) do { const unsigned* _w = Wb + (size_t)((tok) < T ? (tok) : T - 1) * 128; _Pragma("unroll") for (int _q = 0; _q < 4; ++_q) dst[_q] = *(const v4u*)(_w + 4 * _q); } while (0)
    PS_LDW(nA, tA); PS_LDW(nB, tB);
    v4u hA[2], hB[2];
    if (!VSIDE) { const int tb0 = tB < T ? tB : tA; hA[0] = *(const v4u*)(Hb + (size_t)tA * 1024); hA[1] = *(const v4u*)(Hb + (size_t)tA * 1024 + 512); hB[0] = *(const v4u*)(Hb + (size_t)tb0 * 1024); hB[1] = *(const v4u*)(Hb + (size_t)tb0 * 1024 + 512); }
#pragma unroll 1
    for (; tA < T; tA += 2 * nwx, tB += 2 * nwx) {
        const int tBc = tB < T ? tB : tA;
        v4u wA[4], wB[4];
#pragma unroll
        for (int q = 0; q < 4; ++q) { wA[q] = nA[q]; wB[q] = nB[q]; }
        PTok A, B;
        peer_issue<VSIDE>(TB, poff, wA, A, VSIDE ? DLb + (size_t)tA * 2048 : Hb + (size_t)tA * 1024, X1 + (size_t)tA * D + dcol, G2 + (size_t)(tA / SEQ) * 6144);
        peer_issue<VSIDE>(TB, poff, wB, B, VSIDE ? DLb + (size_t)tBc * 2048 : Hb + (size_t)tBc * 1024, X1 + (size_t)tBc * D + dcol, G2 + (size_t)(tBc / SEQ) * 6144);
        if (!VSIDE) {
            A.aux[0] = hA[0]; A.aux[1] = hA[1]; B.aux[0] = hB[0]; B.aux[1] = hB[1];
            { const int t2 = tA + 2 * nwx < T ? tA + 2 * nwx : T - 1, t3 = tB + 2 * nwx < T ? tB + 2 * nwx : T - 1;
              hA[0] = *(const v4u*)(Hb + (size_t)t2 * 1024); hA[1] = *(const v4u*)(Hb + (size_t)t2 * 1024 + 512); hB[0] = *(const v4u*)(Hb + (size_t)t3 * 1024); hB[1] = *(const v4u*)(Hb + (size_t)t3 * 1024 + 512); }
            PS_LDW(nA, tA + 2 * nwx); PS_LDW(nB, tB + 2 * nwx); }
        peer_compute<VSIDE>(A, wA, lane, VSIDE ? a.out + (size_t)tA * D + dcol : PART + (size_t)tA * 512);
        if (VSIDE) { PS_LDW(nA, tA + 2 * nwx); PS_LDW(nB, tB + 2 * nwx); }
        if (tB < T) peer_compute<VSIDE>(B, wB, lane, VSIDE ? a.out + (size_t)tB * D + dcol : PART + (size_t)tB * 512);
    }
#undef PS_LDW
}

struct VTok { v4u vr[16]; };
struct VStr { v4u aw; f32x4 xo, xg; v2u dl; float cs; };
__device__ __forceinline__ void vmfma_issue(const unsigned char* TB, unsigned poff, const v4u (&w)[4], VTok& P) {
#pragma unroll
    for (int i = 0; i < 16; ++i) { const unsigned id = w[i >> 2][i & 3]; P.vr[i] = *(const v4u*)(TB + (id * 128u + poff)); }
}
__device__ __forceinline__ void vmfma_stream(VStr& S, const unsigned char* cpp, const float* csp, const float* xop, const float* xgp, const unsigned char* dlp) {
    S.aw = *(const v4u*)cpp; S.cs = *csp; S.xo = __builtin_nontemporal_load((const f32x4*)xop); S.xg = *(const f32x4*)xgp; S.dl = __builtin_nontemporal_load((const v2u*)dlp);
}
__device__ __forceinline__ void vmfma_compute(const VTok& P, const VStr& S, int lane, LAS unsigned char* img, float* outp, int pv = 0) {
    const int eg = lane >> 3, p = lane & 7, n = lane & 15, q = lane >> 4;
    if (pv == 1) { unsigned acc = 0;
#pragma unroll
        for (int i = 0; i < 16; ++i) acc ^= P.vr[i].x ^ P.vr[i].w;
        f32x4 o; o.x = S.xo.x + bf_lo(S.dl.x) + S.xg.x * S.cs; o.y = S.xo.y + (acc == 0x12345u ? 1.f : 0.f); o.z = S.xo.z + __uint_as_float(S.aw.x & 1u); o.w = S.xo.w; *(f32x4*)outp = o; return; }
    asm volatile("s_waitcnt lgkmcnt(0)" ::: "memory");
#pragma unroll
    for (int i = 0; i < 16; ++i) *(LAS v4u*)(img + (16 * eg + i) * 128 + 16 * (p ^ (i & 7))) = P.vr[i];
    asm volatile("s_waitcnt lgkmcnt(0)" ::: "memory");
    const unsigned rowb = (unsigned)(size_t)img + (unsigned)(32 * q + n) * 128u;
    v8i A; A[0] = (int)S.aw.x; A[1] = (int)S.aw.y; A[2] = (int)S.aw.z; A[3] = (int)S.aw.w; A[4] = 0; A[5] = 0; A[6] = 0; A[7] = 0;
    LAS float* scr = (LAS float*)(img + 16384);
#pragma unroll
    for (int hb = 0; hb < 2; ++hb) {
        v2u tr[8][2];
#pragma unroll
        for (int t2 = 0; t2 < 4; ++t2) { const unsigned a0 = rowb + 16u * (unsigned)((4 * hb + t2) ^ (n & 7));
            asm volatile("ds_read_b64_tr_b4 %0, %1" : "=v"(tr[2 * t2][0]) : "v"(a0) : "memory");
            asm volatile("ds_read_b64_tr_b4 %0, %1 offset:2048" : "=v"(tr[2 * t2][1]) : "v"(a0) : "memory");
            asm volatile("ds_read_b64_tr_b4 %0, %1 offset:8" : "=v"(tr[2 * t2 + 1][0]) : "v"(a0) : "memory");
            asm volatile("ds_read_b64_tr_b4 %0, %1 offset:2056" : "=v"(tr[2 * t2 + 1][1]) : "v"(a0) : "memory"); }
        asm volatile("s_waitcnt lgkmcnt(0)" : "+v"(tr[0][0]), "+v"(tr[0][1]), "+v"(tr[1][0]), "+v"(tr[1][1]), "+v"(tr[2][0]), "+v"(tr[2][1]), "+v"(tr[3][0]), "+v"(tr[3][1]), "+v"(tr[4][0]), "+v"(tr[4][1]), "+v"(tr[5][0]), "+v"(tr[5][1]), "+v"(tr[6][0]), "+v"(tr[6][1]), "+v"(tr[7][0]), "+v"(tr[7][1]) :: "memory");
        __builtin_amdgcn_sched_barrier(0);
#pragma unroll
        for (int t = 0; t < 8; ++t) { const int nt = 8 * hb + t; v8i B; B[0] = (int)tr[t][0].x; B[1] = (int)tr[t][0].y; B[2] = (int)tr[t][1].x; B[3] = (int)tr[t][1].y; B[4] = 0; B[5] = 0; B[6] = 0; B[7] = 0;
            f32x4 c = {0.f, 0.f, 0.f, 0.f};
            c = __builtin_amdgcn_mfma_scale_f32_16x16x128_f8f6f4(A, B, c, 4  , 4  , 0, 0, 0, 0);
            const float val = c[0] + c[1] * 0.125f + c[2] * 0.015625f + c[3] * 0.001953125f;
            if (q == 0) scr[16 * nt + n] = val; }
    }
    asm volatile("s_waitcnt lgkmcnt(0)" ::: "memory");
    const f32x4 v = *(const LAS f32x4*)(scr + 4 * lane);
    const float k = S.cs;
    f32x4 o; o.x = (S.xo.x + bf_lo(S.dl.x)) + S.xg.x * (k * v.x); o.y = (S.xo.y + bf_hi(S.dl.x)) + S.xg.y * (k * v.y); o.z = (S.xo.z + bf_lo(S.dl.y)) + S.xg.z * (k * v.z); o.w = (S.xo.w + bf_hi(S.dl.y)) + S.xg.w * (k * v.w);
    __builtin_nontemporal_store(o, (f32x4*)outp);
}
__device__ __forceinline__ void peer_vslice_mfma(const Args& a, Frame& F, int pv = 0) {
    const int x = F.sl_x, wx = F.sl_rank * NWAVES + F.wave, nwx = F.sl_n * NWAVES;
    if (wx >= T) return;
    const int lane = F.lane, eg = lane >> 3, p = lane & 7;
    const unsigned char* TB = a.ws + WS_V + (size_t)x * (2 * MiB); const unsigned poff = 16u * (unsigned)p;
    const unsigned* Wb = (const unsigned*)(a.ws + WS_EIDX) + 16 * eg;
    const unsigned char* CPb = a.ws + WS_CP + ((lane & 15) & 3) * 64 + 16 * (lane >> 4);
    const float* CSb = (const float*)(a.ws + WS_CS);
    const int dcol = 256 * x + 4 * lane;
    const float* G2 = (const float*)(a.ws + WS_MOD) + 5120 + dcol;
    const unsigned char* DLb = a.ws + WS_DELTA + 2 * dcol;
    LAS unsigned char* img = F.lds + F.wave * 17408;
    v4u nA[4], nB[4]; VStr sA, sB;
    int tA = wx, tB = wx + nwx;
#define PS_LDW(dst, tok) do { const unsigned* _w = Wb + (size_t)((tok) < T ? (tok) : T - 1) * 128; _Pragma("unroll") for (int _q = 0; _q < 4; ++_q) dst[_q] = *(const v4u*)(_w + 4 * _q); } while (0)
#define VS_STREAM(S, tok) do { const int _t = (tok) < T ? (tok) : T - 1; vmfma_stream(S, CPb + (size_t)_t * 256, CSb + _t, a.x + (size_t)_t * D + dcol, G2 + (size_t)(_t / SEQ) * 6144, DLb + (size_t)_t * 2048); } while (0)
    PS_LDW(nA, tA); PS_LDW(nB, tB); VS_STREAM(sA, tA); VS_STREAM(sB, tB);
#pragma unroll 1
    for (; tA < T; tA += 2 * nwx, tB += 2 * nwx) {
        VTok A, B;
        vmfma_issue(TB, poff, nA, A);
        vmfma_issue(TB, poff, nB, B);
        const VStr cA = sA, cB = sB;
        VS_STREAM(sA, tA + 2 * nwx); VS_STREAM(sB, tB + 2 * nwx);
        vmfma_compute(A, cA, lane, img, a.out + (size_t)tA * D + dcol, pv);
        PS_LDW(nA, tA + 2 * nwx); PS_LDW(nB, tB + 2 * nwx);
        if (tB < T) vmfma_compute(B, cB, lane, img, a.out + (size_t)tB * D + dcol, pv);
    }
#undef VS_STREAM
#undef PS_LDW
}

constexpr int N_PHASES = 11;
__global__ void __launch_bounds__(NTHREADS, 2) fwd_kernel(Args a) {
    extern __shared__ __attribute__((aligned(16))) unsigned char lds_raw[];
    Frame F; F.lds = (LAS unsigned char*)lds_raw; F.tid = threadIdx.x; F.lane = F.tid & 63; F.wave = __builtin_amdgcn_readfirstlane(F.tid >> 6); F.G = gridDim.x; F.bid = blockIdx.x;
    const int lo = a.ph_lo, hi = a.ph_hi;
    F.sl_x = F.bid & 3; F.sl_rank = F.bid >> 2; F.sl_n = (F.G - F.sl_x + 3) >> 2;
    unsigned* ctl = (unsigned*)(a.ws + WS_CTL);
    const bool census = (lo == 0 && hi == N_PHASES);
    int my_xcc = 0, my_rank = 0;
    XcdBarrier xbar; xbar.bar = ctl + 4096; xbar.x = 0; xbar.st = (volatile LAS unsigned*)(F.lds + LDS_BYTES - 32);
    if (census) {
        if (F.tid == 0) { xbar.st[0] = 0u; xbar.st[1] = 0u; }
        __syncthreads();
        xbar = xcd_barrier_post(ctl + 4096, (volatile LAS unsigned*)(F.lds + LDS_BYTES - 32));
    }
    if (census) {
        LAS volatile unsigned* top = (LAS volatile unsigned*)(F.lds + LDS_BYTES - 64);
        if (F.tid == 0) { const unsigned xcc = (unsigned)__builtin_amdgcn_s_getreg((3 << 11) | 20) & 7u;
            top[0] = xcc; top[1] = __hip_atomic_fetch_add(ctl + 64 * xcc, 1u, __ATOMIC_RELAXED, __HIP_MEMORY_SCOPE_AGENT); }
        __syncthreads();
        my_xcc = __builtin_amdgcn_readfirstlane((int)top[0]); my_rank = __builtin_amdgcn_readfirstlane((int)top[1]);
    }
#ifndef PH_MASK
#define PH_MASK 0x7ff
#endif
#define REPS(k) ((REP_PH == (k)) ? REP_N : 0)
#define IN(k) (((PH_MASK >> (k)) & 1) && lo <= (k) && (k) < hi)
#define SEAM(k) do { if (IN(k) && IN((k) + 1)) { if ((k) == 0 && USE_CG_SYNC) cg::this_grid().sync(); else xcd_barrier(xbar); } } while (0)
    const float* mod = (const float*)(a.ws + WS_MOD);
    for (int rep = 0; rep <= REPS(0); ++rep) if (IN(0)) { if (rep) xcd_barrier(xbar); for (int it = F.bid; it < 192; it += F.G) mod_item(a, F, it); prep_rest(a, F); }
    SEAM(0);
    for (int rep = 0; rep <= REPS(1); ++rep) if (IN(1)) { if (rep) xcd_barrier(xbar); modnorm_rows<false, 8>(a, F, a.x, a.norm1_g, 0, 1024); }
    SEAM(1);
    for (int rep = 0; rep <= REPS(2); ++rep) if (IN(2)) { if (rep) xcd_barrier(xbar);
        pg8::Gemm g{(const bf16*)(a.ws + WS_H), (const bf16*)(a.ws + WS_WIN), T, NIN, D}; pg8::StaticOrder S; S.init(T, NIN, F.G, F.bid);
        pg8::EpiBf16 E{(bf16*)(a.ws + WS_PROJ), NIN};
        pg8::gemm_phase<pg8::EpiBf16, pg8::StaticOrder, true, true>(F.lds, g, S, E);
        const int extra = S.nwg % F.G;
        if (extra == 0) quant_tables(a, F, F.bid * NWAVES + F.wave, F.G * NWAVES);
        else if (F.bid >= extra) quant_tables(a, F, (F.bid - extra) * NWAVES + F.wave, (F.G - extra) * NWAVES);
    }
    SEAM(2);
    for (int rep = 0; rep <= REPS(3); ++rep) if (IN(3)) { if (rep) xcd_barrier(xbar);
        for (int u = F.bid; u < 768; u += F.G) { if (u < 512) { if (a.var != 2 && (rep == 0 || MIX_VAR != 2)) attn_unit(a, F, u, rep == 0 ? 0 : ATT_VAR); } else { if (a.var != 1 && (rep == 0 || MIX_VAR != 1)) conv_unit(a, F, u - 512); } }
    }
    SEAM(3);
    for (int rep = 0; rep <= REPS(4); ++rep) if (IN(4)) { if (rep) xcd_barrier(xbar);
        pg8::Gemm g{(const bf16*)(a.ws + WS_MIX), (const bf16*)(a.ws + WS_WOUT), T, D, D}; pg8::StaticOrder S; S.init(T, D, F.G, F.bid);
        pg8::EpiGateBf16 E{(bf16*)(a.ws + WS_DELTA), D, mod + 2048, 6144, SEQ};
        pg8::gemm_phase<pg8::EpiGateBf16, pg8::StaticOrder, true, true>(F.lds, g, S, E);
    }
    SEAM(4);
    for (int rep = 0; rep <= REPS(5); ++rep) if (IN(5)) { if (rep) xcd_barrier(xbar); modnorm_rows<true, 4>(a, F, a.x, a.norm2_g, 3072, 4096); }
    SEAM(5);
    for (int rep = 0; rep <= REPS(6); ++rep) if (IN(6)) { if (rep) xcd_barrier(xbar);
        pg8::Gemm g{(const bf16*)(a.ws + WS_H), (const bf16*)(a.ws + WS_WQ), T, NQ, D}; pg8::StaticOrder S; S.init(T, NQ, F.G, F.bid);
        pg8::EpiBf16 E{(bf16*)(a.ws + WS_PROJ), NQ};
        pg8::gemm_phase<pg8::EpiBf16, pg8::StaticOrder, true, true>(F.lds, g, S, E);
    }
    SEAM(6);
    for (int rep = 0; rep <= REPS(7); ++rep) if (IN(7)) { if (rep) xcd_barrier(xbar);
        const int h = F.bid & 7, nbh = (F.G - h + 7) >> 3;
        { const bf16* KEYS = (const bf16*)(a.ws + WS_KEYS); LAS bf16* KL = (LAS bf16*)F.lds;
          for (int i = F.tid; i < 2 * 128 * 16; i += NTHREADS) { const int sd = i >> 11, row = (i >> 4) & 127, c16 = i & 15;
              *(LAS v4u*)(KL + (sd * 128 + row) * KEY_LDS_STRIDE + 8 * c16) = *(const v4u*)(KEYS + ((size_t)(sd * 8 + h) * 128 + row) * 128 + 8 * c16); } }
        __syncthreads();
        for (int t = (F.bid >> 3) * NWAVES + F.wave; t < T / 32; t += nbh * NWAVES) topk_unit(a, F, t, h);
        __syncthreads(); }
    SEAM(7);
    if (census) {
        unsigned sum = 0; bool ok = true; unsigned mine = 1, other = 0;
#pragma unroll
        for (int j = 0; j < 8; ++j) { const unsigned cj = __hip_atomic_load(ctl + 64 * j, __ATOMIC_RELAXED, __HIP_MEMORY_SCOPE_AGENT); sum += cj; ok = ok && (cj > 0u); if (j == my_xcc) mine = cj; if (j == (my_xcc ^ 4)) other = cj; }
        if (ok && sum == (unsigned)F.G) { F.sl_x = my_xcc & 3; F.sl_rank = my_rank + ((my_xcc & 4) ? (int)other : 0); F.sl_n = (int)(mine + other); }
    }
    for (int rep = 0; rep <= REPS(8); ++rep) if (IN(8)) { if (rep) xcd_barrier(xbar); peer_slice<false>(a, F); }
    SEAM(8);
    for (int rep = 0; rep <= REPS(9); ++rep) if (IN(9)) { if (rep) xcd_barrier(xbar); peer_coef(a, F); }
    SEAM(9);
    for (int rep = 0; rep <= REPS(10); ++rep) if (IN(10)) { if (rep) xcd_barrier(xbar); if (V_MFMA) peer_vslice_mfma(a, F, (rep >= 1 && rep < REP_N) ? VS_VAR : 0); else peer_slice<true>(a, F); }
#undef IN
#undef SEAM
}

extern "C" void kernel_launch(void* const* d_in, const int* in_sizes, int n_in, void* d_out, int out_size, void* d_ws, size_t ws_size, hipStream_t stream) {
    static int grid = 0;
    if (grid == 0) {
        if (n_in != 19 || in_sizes[0] != T * D || out_size != T * D || ws_size < WS_END) { fprintf(stderr, "kernel_launch: unexpected shapes (n_in %d, in0 %d, out %d, ws %zu)\n", n_in, n_in > 0 ? in_sizes[0] : -1, out_size, ws_size); grid = -1; return; }
        int dev = 0, cus = 0, per_cu = 0;
        hipGetDevice(&dev); hipDeviceGetAttribute(&cus, hipDeviceAttributeMultiprocessorCount, dev);
        hipFuncSetAttribute((const void*)fwd_kernel, hipFuncAttributeMaxDynamicSharedMemorySize, LDS_BYTES);
        hipOccupancyMaxActiveBlocksPerMultiprocessor(&per_cu, (const void*)fwd_kernel, NTHREADS, LDS_BYTES);
        (void)hipGetLastError();
        if (per_cu < 1) { fprintf(stderr, "kernel_launch: occupancy query says %d blocks/CU\n", per_cu); per_cu = 1; }
        grid = cus * 1;
    }
    if (grid < 0) return;
    (void)hipMemsetAsync(d_ws, 0, 32768, stream);
    Args a{};
    const float** p = (const float**)&a;
    for (int i = 0; i < 19; ++i) p[i] = (const float*)d_in[i];
    a.out = (float*)d_out; a.ws = (unsigned char*)d_ws;
#if N_LAUNCH_SPLIT
    for (int ph = 0; ph < N_PHASES; ++ph) { a.ph_lo = ph; a.ph_hi = ph + 1;
        for (int rep = 0; rep < (((REP_MASK >> ph) & 1) ? 2 : 1); ++rep) hipLaunchKernelGGL(fwd_kernel, dim3(grid), dim3(NTHREADS), LDS_BYTES, stream, a); }
    for (int ph = 0; ph < N_PHASES - 1; ++ph) if ((LATE_MASK >> ph) & 1) { a.ph_lo = ph; a.ph_hi = ph + 1; a.var = LATE_VAR; hipLaunchKernelGGL(fwd_kernel, dim3(grid), dim3(NTHREADS), LDS_BYTES, stream, a); }
#else
    a.ph_lo = 0; a.ph_hi = N_PHASES;
    void* args[] = {&a};
    hipError_t e = hipLaunchCooperativeKernel((const void*)fwd_kernel, dim3(grid), dim3(NTHREADS), args, LDS_BYTES, stream);
    if (e != hipSuccess) fprintf(stderr, "cooperative launch failed: %s (grid %d)\n", hipGetErrorString(e), grid);
#endif
}
```

```cpp
#include <hip/hip_runtime.h>
#include <hip/hip_cooperative_groups.h>
#include <cstdio>
#include <cstdint>
namespace cg = cooperative_groups;

#ifndef REP_MASK
#define REP_MASK 0
#endif
#ifndef USE_CG_SYNC
#define USE_CG_SYNC 0
#endif
#ifndef ATT_VAR
#define ATT_VAR 0
#endif
#ifndef V_MFMA
#define V_MFMA 1
#endif
#ifndef VS_VAR
#define VS_VAR 0
#endif
#ifndef MIX_VAR
#define MIX_VAR 0
#endif
#ifndef REP_PH
#define REP_PH -1
#endif
#ifndef REP_N
#define REP_N 0
#endif
#ifndef LATE_MASK
#define LATE_MASK 0
#endif
#ifndef LATE_VAR
#define LATE_VAR 0
#endif
#ifndef N_LAUNCH_SPLIT
#define N_LAUNCH_SPLIT 0
#endif

namespace pg8 {
#define PG8_LAS __attribute__((address_space(3)))
typedef unsigned short bf16_t;
typedef short bf16x8 __attribute__((ext_vector_type(8)));
typedef float f32x4 __attribute__((ext_vector_type(4)));
typedef unsigned u32x4 __attribute__((ext_vector_type(4)));
constexpr int BM = 256, BK = 64, HALF = 128, HTB = HALF * BK * 2  , STAGE_BYTES = 8 * HTB, NXCD = 8, WGM = 8;

__host__ __device__ __forceinline__ int lds_byte(int r, int c) { const int st = (r >> 4) * 2 + (c >> 5), rr = r & 15, cc = c & 31, ob = rr * 64 + cc * 2; return st * 1024 + (ob ^ (((ob >> 9) & 1) << 5)); }
__host__ __device__ __forceinline__ void stage_rc(int b, int& R, int& C) { const int st = b / 1024, sb = b % 1024, swz = sb ^ (((sb >> 9) & 1) << 5); R = (st >> 1) * 16 + swz / 64; C = (st & 1) * 32 + (swz % 64) / 2; }
__host__ __device__ __forceinline__ int perm32(int rho) { const int n = rho >> 4, i = rho & 15; return 8 * (i >> 2) + 4 * n + (i & 3); }

struct Unit { int pm, pn; };
struct Gemm { const bf16_t* A; const bf16_t* Bt; int M, N, K; };

struct StaticOrder {
    int nM, nN, nwg, G, c;
    __host__ __device__ void init(int M, int N, int G_, int c_) { nM = M / BM; nN = N / BM; nwg = nM * nN; G = G_; c = c_; }
    __host__ __device__ bool next(int i, Unit& u) const {
        const long L = (long)i * G + c; if (L >= nwg) return false;
        int wgid = (int)L; { const int q = nwg / NXCD, r = nwg % NXCD, xcd = wgid % NXCD, off = wgid / NXCD; wgid = (xcd < r ? xcd * (q + 1) : r * (q + 1) + (xcd - r) * q) + off; }
        const int nig = WGM * nN, gid = wgid / nig, fm = gid * WGM, gsz = (nM - fm) < WGM ? (nM - fm) : WGM;
        u.pm = fm + ((wgid % nig) % gsz); u.pn = (wgid % nig) / gsz; return true;
    }
    __device__ __forceinline__ void a_ready(const Unit&) const {}
    __device__ __forceinline__ void done(const Unit&) const {}
};

__device__ __forceinline__ unsigned cvt_pk_bf16(float lo, float hi) { unsigned r; asm volatile("v_cvt_pk_bf16_f32 %0, %1, %2" : "=v"(r) : "v"(lo), "v"(hi)); return r; }

struct EpiBf16 {
    static constexpr bool PERM = true, AFTER_DRAIN = false;
    bf16_t* O; int ldc;
    __device__ __forceinline__ void operator()(const f32x4 (&acc)[2][2][4][2], const Unit& u, int wr, int wc, int fr, int fq) const {
        const int row0 = u.pm * BM + wr * 64 + fr; const int col0 = u.pn * BM + wc * 32 + 8 * fq;
#pragma unroll
        for (int ai = 0; ai < 2; ++ai)
#pragma unroll
            for (int m = 0; m < 4; ++m) { bf16_t* rowp = O + (size_t)(row0 + ai * HALF + m * 16) * ldc + col0;
#pragma unroll
                for (int bj = 0; bj < 2; ++bj) { const f32x4 v0 = acc[ai][bj][m][0], v1 = acc[ai][bj][m][1];
                    u32x4 w; w.x = cvt_pk_bf16(v0[0], v0[1]); w.y = cvt_pk_bf16(v0[2], v0[3]); w.z = cvt_pk_bf16(v1[0], v1[1]); w.w = cvt_pk_bf16(v1[2], v1[3]);
                    *(u32x4*)(rowp + bj * HALF) = w; } }
    }
};
struct EpiGateBf16 {
    static constexpr bool PERM = true, AFTER_DRAIN = false;
    bf16_t* O; int ldc; const float* gate; int gstride; int rows_per_batch;
    __device__ __forceinline__ void operator()(const f32x4 (&acc)[2][2][4][2], const Unit& u, int wr, int wc, int fr, int fq) const {
        const int row0 = u.pm * BM + wr * 64 + fr; const int col0 = u.pn * BM + wc * 32 + 8 * fq;
        const float* gp = gate + (size_t)((u.pm * BM) / rows_per_batch) * gstride + col0;
        f32x4 gv[2][2];
#pragma unroll
        for (int bj = 0; bj < 2; ++bj)
#pragma unroll
            for (int n = 0; n < 2; ++n) gv[bj][n] = *(const f32x4*)(gp + bj * HALF + 4 * n);
#pragma unroll
        for (int ai = 0; ai < 2; ++ai)
#pragma unroll
            for (int m = 0; m < 4; ++m) { bf16_t* rowp = O + (size_t)(row0 + ai * HALF + m * 16) * ldc + col0;
#pragma unroll
                for (int bj = 0; bj < 2; ++bj) { const f32x4 v0 = acc[ai][bj][m][0] * gv[bj][0], v1 = acc[ai][bj][m][1] * gv[bj][1];
                    u32x4 w; w.x = cvt_pk_bf16(v0[0], v0[1]); w.y = cvt_pk_bf16(v0[2], v0[3]); w.z = cvt_pk_bf16(v1[0], v1[1]); w.w = cvt_pk_bf16(v1[2], v1[3]);
                    *(u32x4*)(rowp + bj * HALF) = w; } }
    }
};
struct EpiResid {
    static constexpr bool PERM = false, AFTER_DRAIN = false;
    const float* base; float* out; int ldc; const float* gate; int gstride; int rows_per_batch;
    __device__ __forceinline__ void operator()(const f32x4 (&acc)[2][2][4][2], const Unit& u, int wr, int wc, int fr, int fq) const {
        const int row0 = u.pm * BM + wr * 64 + fr; const int col0 = u.pn * BM + wc * 32 + 4 * fq;
        const float* gp = gate + (size_t)((u.pm * BM) / rows_per_batch) * gstride + col0;
        f32x4 gv[2][2];
#pragma unroll
        for (int bj = 0; bj < 2; ++bj)
#pragma unroll
            for (int n = 0; n < 2; ++n) gv[bj][n] = *(const f32x4*)(gp + bj * HALF + n * 16);
#pragma unroll
        for (int ai = 0; ai < 2; ++ai)
#pragma unroll
            for (int m = 0; m < 4; ++m) { const size_t off = (size_t)(row0 + ai * HALF + m * 16) * ldc + col0;
#pragma unroll
                for (int bj = 0; bj < 2; ++bj)
#pragma unroll
                    for (int n = 0; n < 2; ++n) { const f32x4 bs = *(const f32x4*)(base + off + bj * HALF + n * 16);
                        *(f32x4*)(out + off + bj * HALF + n * 16) = bs + gv[bj][n] * acc[ai][bj][m][n]; } }
    }
};

template <class Epi, class Sched, bool ALIGN_EPI = false, bool SP2 = false>
__device__ __forceinline__ void gemm_phase(PG8_LAS unsigned char* lds, const Gemm g, const Sched& S, const Epi& E) {
    const int tid = threadIdx.x, wid = __builtin_amdgcn_readfirstlane(tid >> 6), lane = tid & 63, wr = wid >> 2, wc = wid & 3, fr = lane & 15, fq = lane >> 4;
    const int K = g.K, nt = K / BK;
    unsigned voffA[2], voffB[2];
#pragma unroll
    for (int i = 0; i < 2; ++i) { int R, C; stage_rc(tid * 16 + i * 8192, R, C); const int Rb = Epi::PERM ? ((R & ~31) + perm32(R & 31)) : R;
        voffA[i] = (unsigned)(R * K + C) * 2u; voffB[i] = (unsigned)(Rb * K + C) * 2u; }
    const size_t kstep = (size_t)(BK * 2);
    const size_t hstep = (size_t)HALF * K * 2;
    const size_t tstep = 2 * hstep;
    const unsigned ldsw = (unsigned)wid * 1024u;
    const int aoff = lds_byte(wr * 64 + fr, fq * 8), boff = lds_byte(wc * 32 + fr, fq * 8);
#define PG8_SA(b, h) (((b) * 2 + (h)) * HTB)
#define PG8_SB(b, h) ((4 + (b) * 2 + (h)) * HTB)
#define PG8_STAGE(bufoff, gbase, voff) do { _Pragma("unroll") for (int _i = 0; _i < 2; ++_i) \
        __builtin_amdgcn_global_load_lds((const unsigned*)((const char*)(gbase) + (voff)[_i]), (PG8_LAS unsigned*)(lds + (bufoff) + ldsw + _i * 8192), 16, 0, 0); } while (0)
#define PG8_LDA(dst, b, h) do { _Pragma("unroll") for (int m = 0; m < 4; ++m) _Pragma("unroll") for (int k = 0; k < 2; ++k) dst[m][k] = *(const PG8_LAS bf16x8*)(lds + PG8_SA(b, h) + aoff + m * 2048 + k * 1024); } while (0)
#define PG8_LDB(dst, b, h) do { _Pragma("unroll") for (int n = 0; n < 2; ++n) _Pragma("unroll") for (int k = 0; k < 2; ++k) dst[n][k] = *(const PG8_LAS bf16x8*)(lds + PG8_SB(b, h) + boff + n * 2048 + k * 1024); } while (0)
#define PG8_MMA(ai, bj, At, Bt) do { __builtin_amdgcn_s_setprio(1); _Pragma("unroll") for (int m = 0; m < 4; ++m) _Pragma("unroll") for (int n = 0; n < 2; ++n) _Pragma("unroll") for (int k = 0; k < 2; ++k) \
        acc[ai][bj][m][n] = __builtin_amdgcn_mfma_f32_16x16x32_bf16(Bt[n][k], At[m][k], acc[ai][bj][m][n], 0, 0, 0); __builtin_amdgcn_s_setprio(0); } while (0)
#define PG8_WAIT_V(n) asm volatile("s_waitcnt vmcnt(" #n ")" ::: "memory")
#define PG8_WAIT_L(n) asm volatile("s_waitcnt lgkmcnt(" #n ")" ::: "memory")
#define PG8_BAR __builtin_amdgcn_s_barrier()
#define PG8_SCHED __builtin_amdgcn_sched_barrier(0)
    Unit cur, nxt; int ui = 0;
    if (!S.next(0, cur)) return;
    f32x4 acc[2][2][4][2];
#pragma unroll
    for (int a = 0; a < 2; ++a)
#pragma unroll
        for (int b = 0; b < 2; ++b)
#pragma unroll
            for (int m = 0; m < 4; ++m)
#pragma unroll
                for (int n = 0; n < 2; ++n) acc[a][b][m][n] = (f32x4){0.f, 0.f, 0.f, 0.f};
    bf16x8 At[4][2], B0[2][2], B1[2][2];
    const char* cA = (const char*)g.A + (size_t)cur.pm * tstep; const char* cB = (const char*)g.Bt + (size_t)cur.pn * tstep;
    S.a_ready(cur);
    if constexpr (SP2) {
        PG8_STAGE(PG8_SB(0, 0), cB, voffB); PG8_STAGE(PG8_SB(0, 1), cB + hstep, voffB); PG8_STAGE(PG8_SA(0, 0), cA, voffA); PG8_STAGE(PG8_SA(0, 1), cA + hstep, voffA);
        if (wr == 1) PG8_BAR;
        PG8_WAIT_V(2); PG8_BAR;
        PG8_STAGE(PG8_SB(1, 0), cB + kstep, voffB); PG8_STAGE(PG8_SA(1, 0), cA + kstep, voffA); PG8_STAGE(PG8_SB(1, 1), cB + hstep + kstep, voffB);
        PG8_WAIT_V(6); PG8_BAR;
    } else {
        PG8_STAGE(PG8_SB(0, 0), cB, voffB); PG8_STAGE(PG8_SA(0, 0), cA, voffA); PG8_STAGE(PG8_SB(0, 1), cB + hstep, voffB); PG8_STAGE(PG8_SA(0, 1), cA + hstep, voffA);
        if (wr == 1) PG8_BAR;
        PG8_WAIT_V(4); PG8_BAR;
        PG8_STAGE(PG8_SB(1, 0), cB + kstep, voffB); PG8_STAGE(PG8_SA(1, 0), cA + kstep, voffA); PG8_STAGE(PG8_SB(1, 1), cB + hstep + kstep, voffB);
        PG8_WAIT_V(6); PG8_BAR;
    }
    for (;;) {
        const bool has_next = S.next(ui + 1, nxt);
        const char* nA = has_next ? (const char*)g.A + (size_t)nxt.pm * tstep : cA; const char* nB = has_next ? (const char*)g.Bt + (size_t)nxt.pn * tstep : cB;
        for (int t = 0; t < nt; t += 2) {
            const bool last = (t == nt - 2);
            const char* a1 = cA + (size_t)(t + 1) * kstep;
            const char* a2 = last ? nA : cA + (size_t)(t + 2) * kstep; const char* b2 = last ? nB : cB + (size_t)(t + 2) * kstep;
            const char* a3 = a2 + kstep; const char* b3 = b2 + kstep;
            if (last && has_next) S.a_ready(nxt);
            if constexpr (SP2) {
            PG8_LDB(B0, 0, 0); PG8_LDB(B1, 0, 1); PG8_SCHED; PG8_LDA(At, 0, 0); PG8_STAGE(PG8_SA(1, 1), a1 + hstep, voffA);
            PG8_WAIT_V(8); PG8_WAIT_L(0); PG8_BAR; PG8_MMA(0, 0, At, B0); PG8_MMA(0, 1, At, B1); PG8_BAR; PG8_SCHED;
            PG8_LDA(At, 0, 1); PG8_STAGE(PG8_SB(0, 0), b2, voffB); PG8_STAGE(PG8_SB(0, 1), b2 + hstep, voffB); PG8_STAGE(PG8_SA(0, 0), a2, voffA);
            PG8_WAIT_V(8); PG8_WAIT_L(0); PG8_BAR; PG8_MMA(1, 0, At, B0); PG8_MMA(1, 1, At, B1); PG8_BAR; PG8_SCHED;
            PG8_LDB(B0, 1, 0); PG8_LDB(B1, 1, 1); PG8_SCHED; PG8_LDA(At, 1, 0); PG8_STAGE(PG8_SA(0, 1), a2 + hstep, voffA);
            PG8_WAIT_V(8); PG8_WAIT_L(0); PG8_BAR; PG8_MMA(0, 0, At, B0); PG8_MMA(0, 1, At, B1); PG8_BAR; PG8_SCHED;
            PG8_LDA(At, 1, 1); PG8_STAGE(PG8_SB(1, 0), b3, voffB); PG8_STAGE(PG8_SB(1, 1), b3 + hstep, voffB); PG8_STAGE(PG8_SA(1, 0), a3, voffA);
            PG8_WAIT_V(8); PG8_WAIT_L(0); PG8_BAR; PG8_MMA(1, 0, At, B0); PG8_MMA(1, 1, At, B1); PG8_BAR; PG8_SCHED;
            } else {
            PG8_LDB(B0, 0, 0); PG8_SCHED; PG8_LDA(At, 0, 0); PG8_STAGE(PG8_SA(1, 1), a1 + hstep, voffA);
            PG8_WAIT_L(8); PG8_BAR; PG8_WAIT_L(0); PG8_MMA(0, 0, At, B0); PG8_BAR; PG8_SCHED;
            PG8_LDB(B1, 0, 1); PG8_STAGE(PG8_SB(0, 0), b2, voffB);
            PG8_BAR; PG8_WAIT_L(0); PG8_MMA(0, 1, At, B1); PG8_BAR;
            PG8_LDA(At, 0, 1); PG8_STAGE(PG8_SA(0, 0), a2, voffA);
            PG8_BAR; PG8_WAIT_L(0); PG8_MMA(1, 0, At, B0); PG8_BAR; PG8_SCHED;
            PG8_STAGE(PG8_SB(0, 1), b2 + hstep, voffB);
            PG8_WAIT_V(6); PG8_BAR; PG8_MMA(1, 1, At, B1); PG8_BAR;
            PG8_LDB(B0, 1, 0); PG8_SCHED; PG8_LDA(At, 1, 0); PG8_STAGE(PG8_SA(0, 1), a2 + hstep, voffA);
            PG8_WAIT_L(8); PG8_BAR; PG8_WAIT_L(0); PG8_MMA(0, 0, At, B0); PG8_BAR; PG8_SCHED;
            PG8_LDB(B1, 1, 1); PG8_STAGE(PG8_SB(1, 0), b3, voffB);
            PG8_BAR; PG8_WAIT_L(0); PG8_MMA(0, 1, At, B1); PG8_BAR;
            PG8_LDA(At, 1, 1); PG8_STAGE(PG8_SA(1, 0), a3, voffA);
            PG8_BAR; PG8_WAIT_L(0); PG8_MMA(1, 0, At, B0); PG8_BAR; PG8_SCHED;
            PG8_STAGE(PG8_SB(1, 1), b3 + hstep, voffB);
            PG8_WAIT_V(6); PG8_BAR; PG8_MMA(1, 1, At, B1); PG8_BAR;
            }
        }
        if constexpr (ALIGN_EPI) { if (wr == 0) PG8_BAR; }
        if constexpr (!Epi::AFTER_DRAIN) { E(acc, cur, wr, wc, fr, fq); S.done(cur); }
        if (!has_next) break;
#pragma unroll
        for (int a = 0; a < 2; ++a)
#pragma unroll
            for (int b = 0; b < 2; ++b)
#pragma unroll
                for (int m = 0; m < 4; ++m)
#pragma unroll
                    for (int n = 0; n < 2; ++n) acc[a][b][m][n] = (f32x4){0.f, 0.f, 0.f, 0.f};
        cur = nxt; cA = nA; cB = nB; ++ui;
        if constexpr (ALIGN_EPI) { if (wr == 1) PG8_BAR; }
    }
    PG8_WAIT_V(0);
    if constexpr (!ALIGN_EPI) { if (wr == 0) PG8_BAR; }
    PG8_BAR;
#undef PG8_SA
#undef PG8_SB
#undef PG8_STAGE
#undef PG8_LDA
#undef PG8_LDB
#undef PG8_MMA
#undef PG8_WAIT_V
#undef PG8_WAIT_L
#undef PG8_BAR
#undef PG8_SCHED
}
}

constexpr int NWAVES = 8, NTHREADS = 512;
constexpr int BATCH = 8, SEQ = 4096, D = 1024, T = BATCH * SEQ;
constexpr int NIN = 2304, NQ = 2048, NEXP = 16384;
constexpr int C_B = 0, C_C = 512, C_H = 1024, C_Q = 1536, C_K = 2048, C_V = 2176;
constexpr float EPS = 1e-6f;
constexpr size_t MiB = 1u << 20;
constexpr size_t WS_CTL = 0;
constexpr size_t WS_MOD = 1 * MiB;
constexpr size_t WS_BIAS = WS_MOD + 256 * 1024;
constexpr size_t WS_WIN = 2 * MiB;
constexpr size_t WS_WOUT = 7 * MiB;
constexpr size_t WS_WQ = 9 * MiB;
constexpr size_t WS_KEYS = 13 * MiB;
constexpr size_t WS_SU = WS_MOD + 384 * 1024;
constexpr size_t WS_SV = WS_MOD + 448 * 1024;
constexpr size_t WS_U = 14 * MiB;
constexpr size_t WS_V = 30 * MiB;
constexpr size_t WS_H = 78 * MiB;
constexpr size_t WS_MIX = 142 * MiB;
constexpr size_t WS_H4 = WS_MIX + 16 * MiB;
constexpr size_t WS_ST = WS_MOD + 512 * 1024;
constexpr size_t WS_CP = WS_MIX + 48 * MiB;
constexpr size_t WS_CS = WS_MOD + 640 * 1024;
constexpr size_t WS_PACK = WS_MIX;
constexpr size_t WS_PROJ = 206 * MiB;
constexpr size_t WS_PART = WS_PROJ;
constexpr size_t WS_EIDX = 350 * MiB;
constexpr size_t WS_GATE = 366 * MiB;
constexpr size_t WS_DELTA = 382 * MiB;
constexpr size_t WS_END = 510 * MiB;

constexpr int LDS_BYTES = 147456;

#define GAS __attribute__((address_space(1)))
#define LAS __attribute__((address_space(3)))
typedef unsigned short bf16;
typedef unsigned v4u __attribute__((ext_vector_type(4)));
typedef unsigned v2u __attribute__((ext_vector_type(2)));
typedef float f32x4 __attribute__((ext_vector_type(4)));
typedef float f32x16 __attribute__((ext_vector_type(16)));
typedef short bf16x8 __attribute__((ext_vector_type(8)));
typedef int v8i __attribute__((ext_vector_type(8)));

__device__ __forceinline__ unsigned f2bf(float f) { unsigned u = __builtin_bit_cast(unsigned, f); return (u + 0x7fffu + ((u >> 16) & 1u)) >> 16; }
__device__ __forceinline__ unsigned pk2(float lo, float hi) { unsigned r; asm("v_cvt_pk_bf16_f32 %0, %1, %2" : "=v"(r) : "v"(lo), "v"(hi)); return r; }
__device__ __forceinline__ float bf_lo(unsigned w) { return __builtin_bit_cast(float, w << 16); }
__device__ __forceinline__ float bf_hi(unsigned w) { return __builtin_bit_cast(float, w & 0xffff0000u); }
__device__ __forceinline__ float wave_sum(float v) {
#pragma unroll
    for (int o = 1; o < 64; o <<= 1) v += __shfl_xor(v, o);
    return v;
}

#define XB_TMO      128
#define XB_XCNT(j)  (256  + 64 * (j))
#define XB_XSUB(j)  (1280 + 64 * (j))
#define XB_XGEN(j)  (2304 + 64 * (j))
#define XB_TOP      3328
#define XB_TOPGEN   3392
#define XCD_BAR_WORDS 3456
#define XB_SPIN_CAP (1u << 18)
__device__ __forceinline__ unsigned xb_ld(unsigned* p)              { return __hip_atomic_load(p, __ATOMIC_RELAXED, __HIP_MEMORY_SCOPE_AGENT); }
__device__ __forceinline__ unsigned xb_add(unsigned* p, unsigned v) { return __hip_atomic_fetch_add(p, v, __ATOMIC_RELAXED, __HIP_MEMORY_SCOPE_AGENT); }
__device__ __forceinline__ unsigned xb_xcc_id() { return (unsigned)__builtin_amdgcn_s_getreg((3 << 11) | 20) & 0xFu; }
#define XB_SPIN(cond, bar) do { unsigned _sp = 0; while (cond) { __builtin_amdgcn_s_sleep(1); \
    if ((++_sp & 255u) == 0u) { if (xb_ld(&(bar)[XB_TMO])) break; if (_sp > XB_SPIN_CAP) { atomicAdd(&(bar)[XB_TMO], 1u); break; } } } } while (0)
struct XcdBarrier { unsigned* bar; unsigned x; volatile LAS unsigned* st; };
__device__ __forceinline__ XcdBarrier xcd_barrier_post(unsigned* bar, volatile LAS unsigned* st) {
    XcdBarrier b; b.bar = bar; b.x = xb_xcc_id(); b.st = st;
    if (threadIdx.x == 0) (void)xb_add(&bar[XB_XCNT(b.x)], 1u);
    return b;
}
__device__ __forceinline__ void xcd_barrier_complete(unsigned* bar, unsigned x, unsigned& nloc, unsigned& nx) {
    const unsigned G = gridDim.x * gridDim.y * gridDim.z;
    unsigned sum, cnt, mine, sp = 0u;
    for (;;) {
        sum = 0u; cnt = 0u; mine = 0u;
#pragma unroll
        for (unsigned j = 0; j < 16; ++j) { const unsigned c = xb_ld(&bar[XB_XCNT(j)]); sum += c; cnt += (c > 0u) ? 1u : 0u; mine = (j == x) ? c : mine; }
        if (sum == G) break;
        __builtin_amdgcn_s_sleep(1);
        if ((++sp & 255u) == 0u) { if (xb_ld(&bar[XB_TMO])) break; if (sp > XB_SPIN_CAP) { atomicAdd(&bar[XB_TMO], 1u); break; } }
    }
    nloc = mine > 0u ? mine : 1u; nx = cnt > 0u ? cnt : 1u;
}
__device__ __forceinline__ void xcd_barrier(const XcdBarrier& b) {
    asm volatile("s_waitcnt vmcnt(0)" ::: "memory");
    __syncthreads();
    if (threadIdx.x == 0) {
        unsigned* bar = b.bar;
        __builtin_amdgcn_s_waitcnt(0);
        unsigned nloc = b.st[0], nx = b.st[1];
        if (nloc == 0u) { xcd_barrier_complete(bar, b.x, nloc, nx); b.st[0] = nloc; b.st[1] = nx; }
        const unsigned old = xb_add(&bar[XB_XSUB(b.x)], 1u);
        const unsigned gen = old / nloc;
        if (old + 1u == (gen + 1u) * nloc) {
            __builtin_amdgcn_fence(__ATOMIC_RELEASE, "agent");
            asm volatile("s_waitcnt vmcnt(0)" ::: "memory");
            const unsigned og = xb_add(&bar[XB_TOP], 1u);
            const unsigned tg = og / nx;
            if (og + 1u == (tg + 1u) * nx) xb_add(&bar[XB_TOPGEN], 1u);
            else XB_SPIN(xb_ld(&bar[XB_TOPGEN]) == tg, bar);
            __builtin_amdgcn_fence(__ATOMIC_ACQUIRE, "agent");
            xb_add(&bar[XB_XGEN(b.x)], 1u);
            asm volatile("s_waitcnt vmcnt(0)" ::: "memory");
        } else {
            XB_SPIN(xb_ld(&bar[XB_XGEN(b.x)]) == gen, bar);
            __builtin_amdgcn_fence(__ATOMIC_ACQUIRE, "agent");
            asm volatile("s_waitcnt vmcnt(0)" ::: "memory");
        }
    }
    __syncthreads();
}

struct Args {
    const float *x, *c, *w_ada, *b_ada, *norm1_g, *w_in, *conv_w, *q_norm_g, *k_norm_g, *sinks, *rel_bias, *conv_out_g, *attn_out_g, *w_out, *norm2_g, *peer_wq, *peer_keys, *peer_u, *peer_v;
    float* out; unsigned char* ws; int ph_lo, ph_hi, var, pad;
};

struct Frame {
    LAS unsigned char* lds; int tid, lane, wave, G, bid;
    int sl_x, sl_rank, sl_n;
};

__device__ __forceinline__ void mod_item(const Args& a, Frame& F, int item) {
    LAS float* sc = (LAS float*)F.lds;
    LAS float* red = (LAS float*)(F.lds + 32768);
    for (int i = F.tid; i < 8192; i += NTHREADS) { const float v = a.c[i]; sc[i] = v / (1.f + __expf(-v)); }
    __syncthreads();
    const int cl = F.tid & 31, kg = F.tid >> 5, col = item * 32 + cl;
    float acc[8];
#pragma unroll
    for (int b = 0; b < 8; ++b) acc[b] = 0.f;
#pragma unroll 1
    for (int k0 = kg * 64; k0 < kg * 64 + 64; k0 += 32) { float w[32];
#pragma unroll
        for (int i = 0; i < 32; ++i) w[i] = a.w_ada[(size_t)(k0 + i) * 6144 + col];
#pragma unroll
        for (int i = 0; i < 32; ++i)
#pragma unroll
            for (int b = 0; b < 8; ++b) acc[b] += sc[b * 1024 + k0 + i] * w[i]; }
#pragma unroll
    for (int b = 0; b < 8; ++b) red[(kg * 32 + cl) * 8 + b] = acc[b];
    __syncthreads();
    if (F.tid < 256) { const int b = F.tid >> 5; float s = 0.f;
#pragma unroll
      for (int g = 0; g < 16; ++g) s += red[(g * 32 + cl) * 8 + b];
      ((float*)(a.ws + WS_MOD))[b * 6144 + col] = s + a.b_ada[col]; }
    __syncthreads();
}
__device__ __forceinline__ void transpose_item(const float* W, int K, int N, bf16* WT, LAS float* scr, int item, int lane) {
    const int nblk = N / 32, kb = item / nblk, nb = item % nblk, k0 = 64 * kb, n0 = 32 * nb;
    { float wv[32];
#pragma unroll
      for (int i = 0; i < 32; ++i) wv[i] = W[(size_t)(k0 + 2 * i + (lane >> 5)) * N + n0 + (lane & 31)];
#pragma unroll
      for (int i = 0; i < 32; ++i) scr[(2 * i + (lane >> 5)) * 33 + (lane & 31)] = wv[i]; }
    asm volatile("s_waitcnt lgkmcnt(0)" ::: "memory");
    const int c = lane & 7;
#pragma unroll
    for (int j = 0; j < 4; ++j) { const int n = (lane >> 3) + 8 * j; const LAS float* s = scr + (8 * c) * 33 + n;
        v4u o; o.x = pk2(s[0 * 33], s[1 * 33]); o.y = pk2(s[2 * 33], s[3 * 33]); o.z = pk2(s[4 * 33], s[5 * 33]); o.w = pk2(s[6 * 33], s[7 * 33]);
        *(v4u*)(WT + (size_t)(n0 + n) * K + k0 + 8 * c) = o; }
    asm volatile("s_waitcnt lgkmcnt(0)" ::: "memory");
}
__device__ __forceinline__ void cvt_rows(const float* src, bf16* dst, size_t n8, size_t gtid, size_t gn) {
    for (size_t i = gtid; i < n8; i += gn) { const f32x4 a = ((const f32x4*)src)[2 * i], b = ((const f32x4*)src)[2 * i + 1];
        v4u o; o.x = pk2(a.x, a.y); o.y = pk2(a.z, a.w); o.z = pk2(b.x, b.y); o.w = pk2(b.z, b.w); ((v4u*)dst)[i] = o; }
}
__device__ __forceinline__ void quant_tables(const Args& a, Frame& F, int widx, int nw) {
    for (int r0 = 4 * widx; r0 < 2 * NEXP; r0 += 4 * nw) {
        const bool isv = r0 >= NEXP; const int e0 = isv ? r0 - NEXP : r0;
        const float* tab = isv ? a.peer_v : a.peer_u;
        f32x4 v[4][4];
#pragma unroll
        for (int r = 0; r < 4; ++r) { const f32x4* src = (const f32x4*)(tab + (size_t)(e0 + r) * D) + F.lane;
#pragma unroll
            for (int j = 0; j < 4; ++j) v[r][j] = src[64 * j]; }
#pragma unroll
        for (int r = 0; r < 4; ++r) { float mx = 0.f;
#pragma unroll
            for (int j = 0; j < 4; ++j) mx = fmaxf(mx, fmaxf(fmaxf(fabsf(v[r][j].x), fabsf(v[r][j].y)), fmaxf(fabsf(v[r][j].z), fabsf(v[r][j].w))));
#pragma unroll
            for (int o = 1; o < 64; o <<= 1) mx = fmaxf(mx, __shfl_xor(mx, o));
            float ssq = 0.f;
#pragma unroll
            for (int j = 0; j < 4; ++j) ssq += (v[r][j].x * v[r][j].x + v[r][j].y * v[r][j].y) + (v[r][j].z * v[r][j].z + v[r][j].w * v[r][j].w);
            ssq = wave_sum(ssq);
            const float rms = sqrtf(ssq * (1.f / D));
            const float scale = mx > 0.f ? (isv ? fminf(mx, 3.0f * rms) * (1.f / 6.f) : fminf(mx, 2.5f * rms) * (1.f / 7.f)) : 1.f, inv = 1.f / scale;
            unsigned char* dst = a.ws + (isv ? WS_V : WS_U) + (size_t)(e0 + r) * 128 + 2 * F.lane;
#pragma unroll
            for (int j = 0; j < 4; ++j) { unsigned w;
                if (isv) { const float y0 = fminf(fmaxf(v[r][j].x * inv, -6.f), 6.f), y1 = fminf(fmaxf(v[r][j].y * inv, -6.f), 6.f), y2 = fminf(fmaxf(v[r][j].z * inv, -6.f), 6.f), y3 = fminf(fmaxf(v[r][j].w * inv, -6.f), 6.f);
                    w = __builtin_amdgcn_cvt_scalef32_pk_fp4_f32(0u, y0, y1, 1.0f, 0); w = __builtin_amdgcn_cvt_scalef32_pk_fp4_f32(w, y2, y3, 1.0f, 1); }
                else { w = 0u;
#pragma unroll
                    for (int c = 0; c < 4; ++c) { const int qi = (int)fminf(fmaxf(rintf(v[r][j][c] * inv), -7.f), 7.f); w |= ((unsigned)qi & 15u) << (4 * c); } }
                *(unsigned short*)(dst + (size_t)j * (2 * MiB)) = (unsigned short)w; }
            if (F.lane == 0) ((float*)(a.ws + (isv ? WS_SV : WS_SU)))[e0 + r] = scale; }
    }
}
__device__ __forceinline__ void prep_rest(const Args& a, Frame& F) {
    LAS float* scr = (LAS float*)(F.lds + 65536 + F.wave * 8448);
    const int gw = F.bid * NWAVES + F.wave, NGW = F.G * NWAVES;
    constexpr int I_IN = (D / 64) * (NIN / 32), I_OUT = (D / 64) * (D / 32), I_Q = (D / 64) * (NQ / 32);
    for (int it = gw; it < I_IN + I_OUT + I_Q; it += NGW) {
        int r = it;
        if (r < I_IN) { transpose_item(a.w_in, D, NIN, (bf16*)(a.ws + WS_WIN), scr, r, F.lane); continue; } r -= I_IN;
        if (r < I_OUT) { transpose_item(a.w_out, D, D, (bf16*)(a.ws + WS_WOUT), scr, r, F.lane); continue; } r -= I_OUT;
        transpose_item(a.peer_wq, D, NQ, (bf16*)(a.ws + WS_WQ), scr, r, F.lane);
    }
    const size_t gtid = (size_t)F.bid * NTHREADS + F.tid, gn = (size_t)F.G * NTHREADS;
    cvt_rows(a.peer_keys, (bf16*)(a.ws + WS_KEYS), (size_t)2 * 8 * 128 * 128 / 8, gtid, gn);
    if (F.bid == 0) { for (int i = F.tid; i < 1024; i += NTHREADS) { const int h = i >> 7, dist = i & 127; int bk;
            if (dist < 16) bk = dist; else { bk = 16 + (int)(__logf((float)dist * (1.f / 16.f)) / 2.0794415416798357f * 16.f); bk = bk < 31 ? bk : 31; }
            ((float*)(a.ws + WS_BIAS))[i] = a.rel_bias[bk * 8 + h]; } }
}
template <bool ADD_DELTA, int RIF>
__device__ __forceinline__ void modnorm_rows(const Args& a, Frame& F, const float* src, const float* g, int sh_off, int sc_off) {
    const int gw = F.bid * NWAVES + F.wave, NGW = F.G * NWAVES;
    const float* mod = (const float*)(a.ws + WS_MOD);
    bf16* H = (bf16*)(a.ws + WS_H);
    for (int m0 = 16 * gw; m0 < T; m0 += 16 * NGW) {
        const float* mb = mod + (size_t)(m0 / SEQ) * 6144;
        f32x4 gam[4], sh[4];
#pragma unroll
        for (int j = 0; j < 4; ++j) { const int col = 4 * F.lane + 256 * j; gam[j] = *(const f32x4*)(g + col) * (*(const f32x4*)(mb + sc_off + col) + 1.f); sh[j] = *(const f32x4*)(mb + sh_off + col); }
#pragma unroll 1
        for (int r0 = 0; r0 < 16; r0 += RIF) {
            f32x4 v[RIF][4]; v2u dl[RIF][4];
#pragma unroll
            for (int r = 0; r < RIF; ++r) { const f32x4* xr = (const f32x4*)(src + (size_t)(m0 + r0 + r) * D) + F.lane;
                const v2u* dr = (const v2u*)((const bf16*)(a.ws + WS_DELTA) + (size_t)(m0 + r0 + r) * D) + F.lane;
#pragma unroll
                for (int j = 0; j < 4; ++j) { v[r][j] = xr[64 * j]; if (ADD_DELTA) dl[r][j] = dr[64 * j]; } }
#pragma unroll
            for (int r = 0; r < RIF; ++r) { float s = 0.f;
                if (ADD_DELTA) {
#pragma unroll
                    for (int j = 0; j < 4; ++j) { v[r][j].x += bf_lo(dl[r][j].x); v[r][j].y += bf_hi(dl[r][j].x); v[r][j].z += bf_lo(dl[r][j].y); v[r][j].w += bf_hi(dl[r][j].y); } }
#pragma unroll
                for (int j = 0; j < 4; ++j) s += (v[r][j].x * v[r][j].x + v[r][j].y * v[r][j].y) + (v[r][j].z * v[r][j].z + v[r][j].w * v[r][j].w);
                const float rstd = rsqrtf(wave_sum(s) * (1.f / D) + EPS);
                v2u* o8 = (v2u*)(H + (size_t)(m0 + r0 + r) * D) + F.lane;
                f32x4 y[4]; float am = 0.f;
#pragma unroll
                for (int j = 0; j < 4; ++j) { y[j] = v[r][j] * rstd * gam[j] + sh[j]; v2u w; w.x = pk2(y[j].x, y[j].y); w.y = pk2(y[j].z, y[j].w); o8[64 * j] = w;
                    am = fmaxf(am, fmaxf(fmaxf(fabsf(y[j].x), fabsf(y[j].y)), fmaxf(fabsf(y[j].z), fabsf(y[j].w)))); }
                if (ADD_DELTA) {
#pragma unroll
                    for (int o = 1; o < 64; o <<= 1) am = fmaxf(am, __shfl_xor(am, o));
                    const float st = am > 0.f ? am * (1.f / 7.f) : 1.f, ist = 1.f / st;
                    unsigned char* hp = a.ws + WS_H4 + (size_t)(m0 + r0 + r) * 1024 + 2 * F.lane;
#pragma unroll
                    for (int j = 0; j < 4; ++j) { unsigned w0 = 0u, w1 = 0u;
#pragma unroll
                        for (int c = 0; c < 4; ++c) { const float rr = y[j][c] * ist; const float d0 = fminf(fmaxf(rintf(rr), -7.f), 7.f); const float d1 = fminf(fmaxf(rintf((rr - d0) * 16.f), -8.f), 7.f);
                            w0 |= ((unsigned)(int)d0 & 15u) << (4 * c); w1 |= ((unsigned)(int)d1 & 15u) << (4 * c); }
                        *(unsigned short*)(hp + 128 * j) = (unsigned short)w0; *(unsigned short*)(hp + 512 + 128 * j) = (unsigned short)w1; }
                    if (F.lane == 0) ((float*)(a.ws + WS_ST))[m0 + r0 + r] = st; } }
        }
    }
}

constexpr int KS_STRIDE = 72, VT_STRIDE = 260;
constexpr int ATT_KS = 0, ATT_VT = 256 * KS_STRIDE * 2, ATT_BIAS = ATT_VT + 64 * VT_STRIDE * 2;
__device__ __forceinline__ void attn_unit(const Args& a, Frame& F, int unit, int pv = 0) {
    const int kvh = unit & 1, nb = (unit >> 1) & 31, b = unit >> 6;
    const bf16* PROJ = (const bf16*)(a.ws + WS_PROJ);
    bf16* MIX = (bf16*)(a.ws + WS_MIX);
    LAS bf16* Ks = (LAS bf16*)(F.lds + ATT_KS); LAS bf16* Vt = (LAS bf16*)(F.lds + ATT_VT); LAS float* bl = (LAS float*)(F.lds + ATT_BIAS);
    const int g = F.wave & 3, hq = kvh * 4 + g, hh = F.lane >> 5, l31 = F.lane & 31;
    v4u qraw[2][4];
#pragma unroll
    for (int qq = 0; qq < 2; ++qq) { const int qi = 32 * ((F.wave >> 2) * 2 + qq) + l31; const size_t tok = (size_t)b * SEQ + nb * 128 + qi;
#pragma unroll
        for (int ks = 0; ks < 4; ++ks) qraw[qq][ks] = *(const v4u*)(PROJ + tok * NIN + C_Q + hq * 64 + 16 * ks + 8 * hh); }
    if (pv != 2) {
        const int key = F.tid >> 1, half = F.tid & 1; const bool valid = (nb > 0) || (key >= 128);
        const size_t tok = (size_t)b * SEQ + nb * 128 - 128 + key;
        v4u kr[4], vr[4];
#pragma unroll
        for (int i = 0; i < 4; ++i) { kr[i] = (v4u){0u, 0u, 0u, 0u}; vr[i] = kr[i]; }
        if (valid) {
            const v4u* kp = (const v4u*)(PROJ + tok * NIN + C_K + kvh * 64 + 32 * half);
            const v4u* vp = (const v4u*)(PROJ + tok * NIN + C_V + kvh * 64 + 32 * half);
#pragma unroll
            for (int i = 0; i < 4; ++i) { kr[i] = kp[i]; vr[i] = vp[i]; }
        }
        float ss = 0.f;
#pragma unroll
        for (int i = 0; i < 4; ++i) {
#pragma unroll
            for (int e = 0; e < 4; ++e) { const float lo = bf_lo(kr[i][e]), hi = bf_hi(kr[i][e]); ss += lo * lo + hi * hi; } }
        ss += __shfl_xor(ss, 1);
        const float rstd = rsqrtf(ss * (1.f / 64.f) + EPS);
#pragma unroll
        for (int i = 0; i < 4; ++i) { v4u o;
#pragma unroll
            for (int e = 0; e < 4; ++e) { const int d = 32 * half + 8 * i + 2 * e;
                o[e] = pk2(bf_lo(kr[i][e]) * rstd * a.k_norm_g[d], bf_hi(kr[i][e]) * rstd * a.k_norm_g[d + 1]); }
            *(LAS v4u*)(Ks + key * KS_STRIDE + 32 * half + 8 * i) = o; }
#pragma unroll
        for (int i = 0; i < 4; ++i)
#pragma unroll
            for (int e = 0; e < 4; ++e) { const int d = 32 * half + 8 * i + 2 * e;
                Vt[d * VT_STRIDE + key] = (bf16)(vr[i][e] & 0xffffu); Vt[(d + 1) * VT_STRIDE + key] = (bf16)(vr[i][e] >> 16); }
        { const int g = F.tid >> 7, dist = F.tid & 127; bl[F.tid] = ((const float*)(a.ws + WS_BIAS))[(kvh * 4 + g) * 128 + dist]; }
        if (F.tid < 64) bl[512 + F.tid] = a.q_norm_g[F.tid]; else if (F.tid < 128) bl[512 + F.tid] = a.k_norm_g[F.tid - 64]; else if (F.tid < 384) bl[512 + F.tid] = a.attn_out_g[kvh * 256 + (F.tid - 128)];
    }
    __syncthreads();
    const float sink = a.sinks[hq];
#pragma unroll 1
    for (int qq = 0; qq < (pv == 1 ? 0 : 2); ++qq) {
        const int qt = (F.wave >> 2) * 2 + qq, qi = 32 * qt + l31;
        const size_t tok = (size_t)b * SEQ + nb * 128 + qi;
        bf16x8 qf[4];
        {
            v4u qr[4]; float ss = 0.f;
#pragma unroll
            for (int ks = 0; ks < 4; ++ks) { qr[ks] = qq ? qraw[1][ks] : qraw[0][ks];
#pragma unroll
                for (int e = 0; e < 4; ++e) { const float lo = bf_lo(qr[ks][e]), hi = bf_hi(qr[ks][e]); ss += lo * lo + hi * hi; } }
            ss += __shfl_xor(ss, 32);
            const float rstd = rsqrtf(ss * (1.f / 64.f) + EPS) * 0.125f;
#pragma unroll
            for (int ks = 0; ks < 4; ++ks) { v4u o;
#pragma unroll
                for (int e = 0; e < 4; ++e) { const int d = 16 * ks + 8 * hh + 2 * e;
                    o[e] = pk2(bf_lo(qr[ks][e]) * rstd * bl[512 + d], bf_hi(qr[ks][e]) * rstd * bl[512 + d + 1]); }
                qf[ks] = __builtin_bit_cast(bf16x8, o); }
        }
        f32x16 s[5];
#pragma unroll
        for (int k5 = 0; k5 < 5; ++k5) { const int kt = qt + k5;
            f32x16 acc;
#pragma unroll
            for (int r = 0; r < 16; ++r) acc[r] = 0.f;
#pragma unroll
            for (int ks = 0; ks < 4; ++ks) { const bf16x8 kf = *(const LAS bf16x8*)(Ks + (32 * kt + l31) * KS_STRIDE + 16 * ks + 8 * hh);
                acc = __builtin_amdgcn_mfma_f32_32x32x16_bf16(kf, qf[ks], acc, 0, 0, 0); }
            s[k5] = acc; }
        float mx = -INFINITY;
#pragma unroll
        for (int k5 = 0; k5 < 5; ++k5) { const float pen_tile = (nb == 0 && (qt + k5) < 4) ? -INFINITY : 0.f;
#pragma unroll
            for (int r = 0; r < 16; ++r) { const int kj = 32 * (qt + k5) + (r & 3) + 8 * (r >> 2) + 4 * hh; const int dist = qi + 128 - kj;
                float v = s[k5][r] + bl[g * 128 + (dist & 127)] + pen_tile;
                if (k5 == 0) v += (dist > 127) ? -INFINITY : 0.f;
                if (k5 == 4) v += (dist < 0) ? -INFINITY : 0.f;
                s[k5][r] = v; mx = fmaxf(mx, v); } }
        mx = fmaxf(mx, __shfl_xor(mx, 32)); mx = fmaxf(mx, sink);
        float ls = 0.f;
#pragma unroll
        for (int k5 = 0; k5 < 5; ++k5)
#pragma unroll
            for (int r = 0; r < 16; ++r) { const float p = __expf(s[k5][r] - mx); s[k5][r] = p; ls += p; }
        ls += __shfl_xor(ls, 32);
        const float inv = 1.f / (ls + __expf(sink - mx));
        f32x16 o[2];
#pragma unroll
        for (int dt = 0; dt < 2; ++dt)
#pragma unroll
            for (int r = 0; r < 16; ++r) o[dt][r] = 0.f;
#pragma unroll
        for (int k5 = 0; k5 < 5; ++k5)
#pragma unroll
            for (int s2 = 0; s2 < 2; ++s2) { const int kt = qt + k5;
                v4u pw; pw.x = pk2(s[k5][8 * s2 + 0], s[k5][8 * s2 + 1]); pw.y = pk2(s[k5][8 * s2 + 2], s[k5][8 * s2 + 3]); pw.z = pk2(s[k5][8 * s2 + 4], s[k5][8 * s2 + 5]); pw.w = pk2(s[k5][8 * s2 + 6], s[k5][8 * s2 + 7]);
                const bf16x8 pf = __builtin_bit_cast(bf16x8, pw);
#pragma unroll
                for (int dt = 0; dt < 2; ++dt) { const LAS bf16* vp = Vt + (32 * dt + l31) * VT_STRIDE + 32 * kt + 16 * s2 + 4 * hh;
                    const v2u v0 = *(const LAS v2u*)vp, v1 = *(const LAS v2u*)(vp + 8);
                    v4u vw; vw.x = v0.x; vw.y = v0.y; vw.z = v1.x; vw.w = v1.y;
                    o[dt] = __builtin_amdgcn_mfma_f32_32x32x16_bf16(__builtin_bit_cast(bf16x8, vw), pf, o[dt], 0, 0, 0); } }
        float ss = 0.f;
#pragma unroll
        for (int dt = 0; dt < 2; ++dt)
#pragma unroll
            for (int r = 0; r < 16; ++r) { o[dt][r] *= inv; ss += o[dt][r] * o[dt][r]; }
        ss += __shfl_xor(ss, 32);
        const float rstd = rsqrtf(ss * (1.f / 64.f) + EPS);
#pragma unroll
        for (int dt = 0; dt < 2; ++dt)
#pragma unroll
            for (int rq = 0; rq < 4; ++rq) { const int d = 32 * dt + 8 * rq + 4 * hh; const f32x4 gg = *(const LAS f32x4*)(bl + 640 + g * 64 + d);
                v2u w; w.x = pk2(o[dt][4 * rq + 0] * rstd * gg.x, o[dt][4 * rq + 1] * rstd * gg.y); w.y = pk2(o[dt][4 * rq + 2] * rstd * gg.z, o[dt][4 * rq + 3] * rstd * gg.w);
                *(v2u*)(MIX + tok * D + 512 + hq * 64 + d) = w; }
    }
    __syncthreads();
}
__device__ __forceinline__ void unpack8(const v4u r, float (&f)[8]) {
#pragma unroll
    for (int e = 0; e < 4; ++e) { f[2 * e] = bf_lo(r[e]); f[2 * e + 1] = bf_hi(r[e]); }
}
__device__ __forceinline__ void conv_unit(const Args& a, Frame& F, int unit) {
    const int nb = unit & 31, b = unit >> 5;
    const bf16* PROJ = (const bf16*)(a.ws + WS_PROJ);
    bf16* MIX = (bf16*)(a.ws + WS_MIX);
    const int ch = 8 * F.lane, pos0 = nb * 128 + 16 * F.wave;
    const size_t tok0 = (size_t)b * SEQ + pos0;
    float w0[8], w1[8], w2[8], gg[8], um2[8], um1[8];
#pragma unroll
    for (int e = 0; e < 8; ++e) { w0[e] = a.conv_w[ch + e]; w1[e] = a.conv_w[512 + ch + e]; w2[e] = a.conv_w[1024 + ch + e]; gg[e] = a.conv_out_g[ch + e]; um2[e] = 0.f; um1[e] = 0.f; }
    if (pos0 >= 2) {
        float c[8], h[8];
        unpack8(*(const v4u*)(PROJ + (tok0 - 2) * NIN + C_C + ch), c); unpack8(*(const v4u*)(PROJ + (tok0 - 2) * NIN + C_H + ch), h);
#pragma unroll
        for (int e = 0; e < 8; ++e) um2[e] = c[e] * h[e];
        unpack8(*(const v4u*)(PROJ + (tok0 - 1) * NIN + C_C + ch), c); unpack8(*(const v4u*)(PROJ + (tok0 - 1) * NIN + C_H + ch), h);
#pragma unroll
        for (int e = 0; e < 8; ++e) um1[e] = c[e] * h[e];
    }
#pragma unroll 1
    for (int i0 = 0; i0 < 16; i0 += 4) {
        v4u rb[4], rc[4], rh[4];
#pragma unroll
        for (int i = 0; i < 4; ++i) { const size_t tok = tok0 + i0 + i; rb[i] = *(const v4u*)(PROJ + tok * NIN + C_B + ch); rc[i] = *(const v4u*)(PROJ + tok * NIN + C_C + ch); rh[i] = *(const v4u*)(PROJ + tok * NIN + C_H + ch); }
#pragma unroll
        for (int i = 0; i < 4; ++i) { const size_t tok = tok0 + i0 + i;
            float bg[8], c[8], h[8], y[8]; float ss = 0.f;
            unpack8(rb[i], bg); unpack8(rc[i], c); unpack8(rh[i], h);
#pragma unroll
            for (int e = 0; e < 8; ++e) { const float u0 = c[e] * h[e]; y[e] = bg[e] * (w0[e] * um2[e] + w1[e] * um1[e] + w2[e] * u0); ss += y[e] * y[e]; um2[e] = um1[e]; um1[e] = u0; }
            ss += __shfl_xor(ss, 1); ss += __shfl_xor(ss, 2); ss += __shfl_xor(ss, 4);
            const float rstd = rsqrtf(ss * (1.f / 64.f) + EPS);
            v4u o;
#pragma unroll
            for (int e = 0; e < 4; ++e) o[e] = pk2(y[2 * e] * rstd * gg[2 * e], y[2 * e + 1] * rstd * gg[2 * e + 1]);
            *(v4u*)(MIX + tok * D + ch) = o; }
    }
}

#define CE_DESC(x, y) do { const unsigned _hi = (x) > (y) ? (x) : (y), _lo = (x) > (y) ? (y) : (x); (x) = _hi; (y) = _lo; } while (0)
__device__ __forceinline__ void sort16_desc(unsigned (&v)[16]) {
#define S16(i, j) CE_DESC(v[i], v[j]);
    S16(0, 1) S16(2, 3) S16(0, 2) S16(1, 3) S16(1, 2) S16(4, 5) S16(6, 7) S16(4, 6) S16(5, 7) S16(5, 6) S16(0, 4) S16(2, 6) S16(2, 4) S16(1, 5) S16(3, 7) S16(3, 5) S16(1, 2) S16(3, 4) S16(5, 6)
    S16(8, 9) S16(10, 11) S16(8, 10) S16(9, 11) S16(9, 10) S16(12, 13) S16(14, 15) S16(12, 14) S16(13, 15) S16(13, 14) S16(8, 12) S16(10, 14) S16(10, 12) S16(9, 13) S16(11, 15) S16(11, 13) S16(9, 10) S16(11, 12) S16(13, 14)
    S16(0, 8) S16(4, 12) S16(4, 8) S16(2, 10) S16(6, 14) S16(6, 10) S16(2, 4) S16(6, 8) S16(10, 12) S16(1, 9) S16(5, 13) S16(5, 9) S16(3, 11) S16(7, 15) S16(7, 11) S16(3, 5) S16(7, 9) S16(11, 13)
    S16(1, 2) S16(3, 4) S16(5, 6) S16(7, 8) S16(9, 10) S16(11, 12) S16(13, 14)
#undef S16
}
__device__ __forceinline__ void merge16_desc(unsigned (&x)[16], const unsigned (&y)[16]) {
#pragma unroll
    for (int i = 0; i < 16; ++i) x[i] = x[i] > y[15 - i] ? x[i] : y[15 - i];
#pragma unroll
    for (int j = 8; j > 0; j >>= 1)
#pragma unroll
        for (int i = 0; i < 16; ++i) if ((i & j) == 0) CE_DESC(x[i], x[i | j]);
}
constexpr int KEY_LDS_STRIDE = 136;
__device__ __forceinline__ void side_top16(const bf16* QP, const LAS bf16* KL, int tok0, int h, int s, int lane, unsigned (&top)[16]) {
    const int l31 = lane & 31, hh = lane >> 5;
    bf16x8 qf[8];
    const bf16* qp = QP + (size_t)(tok0 + l31) * NQ + h * 256 + s * 128 + 8 * hh;
#pragma unroll
    for (int ks = 0; ks < 8; ++ks) qf[ks] = *(const bf16x8*)(qp + 16 * ks);
    const LAS bf16* kp = KL + (s * 128 + l31) * KEY_LDS_STRIDE + 8 * hh;
#define SIDE_TILE(kt, dst) do { f32x16 acc; \
        _Pragma("unroll") for (int r = 0; r < 16; ++r) acc[r] = 0.f; \
        _Pragma("unroll") for (int ks = 0; ks < 8; ++ks) { const bf16x8 kf = *(const LAS bf16x8*)(kp + (32 * (kt)) * KEY_LDS_STRIDE + 16 * ks); \
            acc = __builtin_amdgcn_mfma_f32_32x32x16_bf16(kf, qf[ks], acc, 0, 0, 0); } \
        _Pragma("unroll") for (int r = 0; r < 16; ++r) { const int nn = 32 * (kt) + (r & 3) + 8 * (r >> 2) + 4 * hh; \
            int fx = (int)__builtin_fmaf(acc[r], 524288.f, 16777216.f); fx = fx < 0 ? 0 : (fx > (1 << 25) - 1 ? (1 << 25) - 1 : fx); \
            dst[r] = ((unsigned)fx << 7) | (unsigned)(127 - nn); } \
        sort16_desc(dst); } while (0)
    SIDE_TILE(0, top);
#pragma unroll 1
    for (int kt = 1; kt < 4; ++kt) { unsigned v[16]; SIDE_TILE(kt, v); merge16_desc(top, v); }
#undef SIDE_TILE
    unsigned oth[16];
#pragma unroll
    for (int i = 0; i < 16; ++i) oth[i] = (unsigned)__shfl_xor((int)top[i], 32);
    merge16_desc(top, oth);
}
__device__ __forceinline__ void topk_unit(const Args& a, Frame& F, int tile, int h) {
    const int tok0 = tile * 32;
    const bf16* QP = (const bf16*)(a.ws + WS_PROJ); const LAS bf16* KL = (const LAS bf16*)F.lds;
    unsigned ka[16], kb[16];
    side_top16(QP, KL, tok0, h, 0, F.lane, ka);
    side_top16(QP, KL, tok0, h, 1, F.lane, kb);
    unsigned c[4][16];
    int n = 0;
#pragma unroll
    for (int i = 0; i < 16; ++i)
#pragma unroll
        for (int j = 0; j < 16; ++j) if ((i + 1) * (j + 1) <= 16) {
            int sfx = (int)(ka[i] >> 7) + (int)(kb[j] >> 7) - (1 << 25);
            sfx = sfx < 0 ? 0 : (sfx > (1 << 23) - 1 ? (1 << 23) - 1 : sfx);
            const unsigned e = (127u - (ka[i] & 127u)) * 128u + (127u - (kb[j] & 127u));
            c[n >> 4][n & 15] = ((unsigned)(sfx >> 5) << 14) | (16383u - e); ++n; }
#pragma unroll
    for (; n < 64; ++n) c[n >> 4][n & 15] = 0u;
    sort16_desc(c[0]); sort16_desc(c[1]); sort16_desc(c[2]); CE_DESC(c[3][0], c[3][1]);
    merge16_desc(c[0], c[1]); merge16_desc(c[2], c[3]); merge16_desc(c[0], c[2]);
    float w[16]; float sum = 0.f; const float f0 = (float)(c[0][0] >> 14);
#pragma unroll
    for (int k = 0; k < 16; ++k) { w[k] = __expf(((float)(c[0][k] >> 14) - f0) * (1.f / 16384.f)); sum += w[k]; }
    const float inv = 1.f / sum;
    const int tok = tok0 + (F.lane & 31), hh = F.lane >> 5;
    int* ei = (int*)(a.ws + WS_EIDX) + (size_t)tok * 128 + h * 16 + 8 * hh;
    float* gt = (float*)(a.ws + WS_GATE) + (size_t)tok * 128 + h * 16 + 8 * hh;
    v4u e0, e1; f32x4 g0, g1;
#pragma unroll
    for (int k = 0; k < 4; ++k) { const unsigned x0 = hh ? c[0][8 + k] : c[0][k], x1 = hh ? c[0][12 + k] : c[0][4 + k];
        e0[k] = 16383u - (x0 & 16383u); e1[k] = 16383u - (x1 & 16383u);
        g0[k] = (hh ? w[8 + k] : w[k]) * inv; g1[k] = (hh ? w[12 + k] : w[4 + k]) * inv; }
    *(v4u*)ei = e0; *(v4u*)(ei + 4) = e1; *(f32x4*)gt = g0; *(f32x4*)(gt + 4) = g1;
}

__device__ __forceinline__ float gelu_tanh(float x) {
    const float u = 0.7978845608028654f * (x + 0.044715f * x * x * x);
    const float t = 1.f - 2.f / (1.f + __expf(2.f * u));
    return 0.5f * x * (1.f + t);
}
__device__ __forceinline__ void peer_coef(const Args& a, Frame& F) {
    const int gw = F.bid * NWAVES + F.wave, NGW = F.G * NWAVES, lane = F.lane;
    const float* SU = (const float*)(a.ws + WS_SU); const float* SV = (const float*)(a.ws + WS_SV);
    for (int t0 = 4 * gw; t0 < T; t0 += 4 * NGW) {
        float s0[4], s1[4], st[4]; int2 e[4]; float2 g[4]; float su0[4], su1[4], sv0[4], sv1[4];
#pragma unroll
        for (int k = 0; k < 4; ++k) { const int tok = t0 + k;
            const float* pp = (const float*)(a.ws + WS_PART) + (size_t)tok * 512 + 2 * lane;
            float2 p0 = *(const float2*)pp, p1 = *(const float2*)(pp + 128), p2 = *(const float2*)(pp + 256), p3 = *(const float2*)(pp + 384);
            s0[k] = (p0.x + p1.x) + (p2.x + p3.x); s1[k] = (p0.y + p1.y) + (p2.y + p3.y);
            e[k] = *(const int2*)((const int*)(a.ws + WS_EIDX) + (size_t)tok * 128 + 2 * lane);
            g[k] = *(const float2*)((const float*)(a.ws + WS_GATE) + (size_t)tok * 128 + 2 * lane);
            st[k] = ((const float*)(a.ws + WS_ST))[tok]; }
#pragma unroll
        for (int k = 0; k < 4; ++k) { su0[k] = SU[e[k].x]; su1[k] = SU[e[k].y]; sv0[k] = SV[e[k].x]; sv1[k] = SV[e[k].y]; }
#pragma unroll
        for (int k = 0; k < 4; ++k) { const int tok = t0 + k;
            const float r0 = g[k].x * gelu_tanh(s0[k] * (su0[k] * st[k])) * sv0[k], r1 = g[k].y * gelu_tanh(s1[k] * (su1[k] * st[k])) * sv1[k];
            if (!V_MFMA) {
                uint2 w; w.x = ((__float_as_uint(r0) + 0x2000u) & 0xffffc000u) | (unsigned)e[k].x; w.y = ((__float_as_uint(r1) + 0x2000u) & 0xffffc000u) | (unsigned)e[k].y;
                *(uint2*)((unsigned*)(a.ws + WS_PACK) + (size_t)tok * 128 + 2 * lane) = w; }
            if (V_MFMA) {
                float am = fmaxf(fabsf(r0), fabsf(r1));
#pragma unroll
                for (int o = 1; o < 64; o <<= 1) am = fmaxf(am, __shfl_xor(am, o));
                const float cs = am > 0.f ? am * (1.f / 4.5f) : 1.f, ics = 1.f / cs;
                float ra = r0 * ics, rb = r1 * ics;
                unsigned char* cp = a.ws + WS_CP + (size_t)tok * 256 + lane;
#pragma unroll
                for (int pl = 0; pl < 4; ++pl) { const float da = fminf(fmaxf(rintf(ra), -4.f), 4.f), db = fminf(fmaxf(rintf(rb), -4.f), 4.f);
                    cp[64 * pl] = (unsigned char)__builtin_amdgcn_cvt_scalef32_pk_fp4_f32(0u, da, db, 1.0f, 0);
                    ra = (ra - da) * 8.f; rb = (rb - db) * 8.f; }
                if (lane == 0) ((float*)(a.ws + WS_CS))[tok] = cs; }
        }
    }
}
typedef float f32x2 __attribute__((ext_vector_type(2)));
__device__ __forceinline__ float dpp_sum8(float s) {
    s += __builtin_bit_cast(float, __builtin_amdgcn_update_dpp(0, __builtin_bit_cast(int, s), 0xB1, 0xF, 0xF, true));
    s += __builtin_bit_cast(float, __builtin_amdgcn_update_dpp(0, __builtin_bit_cast(int, s), 0x4E, 0xF, 0xF, true));
    s += __builtin_bit_cast(float, __builtin_amdgcn_update_dpp(0, __builtin_bit_cast(int, s), 0x141, 0xF, 0xF, true));
    return s;
}
struct PTok { v4u vr[16]; v4u aux[4]; f32x4 xo, xg; };
template <bool VSIDE>
__device__ __forceinline__ void peer_issue(const unsigned char* TB, unsigned poff, const v4u (&w)[4], PTok& P, const unsigned char* sidep, const float* xop, const float* xgp) {
#pragma unroll
    for (int i = 0; i < 16; ++i) { const unsigned id = w[i >> 2][i & 3] & 0x3fffu; P.vr[i] = *(const v4u*)(TB + (id * 128u + poff)); }
    if (VSIDE) { P.xo = *(const f32x4*)xop; P.xg = *(const f32x4*)xgp; P.aux[0].x = ((const unsigned*)sidep)[0]; P.aux[0].y = ((const unsigned*)sidep)[1]; }
    else { (void)sidep; }
}
template <bool VSIDE>
__device__ __forceinline__ void peer_compute(const PTok& P, const v4u (&w)[4], int lane, float* outp) {
    const int p = lane & 7;
    if (VSIDE) {
        f32x2 acc2[16];
#pragma unroll
        for (int j = 0; j < 16; ++j) acc2[j] = (f32x2){0.f, 0.f};
#pragma unroll
        for (int i = 0; i < 16; ++i) {
            const v2u cpair = (i & 2) ? (v2u){w[i >> 2].z, w[i >> 2].w} : (v2u){w[i >> 2].x, w[i >> 2].y};
#pragma unroll
            for (int q = 0; q < 4; ++q) { const unsigned wd = P.vr[i][q];
                const f32x2 f0 = __builtin_amdgcn_cvt_scalef32_pk_f32_fp4(wd, 1.0f, 0), f1 = __builtin_amdgcn_cvt_scalef32_pk_f32_fp4(wd, 1.0f, 1), f2 = __builtin_amdgcn_cvt_scalef32_pk_f32_fp4(wd, 1.0f, 2), f3 = __builtin_amdgcn_cvt_scalef32_pk_f32_fp4(wd, 1.0f, 3);
                if (i & 1) {
                    asm volatile("v_pk_fma_f32 %0, %1, %2, %0 op_sel:[0,1,0] op_sel_hi:[1,1,1]" : "+v"(acc2[4 * q]) : "v"(f0), "v"(cpair));
                    asm volatile("v_pk_fma_f32 %0, %1, %2, %0 op_sel:[0,1,0] op_sel_hi:[1,1,1]" : "+v"(acc2[4 * q + 1]) : "v"(f1), "v"(cpair));
                    asm volatile("v_pk_fma_f32 %0, %1, %2, %0 op_sel:[0,1,0] op_sel_hi:[1,1,1]" : "+v"(acc2[4 * q + 2]) : "v"(f2), "v"(cpair));
                    asm volatile("v_pk_fma_f32 %0, %1, %2, %0 op_sel:[0,1,0] op_sel_hi:[1,1,1]" : "+v"(acc2[4 * q + 3]) : "v"(f3), "v"(cpair));
                } else {
                    asm volatile("v_pk_fma_f32 %0, %1, %2, %0 op_sel_hi:[1,0,1]" : "+v"(acc2[4 * q]) : "v"(f0), "v"(cpair));
                    asm volatile("v_pk_fma_f32 %0, %1, %2, %0 op_sel_hi:[1,0,1]" : "+v"(acc2[4 * q + 1]) : "v"(f1), "v"(cpair));
                    asm volatile("v_pk_fma_f32 %0, %1, %2, %0 op_sel_hi:[1,0,1]" : "+v"(acc2[4 * q + 2]) : "v"(f2), "v"(cpair));
                    asm volatile("v_pk_fma_f32 %0, %1, %2, %0 op_sel_hi:[1,0,1]" : "+v"(acc2[4 * q + 3]) : "v"(f3), "v"(cpair));
                } } }
        float acc[32];
#pragma unroll
        for (int j = 0; j < 16; ++j) { acc[2 * j] = acc2[j].x; acc[2 * j + 1] = acc2[j].y; }
        const int b5 = (lane >> 5) & 1, b4 = (lane >> 4) & 1, b3 = (lane >> 3) & 1;
        float v1[16], v2[8], v3[4];
#pragma unroll
        for (int j = 0; j < 16; ++j) { const v2u r = __builtin_amdgcn_permlane32_swap(__float_as_uint(acc[j]), __float_as_uint(acc[16 + j]), false, false);
            v1[j] = __uint_as_float(r.x) + __uint_as_float(r.y); }
#pragma unroll
        for (int j = 0; j < 8; ++j) { const v2u r = __builtin_amdgcn_permlane16_swap(__float_as_uint(v1[j]), __float_as_uint(v1[8 + j]), false, false);
            v2[j] = __uint_as_float(r.x) + __uint_as_float(r.y); }
#pragma unroll
        for (int j = 0; j < 4; ++j) { const float kp = b3 ? v2[4 + j] : v2[j], sd = b3 ? v2[j] : v2[4 + j];
            v3[j] = kp + __builtin_bit_cast(float, __builtin_amdgcn_update_dpp(0, __builtin_bit_cast(int, sd), 0x128, 0xF, 0xF, true)); }
        f32x4 o; o.x = (P.xo.x + bf_lo(P.aux[0].x)) + P.xg.x * v3[0]; o.y = (P.xo.y + bf_hi(P.aux[0].x)) + P.xg.y * v3[1]; o.z = (P.xo.z + bf_lo(P.aux[0].y)) + P.xg.z * v3[2]; o.w = (P.xo.w + bf_hi(P.aux[0].y)) + P.xg.w * v3[3]; *(f32x4*)outp = o;
    } else {
        f32x2 keep = {0.f, 0.f};
#pragma unroll
        for (int i = 0; i < 16; ++i) { int s0 = 0, s1 = 0;
#pragma unroll
            for (int q = 0; q < 4; ++q) { s0 = __builtin_amdgcn_sdot8((int)P.vr[i][q], (int)P.aux[0][q], s0, false); s1 = __builtin_amdgcn_sdot8((int)P.vr[i][q], (int)P.aux[1][q], s1, false); }
            const float dt = dpp_sum8((float)s0 + (float)s1 * 0.0625f);
            if ((i >> 1) == p) { if (i & 1) keep.y = dt; else keep.x = dt; } }
        *(f32x2*)outp = keep;
    }
}
template <bool VSIDE>
__device__ __forceinline__ void peer_slice(const Args& a, Frame& F) {
    const int x = F.sl_x, wx = F.sl_rank * NWAVES + F.wave, nwx = F.sl_n * NWAVES;
    if (wx >= T) return;
    const int lane = F.lane, eg = lane >> 3, p = lane & 7;
    const unsigned char* TB = a.ws + (VSIDE ? WS_V : WS_U) + (size_t)x * (2 * MiB); const unsigned poff = 16u * (unsigned)p;
    const unsigned* Wb = (const unsigned*)(a.ws + (VSIDE ? WS_PACK : WS_EIDX)) + 16 * eg;
    const unsigned char* Hb = a.ws + WS_H4 + 128 * x + 16 * p;
    const int dcol = 256 * x + 32 * p + 16 * ((lane >> 5) & 1) + 8 * ((lane >> 4) & 1) + 4 * ((lane >> 3) & 1);
    const float* G2 = (const float*)(a.ws + WS_MOD) + 5120 + dcol;
    float* PART = (float*)(a.ws + WS_PART) + (size_t)x * 128 + 16 * eg + 2 * p;
    const float* X1 = a.x;
    const unsigned char* DLb = a.ws + WS_DELTA + 2 * dcol;
    v4u nA[4], nB[4];
    int tA = wx, tB = wx + nwx;
#define PS_LDW(dst, tok) do { const unsigned* _w = Wb + (size_t)((tok) < T ? (tok) : T - 1) * 128; _Pragma("unroll") for (int _q = 0; _q < 4; ++_q) dst[_q] = *(const v4u*)(_w + 4 * _q); } while (0)
    PS_LDW(nA, tA); PS_LDW(nB, tB);
    v4u hA[2], hB[2];
    if (!VSIDE) { const int tb0 = tB < T ? tB : tA; hA[0] = *(const v4u*)(Hb + (size_t)tA * 1024); hA[1] = *(const v4u*)(Hb + (size_t)tA * 1024 + 512); hB[0] = *(const v4u*)(Hb + (size_t)tb0 * 1024); hB[1] = *(const v4u*)(Hb + (size_t)tb0 * 1024 + 512); }
#pragma unroll 1
    for (; tA < T; tA += 2 * nwx, tB += 2 * nwx) {
        const int tBc = tB < T ? tB : tA;
        v4u wA[4], wB[4];
#pragma unroll
        for (int q = 0; q < 4; ++q) { wA[q] = nA[q]; wB[q] = nB[q]; }
        PTok A, B;
        peer_issue<VSIDE>(TB, poff, wA, A, VSIDE ? DLb + (size_t)tA * 2048 : Hb + (size_t)tA * 1024, X1 + (size_t)tA * D + dcol, G2 + (size_t)(tA / SEQ) * 6144);
        peer_issue<VSIDE>(TB, poff, wB, B, VSIDE ? DLb + (size_t)tBc * 2048 : Hb + (size_t)tBc * 1024, X1 + (size_t)tBc * D + dcol, G2 + (size_t)(tBc / SEQ) * 6144);
        if (!VSIDE) {
            A.aux[0] = hA[0]; A.aux[1] = hA[1]; B.aux[0] = hB[0]; B.aux[1] = hB[1];
            { const int t2 = tA + 2 * nwx < T ? tA + 2 * nwx : T - 1, t3 = tB + 2 * nwx < T ? tB + 2 * nwx : T - 1;
              hA[0] = *(const v4u*)(Hb + (size_t)t2 * 1024); hA[1] = *(const v4u*)(Hb + (size_t)t2 * 1024 + 512); hB[0] = *(const v4u*)(Hb + (size_t)t3 * 1024); hB[1] = *(const v4u*)(Hb + (size_t)t3 * 1024 + 512); }
            PS_LDW(nA, tA + 2 * nwx); PS_LDW(nB, tB + 2 * nwx); }
        peer_compute<VSIDE>(A, wA, lane, VSIDE ? a.out + (size_t)tA * D + dcol : PART + (size_t)tA * 512);
        if (VSIDE) { PS_LDW(nA, tA + 2 * nwx); PS_LDW(nB, tB + 2 * nwx); }
        if (tB < T) peer_compute<VSIDE>(B, wB, lane, VSIDE ? a.out + (size_t)tB * D + dcol : PART + (size_t)tB * 512);
    }
#undef PS_LDW
}

struct VTok { v4u vr[16]; };
struct VStr { v4u aw; f32x4 xo, xg; v2u dl; float cs; };
__device__ __forceinline__ void vmfma_issue(const unsigned char* TB, unsigned poff, const v4u (&w)[4], VTok& P) {
#pragma unroll
    for (int i = 0; i < 16; ++i) { const unsigned id = w[i >> 2][i & 3]; P.vr[i] = *(const v4u*)(TB + (id * 128u + poff)); }
}
__device__ __forceinline__ void vmfma_stream(VStr& S, const unsigned char* cpp, const float* csp, const float* xop, const float* xgp, const unsigned char* dlp) {
    S.aw = *(const v4u*)cpp; S.cs = *csp; S.xo = __builtin_nontemporal_load((const f32x4*)xop); S.xg = *(const f32x4*)xgp; S.dl = __builtin_nontemporal_load((const v2u*)dlp);
}
__device__ __forceinline__ void vmfma_compute(const VTok& P, const VStr& S, int lane, LAS unsigned char* img, float* outp, int pv = 0) {
    const int eg = lane >> 3, p = lane & 7, n = lane & 15, q = lane >> 4;
    if (pv == 1) { unsigned acc = 0;
#pragma unroll
        for (int i = 0; i < 16; ++i) acc ^= P.vr[i].x ^ P.vr[i].w;
        f32x4 o; o.x = S.xo.x + bf_lo(S.dl.x) + S.xg.x * S.cs; o.y = S.xo.y + (acc == 0x12345u ? 1.f : 0.f); o.z = S.xo.z + __uint_as_float(S.aw.x & 1u); o.w = S.xo.w; *(f32x4*)outp = o; return; }
    asm volatile("s_waitcnt lgkmcnt(0)" ::: "memory");
#pragma unroll
    for (int i = 0; i < 16; ++i) *(LAS v4u*)(img + (16 * eg + i) * 128 + 16 * (p ^ (i & 7))) = P.vr[i];
    asm volatile("s_waitcnt lgkmcnt(0)" ::: "memory");
    const unsigned rowb = (unsigned)(size_t)img + (unsigned)(32 * q + n) * 128u;
    v8i A; A[0] = (int)S.aw.x; A[1] = (int)S.aw.y; A[2] = (int)S.aw.z; A[3] = (int)S.aw.w; A[4] = 0; A[5] = 0; A[6] = 0; A[7] = 0;
    LAS float* scr = (LAS float*)(img + 16384);
#pragma unroll
    for (int hb = 0; hb < 2; ++hb) {
        v2u tr[8][2];
#pragma unroll
        for (int t2 = 0; t2 < 4; ++t2) { const unsigned a0 = rowb + 16u * (unsigned)((4 * hb + t2) ^ (n & 7));
            asm volatile("ds_read_b64_tr_b4 %0, %1" : "=v"(tr[2 * t2][0]) : "v"(a0) : "memory");
            asm volatile("ds_read_b64_tr_b4 %0, %1 offset:2048" : "=v"(tr[2 * t2][1]) : "v"(a0) : "memory");
            asm volatile("ds_read_b64_tr_b4 %0, %1 offset:8" : "=v"(tr[2 * t2 + 1][0]) : "v"(a0) : "memory");
            asm volatile("ds_read_b64_tr_b4 %0, %1 offset:2056" : "=v"(tr[2 * t2 + 1][1]) : "v"(a0) : "memory"); }
        asm volatile("s_waitcnt lgkmcnt(0)" : "+v"(tr[0][0]), "+v"(tr[0][1]), "+v"(tr[1][0]), "+v"(tr[1][1]), "+v"(tr[2][0]), "+v"(tr[2][1]), "+v"(tr[3][0]), "+v"(tr[3][1]), "+v"(tr[4][0]), "+v"(tr[4][1]), "+v"(tr[5][0]), "+v"(tr[5][1]), "+v"(tr[6][0]), "+v"(tr[6][1]), "+v"(tr[7][0]), "+v"(tr[7][1]) :: "memory");
        __builtin_amdgcn_sched_barrier(0);
#pragma unroll
        for (int t = 0; t < 8; ++t) { const int nt = 8 * hb + t; v8i B; B[0] = (int)tr[t][0].x; B[1] = (int)tr[t][0].y; B[2] = (int)tr[t][1].x; B[3] = (int)tr[t][1].y; B[4] = 0; B[5] = 0; B[6] = 0; B[7] = 0;
            f32x4 c = {0.f, 0.f, 0.f, 0.f};
            c = __builtin_amdgcn_mfma_scale_f32_16x16x128_f8f6f4(A, B, c, 4  , 4  , 0, 0, 0, 0);
            const float val = c[0] + c[1] * 0.125f + c[2] * 0.015625f + c[3] * 0.001953125f;
            if (q == 0) scr[16 * nt + n] = val; }
    }
    asm volatile("s_waitcnt lgkmcnt(0)" ::: "memory");
    const f32x4 v = *(const LAS f32x4*)(scr + 4 * lane);
    const float k = S.cs;
    f32x4 o; o.x = (S.xo.x + bf_lo(S.dl.x)) + S.xg.x * (k * v.x); o.y = (S.xo.y + bf_hi(S.dl.x)) + S.xg.y * (k * v.y); o.z = (S.xo.z + bf_lo(S.dl.y)) + S.xg.z * (k * v.z); o.w = (S.xo.w + bf_hi(S.dl.y)) + S.xg.w * (k * v.w);
    __builtin_nontemporal_store(o, (f32x4*)outp);
}
__device__ __forceinline__ void peer_vslice_mfma(const Args& a, Frame& F, int pv = 0) {
    const int x = F.sl_x, wx = F.sl_rank * NWAVES + F.wave, nwx = F.sl_n * NWAVES;
    if (wx >= T) return;
    const int lane = F.lane, eg = lane >> 3, p = lane & 7;
    const unsigned char* TB = a.ws + WS_V + (size_t)x * (2 * MiB); const unsigned poff = 16u * (unsigned)p;
    const unsigned* Wb = (const unsigned*)(a.ws + WS_EIDX) + 16 * eg;
    const unsigned char* CPb = a.ws + WS_CP + ((lane & 15) & 3) * 64 + 16 * (lane >> 4);
    const float* CSb = (const float*)(a.ws + WS_CS);
    const int dcol = 256 * x + 4 * lane;
    const float* G2 = (const float*)(a.ws + WS_MOD) + 5120 + dcol;
    const unsigned char* DLb = a.ws + WS_DELTA + 2 * dcol;
    LAS unsigned char* img = F.lds + F.wave * 17408;
    v4u nA[4], nB[4]; VStr sA, sB;
    int tA = wx, tB = wx + nwx;
#define PS_LDW(dst, tok) do { const unsigned* _w = Wb + (size_t)((tok) < T ? (tok) : T - 1) * 128; _Pragma("unroll") for (int _q = 0; _q < 4; ++_q) dst[_q] = *(const v4u*)(_w + 4 * _q); } while (0)
#define VS_STREAM(S, tok) do { const int _t = (tok) < T ? (tok) : T - 1; vmfma_stream(S, CPb + (size_t)_t * 256, CSb + _t, a.x + (size_t)_t * D + dcol, G2 + (size_t)(_t / SEQ) * 6144, DLb + (size_t)_t * 2048); } while (0)
    PS_LDW(nA, tA); PS_LDW(nB, tB); VS_STREAM(sA, tA); VS_STREAM(sB, tB);
#pragma unroll 1
    for (; tA < T; tA += 2 * nwx, tB += 2 * nwx) {
        VTok A, B;
        vmfma_issue(TB, poff, nA, A);
        vmfma_issue(TB, poff, nB, B);
        const VStr cA = sA, cB = sB;
        VS_STREAM(sA, tA + 2 * nwx); VS_STREAM(sB, tB + 2 * nwx);
        vmfma_compute(A, cA, lane, img, a.out + (size_t)tA * D + dcol, pv);
        PS_LDW(nA, tA + 2 * nwx); PS_LDW(nB, tB + 2 * nwx);
        if (tB < T) vmfma_compute(B, cB, lane, img, a.out + (size_t)tB * D + dcol, pv);
    }
#undef VS_STREAM
#undef PS_LDW
}

constexpr int N_PHASES = 11;
__global__ void __launch_bounds__(NTHREADS, 2) fwd_kernel(Args a) {
    extern __shared__ __attribute__((aligned(16))) unsigned char lds_raw[];
    Frame F; F.lds = (LAS unsigned char*)lds_raw; F.tid = threadIdx.x; F.lane = F.tid & 63; F.wave = __builtin_amdgcn_readfirstlane(F.tid >> 6); F.G = gridDim.x; F.bid = blockIdx.x;
    const int lo = a.ph_lo, hi = a.ph_hi;
    F.sl_x = F.bid & 3; F.sl_rank = F.bid >> 2; F.sl_n = (F.G - F.sl_x + 3) >> 2;
    unsigned* ctl = (unsigned*)(a.ws + WS_CTL);
    const bool census = (lo == 0 && hi == N_PHASES);
    int my_xcc = 0, my_rank = 0;
    XcdBarrier xbar; xbar.bar = ctl + 4096; xbar.x = 0; xbar.st = (volatile LAS unsigned*)(F.lds + LDS_BYTES - 32);
    if (census) {
        if (F.tid == 0) { xbar.st[0] = 0u; xbar.st[1] = 0u; }
        __syncthreads();
        xbar = xcd_barrier_post(ctl + 4096, (volatile LAS unsigned*)(F.lds + LDS_BYTES - 32));
    }
    if (census) {
        LAS volatile unsigned* top = (LAS volatile unsigned*)(F.lds + LDS_BYTES - 64);
        if (F.tid == 0) { const unsigned xcc = (unsigned)__builtin_amdgcn_s_getreg((3 << 11) | 20) & 7u;
            top[0] = xcc; top[1] = __hip_atomic_fetch_add(ctl + 64 * xcc, 1u, __ATOMIC_RELAXED, __HIP_MEMORY_SCOPE_AGENT); }
        __syncthreads();
        my_xcc = __builtin_amdgcn_readfirstlane((int)top[0]); my_rank = __builtin_amdgcn_readfirstlane((int)top[1]);
    }
#ifndef PH_MASK
#define PH_MASK 0x7ff
#endif
#define REPS(k) ((REP_PH == (k)) ? REP_N : 0)
#define IN(k) (((PH_MASK >> (k)) & 1) && lo <= (k) && (k) < hi)
#define SEAM(k) do { if (IN(k) && IN((k) + 1)) { if ((k) == 0 && USE_CG_SYNC) cg::this_grid().sync(); else xcd_barrier(xbar); } } while (0)
    const float* mod = (const float*)(a.ws + WS_MOD);
    for (int rep = 0; rep <= REPS(0); ++rep) if (IN(0)) { if (rep) xcd_barrier(xbar); for (int it = F.bid; it < 192; it += F.G) mod_item(a, F, it); prep_rest(a, F); }
    SEAM(0);
    for (int rep = 0; rep <= REPS(1); ++rep) if (IN(1)) { if (rep) xcd_barrier(xbar); modnorm_rows<false, 8>(a, F, a.x, a.norm1_g, 0, 1024); }
    SEAM(1);
    for (int rep = 0; rep <= REPS(2); ++rep) if (IN(2)) { if (rep) xcd_barrier(xbar);
        pg8::Gemm g{(const bf16*)(a.ws + WS_H), (const bf16*)(a.ws + WS_WIN), T, NIN, D}; pg8::StaticOrder S; S.init(T, NIN, F.G, F.bid);
        pg8::EpiBf16 E{(bf16*)(a.ws + WS_PROJ), NIN};
        pg8::gemm_phase<pg8::EpiBf16, pg8::StaticOrder, true, true>(F.lds, g, S, E);
        const int extra = S.nwg % F.G;
        if (extra == 0) quant_tables(a, F, F.bid * NWAVES + F.wave, F.G * NWAVES);
        else if (F.bid >= extra) quant_tables(a, F, (F.bid - extra) * NWAVES + F.wave, (F.G - extra) * NWAVES);
    }
    SEAM(2);
    for (int rep = 0; rep <= REPS(3); ++rep) if (IN(3)) { if (rep) xcd_barrier(xbar);
        for (int u = F.bid; u < 768; u += F.G) { if (u < 512) { if (a.var != 2 && (rep == 0 || MIX_VAR != 2)) attn_unit(a, F, u, rep == 0 ? 0 : ATT_VAR); } else { if (a.var != 1 && (rep == 0 || MIX_VAR != 1)) conv_unit(a, F, u - 512); } }
    }
    SEAM(3);
    for (int rep = 0; rep <= REPS(4); ++rep) if (IN(4)) { if (rep) xcd_barrier(xbar);
        pg8::Gemm g{(const bf16*)(a.ws + WS_MIX), (const bf16*)(a.ws + WS_WOUT), T, D, D}; pg8::StaticOrder S; S.init(T, D, F.G, F.bid);
        pg8::EpiGateBf16 E{(bf16*)(a.ws + WS_DELTA), D, mod + 2048, 6144, SEQ};
        pg8::gemm_phase<pg8::EpiGateBf16, pg8::StaticOrder, true, true>(F.lds, g, S, E);
    }
    SEAM(4);
    for (int rep = 0; rep <= REPS(5); ++rep) if (IN(5)) { if (rep) xcd_barrier(xbar); modnorm_rows<true, 4>(a, F, a.x, a.norm2_g, 3072, 4096); }
    SEAM(5);
    for (int rep = 0; rep <= REPS(6); ++rep) if (IN(6)) { if (rep) xcd_barrier(xbar);
        pg8::Gemm g{(const bf16*)(a.ws + WS_H), (const bf16*)(a.ws + WS_WQ), T, NQ, D}; pg8::StaticOrder S; S.init(T, NQ, F.G, F.bid);
        pg8::EpiBf16 E{(bf16*)(a.ws + WS_PROJ), NQ};
        pg8::gemm_phase<pg8::EpiBf16, pg8::StaticOrder, true, true>(F.lds, g, S, E);
    }
    SEAM(6);
    for (int rep = 0; rep <= REPS(7); ++rep) if (IN(7)) { if (rep) xcd_barrier(xbar);
        const int h = F.bid & 7, nbh = (F.G - h + 7) >> 3;
        { const bf16* KEYS = (const bf16*)(a.ws + WS_KEYS); LAS bf16* KL = (LAS bf16*)F.lds;
          v4u kv[8];
#pragma unroll
          for (int j = 0; j < 8; ++j) { const int i = F.tid + j * NTHREADS; const int sd = i >> 11, row = (i >> 4) & 127, c16 = i & 15; kv[j] = *(const v4u*)(KEYS + ((size_t)(sd * 8 + h) * 128 + row) * 128 + 8 * c16); }
#pragma unroll
          for (int j = 0; j < 8; ++j) { const int i = F.tid + j * NTHREADS; const int sd = i >> 11, row = (i >> 4) & 127, c16 = i & 15; *(LAS v4u*)(KL + (sd * 128 + row) * KEY_LDS_STRIDE + 8 * c16) = kv[j]; } }
        __syncthreads();
        for (int t = (F.bid >> 3) * NWAVES + F.wave; t < T / 32; t += nbh * NWAVES) topk_unit(a, F, t, h);
        __syncthreads(); }
    SEAM(7);
    if (census) {
        unsigned sum = 0; bool ok = true; unsigned mine = 1, other = 0;
#pragma unroll
        for (int j = 0; j < 8; ++j) { const unsigned cj = __hip_atomic_load(ctl + 64 * j, __ATOMIC_RELAXED, __HIP_MEMORY_SCOPE_AGENT); sum += cj; ok = ok && (cj > 0u); if (j == my_xcc) mine = cj; if (j == (my_xcc ^ 4)) other = cj; }
        if (ok && sum == (unsigned)F.G) { F.sl_x = my_xcc & 3; F.sl_rank = my_rank + ((my_xcc & 4) ? (int)other : 0); F.sl_n = (int)(mine + other); }
    }
    for (int rep = 0; rep <= REPS(8); ++rep) if (IN(8)) { if (rep) xcd_barrier(xbar); peer_slice<false>(a, F); }
    SEAM(8);
    for (int rep = 0; rep <= REPS(9); ++rep) if (IN(9)) { if (rep) xcd_barrier(xbar); peer_coef(a, F); }
    SEAM(9);
    for (int rep = 0; rep <= REPS(10); ++rep) if (IN(10)) { if (rep) xcd_barrier(xbar); if (V_MFMA) peer_vslice_mfma(a, F, (rep >= 1 && rep < REP_N) ? VS_VAR : 0); else peer_slice<true>(a, F); }
#undef IN
#undef SEAM
}

extern "C" void kernel_launch(void* const* d_in, const int* in_sizes, int n_in, void* d_out, int out_size, void* d_ws, size_t ws_size, hipStream_t stream) {
    static int grid = 0;
    if (grid == 0) {
        if (n_in != 19 || in_sizes[0] != T * D || out_size != T * D || ws_size < WS_END) { fprintf(stderr, "kernel_launch: unexpected shapes (n_in %d, in0 %d, out %d, ws %zu)\n", n_in, n_in > 0 ? in_sizes[0] : -1, out_size, ws_size); grid = -1; return; }
        int dev = 0, cus = 0, per_cu = 0;
        hipGetDevice(&dev); hipDeviceGetAttribute(&cus, hipDeviceAttributeMultiprocessorCount, dev);
        hipFuncSetAttribute((const void*)fwd_kernel, hipFuncAttributeMaxDynamicSharedMemorySize, LDS_BYTES);
        hipOccupancyMaxActiveBlocksPerMultiprocessor(&per_cu, (const void*)fwd_kernel, NTHREADS, LDS_BYTES);
        (void)hipGetLastError();
        if (per_cu < 1) { fprintf(stderr, "kernel_launch: occupancy query says %d blocks/CU\n", per_cu); per_cu = 1; }
        grid = cus * 1;
    }
    if (grid < 0) return;
    (void)hipMemsetAsync(d_ws, 0, 32768, stream);
    Args a{};
    const float** p = (const float**)&a;
    for (int i = 0; i < 19; ++i) p[i] = (const float*)d_in[i];
    a.out = (float*)d_out; a.ws = (unsigned char*)d_ws;
#if N_LAUNCH_SPLIT
    for (int ph = 0; ph < N_PHASES; ++ph) { a.ph_lo = ph; a.ph_hi = ph + 1;
        for (int rep = 0; rep < (((REP_MASK >> ph) & 1) ? 2 : 1); ++rep) hipLaunchKernelGGL(fwd_kernel, dim3(grid), dim3(NTHREADS), LDS_BYTES, stream, a); }
    for (int ph = 0; ph < N_PHASES - 1; ++ph) if ((LATE_MASK >> ph) & 1) { a.ph_lo = ph; a.ph_hi = ph + 1; a.var = LATE_VAR; hipLaunchKernelGGL(fwd_kernel, dim3(grid), dim3(NTHREADS), LDS_BYTES, stream, a); }
#else
    a.ph_lo = 0; a.ph_hi = N_PHASES;
    void* args[] = {&a};
    hipError_t e = hipLaunchCooperativeKernel((const void*)fwd_kernel, dim3(grid), dim3(NTHREADS), args, LDS_BYTES, stream);
    if (e != hipSuccess) fprintf(stderr, "cooperative launch failed: %s (grid %d)\n", hipGetErrorString(e), grid);
#endif
}
```

```cpp
#include <hip/hip_runtime.h>
#include <hip/hip_cooperative_groups.h>
#include <cstdio>
#include <cstdint>
namespace cg = cooperative_groups;

#ifndef REP_MASK
#define REP_MASK 0
#endif
#ifndef USE_CG_SYNC
#define USE_CG_SYNC 0
#endif
#ifndef ATT_VAR
#define ATT_VAR 0
#endif
#ifndef V_MFMA
#define V_MFMA 1
#endif
#ifndef VS_VAR
#define VS_VAR 0
#endif
#ifndef CONV_ON
#define CONV_ON 1
#endif
#ifndef ATT_ON
#define ATT_ON 1
#endif
#ifndef MIX_VAR
#define MIX_VAR 0
#endif
#ifndef REP_PH
#define REP_PH -1
#endif
#ifndef REP_N
#define REP_N 0
#endif
#ifndef LATE_MASK
#define LATE_MASK 0
#endif
#ifndef LATE_VAR
#define LATE_VAR 0
#endif
#ifndef N_LAUNCH_SPLIT
#define N_LAUNCH_SPLIT 0
#endif

namespace pg8 {
#define PG8_LAS __attribute__((address_space(3)))
typedef unsigned short bf16_t;
typedef short bf16x8 __attribute__((ext_vector_type(8)));
typedef float f32x4 __attribute__((ext_vector_type(4)));
typedef unsigned u32x4 __attribute__((ext_vector_type(4)));
constexpr int BM = 256, BK = 64, HALF = 128, HTB = HALF * BK * 2  , STAGE_BYTES = 8 * HTB, NXCD = 8, WGM = 8;

__host__ __device__ __forceinline__ int lds_byte(int r, int c) { const int st = (r >> 4) * 2 + (c >> 5), rr = r & 15, cc = c & 31, ob = rr * 64 + cc * 2; return st * 1024 + (ob ^ (((ob >> 9) & 1) << 5)); }
__host__ __device__ __forceinline__ void stage_rc(int b, int& R, int& C) { const int st = b / 1024, sb = b % 1024, swz = sb ^ (((sb >> 9) & 1) << 5); R = (st >> 1) * 16 + swz / 64; C = (st & 1) * 32 + (swz % 64) / 2; }
__host__ __device__ __forceinline__ int perm32(int rho) { const int n = rho >> 4, i = rho & 15; return 8 * (i >> 2) + 4 * n + (i & 3); }

struct Unit { int pm, pn; };
struct Gemm { const bf16_t* A; const bf16_t* Bt; int M, N, K; };

struct StaticOrder {
    int nM, nN, nwg, G, c;
    __host__ __device__ void init(int M, int N, int G_, int c_) { nM = M / BM; nN = N / BM; nwg = nM * nN; G = G_; c = c_; }
    __host__ __device__ bool next(int i, Unit& u) const {
        const long L = (long)i * G + c; if (L >= nwg) return false;
        int wgid = (int)L; { const int q = nwg / NXCD, r = nwg % NXCD, xcd = wgid % NXCD, off = wgid / NXCD; wgid = (xcd < r ? xcd * (q + 1) : r * (q + 1) + (xcd - r) * q) + off; }
        const int nig = WGM * nN, gid = wgid / nig, fm = gid * WGM, gsz = (nM - fm) < WGM ? (nM - fm) : WGM;
        u.pm = fm + ((wgid % nig) % gsz); u.pn = (wgid % nig) / gsz; return true;
    }
    __device__ __forceinline__ void a_ready(const Unit&) const {}
    __device__ __forceinline__ void done(const Unit&) const {}
};

__device__ __forceinline__ unsigned cvt_pk_bf16(float lo, float hi) { unsigned r; asm volatile("v_cvt_pk_bf16_f32 %0, %1, %2" : "=v"(r) : "v"(lo), "v"(hi)); return r; }

struct EpiBf16 {
    static constexpr bool PERM = true, AFTER_DRAIN = false;
    bf16_t* O; int ldc;
    __device__ __forceinline__ void operator()(const f32x4 (&acc)[2][2][4][2], const Unit& u, int wr, int wc, int fr, int fq) const {
        const int row0 = u.pm * BM + wr * 64 + fr; const int col0 = u.pn * BM + wc * 32 + 8 * fq;
#pragma unroll
        for (int ai = 0; ai < 2; ++ai)
#pragma unroll
            for (int m = 0; m < 4; ++m) { bf16_t* rowp = O + (size_t)(row0 + ai * HALF + m * 16) * ldc + col0;
#pragma unroll
                for (int bj = 0; bj < 2; ++bj) { const f32x4 v0 = acc[ai][bj][m][0], v1 = acc[ai][bj][m][1];
                    u32x4 w; w.x = cvt_pk_bf16(v0[0], v0[1]); w.y = cvt_pk_bf16(v0[2], v0[3]); w.z = cvt_pk_bf16(v1[0], v1[1]); w.w = cvt_pk_bf16(v1[2], v1[3]);
                    *(u32x4*)(rowp + bj * HALF) = w; } }
    }
};
struct EpiGateBf16 {
    static constexpr bool PERM = true, AFTER_DRAIN = false;
    bf16_t* O; int ldc; const float* gate; int gstride; int rows_per_batch;
    __device__ __forceinline__ void operator()(const f32x4 (&acc)[2][2][4][2], const Unit& u, int wr, int wc, int fr, int fq) const {
        const int row0 = u.pm * BM + wr * 64 + fr; const int col0 = u.pn * BM + wc * 32 + 8 * fq;
        const float* gp = gate + (size_t)((u.pm * BM) / rows_per_batch) * gstride + col0;
        f32x4 gv[2][2];
#pragma unroll
        for (int bj = 0; bj < 2; ++bj)
#pragma unroll
            for (int n = 0; n < 2; ++n) gv[bj][n] = *(const f32x4*)(gp + bj * HALF + 4 * n);
#pragma unroll
        for (int ai = 0; ai < 2; ++ai)
#pragma unroll
            for (int m = 0; m < 4; ++m) { bf16_t* rowp = O + (size_t)(row0 + ai * HALF + m * 16) * ldc + col0;
#pragma unroll
                for (int bj = 0; bj < 2; ++bj) { const f32x4 v0 = acc[ai][bj][m][0] * gv[bj][0], v1 = acc[ai][bj][m][1] * gv[bj][1];
                    u32x4 w; w.x = cvt_pk_bf16(v0[0], v0[1]); w.y = cvt_pk_bf16(v0[2], v0[3]); w.z = cvt_pk_bf16(v1[0], v1[1]); w.w = cvt_pk_bf16(v1[2], v1[3]);
                    *(u32x4*)(rowp + bj * HALF) = w; } }
    }
};
struct EpiResid {
    static constexpr bool PERM = false, AFTER_DRAIN = false;
    const float* base; float* out; int ldc; const float* gate; int gstride; int rows_per_batch;
    __device__ __forceinline__ void operator()(const f32x4 (&acc)[2][2][4][2], const Unit& u, int wr, int wc, int fr, int fq) const {
        const int row0 = u.pm * BM + wr * 64 + fr; const int col0 = u.pn * BM + wc * 32 + 4 * fq;
        const float* gp = gate + (size_t)((u.pm * BM) / rows_per_batch) * gstride + col0;
        f32x4 gv[2][2];
#pragma unroll
        for (int bj = 0; bj < 2; ++bj)
#pragma unroll
            for (int n = 0; n < 2; ++n) gv[bj][n] = *(const f32x4*)(gp + bj * HALF + n * 16);
#pragma unroll
        for (int ai = 0; ai < 2; ++ai)
#pragma unroll
            for (int m = 0; m < 4; ++m) { const size_t off = (size_t)(row0 + ai * HALF + m * 16) * ldc + col0;
#pragma unroll
                for (int bj = 0; bj < 2; ++bj)
#pragma unroll
                    for (int n = 0; n < 2; ++n) { const f32x4 bs = *(const f32x4*)(base + off + bj * HALF + n * 16);
                        *(f32x4*)(out + off + bj * HALF + n * 16) = bs + gv[bj][n] * acc[ai][bj][m][n]; } }
    }
};

template <class Epi, class Sched, bool ALIGN_EPI = false, bool SP2 = false>
__device__ __forceinline__ void gemm_phase(PG8_LAS unsigned char* lds, const Gemm g, const Sched& S, const Epi& E) {
    int tid = threadIdx.x; asm volatile("" : "+v"(tid));
    const int wid = __builtin_amdgcn_readfirstlane(tid >> 6), lane = tid & 63, wr = wid >> 2, wc = wid & 3, fr = lane & 15, fq = lane >> 4;
    const int K = g.K, nt = K / BK;
    unsigned voffA[2], voffB[2];
#pragma unroll
    for (int i = 0; i < 2; ++i) { int R, C; stage_rc(tid * 16 + i * 8192, R, C); const int Rb = Epi::PERM ? ((R & ~31) + perm32(R & 31)) : R;
        voffA[i] = (unsigned)(R * K + C) * 2u; voffB[i] = (unsigned)(Rb * K + C) * 2u; }
    const size_t kstep = (size_t)(BK * 2);
    const size_t hstep = (size_t)HALF * K * 2;
    const size_t tstep = 2 * hstep;
    const unsigned ldsw = (unsigned)wid * 1024u;
    const int aoff = lds_byte(wr * 64 + fr, fq * 8), boff = lds_byte(wc * 32 + fr, fq * 8);
#define PG8_SA(b, h) (((b) * 2 + (h)) * HTB)
#define PG8_SB(b, h) ((4 + (b) * 2 + (h)) * HTB)
#define PG8_STAGE(bufoff, gbase, voff) do { _Pragma("unroll") for (int _i = 0; _i < 2; ++_i) \
        __builtin_amdgcn_global_load_lds((const unsigned*)((const char*)(gbase) + (voff)[_i]), (PG8_LAS unsigned*)(lds + (bufoff) + ldsw + _i * 8192), 16, 0, 0); } while (0)
#define PG8_LDA(dst, b, h) do { _Pragma("unroll") for (int m = 0; m < 4; ++m) _Pragma("unroll") for (int k = 0; k < 2; ++k) dst[m][k] = *(const PG8_LAS bf16x8*)(lds + PG8_SA(b, h) + aoff + m * 2048 + k * 1024); } while (0)
#define PG8_LDB(dst, b, h) do { _Pragma("unroll") for (int n = 0; n < 2; ++n) _Pragma("unroll") for (int k = 0; k < 2; ++k) dst[n][k] = *(const PG8_LAS bf16x8*)(lds + PG8_SB(b, h) + boff + n * 2048 + k * 1024); } while (0)
#define PG8_MMA(ai, bj, At, Bt) do { __builtin_amdgcn_s_setprio(1); _Pragma("unroll") for (int m = 0; m < 4; ++m) _Pragma("unroll") for (int n = 0; n < 2; ++n) _Pragma("unroll") for (int k = 0; k < 2; ++k) \
        acc[ai][bj][m][n] = __builtin_amdgcn_mfma_f32_16x16x32_bf16(Bt[n][k], At[m][k], acc[ai][bj][m][n], 0, 0, 0); __builtin_amdgcn_s_setprio(0); } while (0)
#define PG8_WAIT_V(n) asm volatile("s_waitcnt vmcnt(" #n ")" ::: "memory")
#define PG8_WAIT_L(n) asm volatile("s_waitcnt lgkmcnt(" #n ")" ::: "memory")
#define PG8_BAR __builtin_amdgcn_s_barrier()
#define PG8_SCHED __builtin_amdgcn_sched_barrier(0)
    Unit cur, nxt; int ui = 0;
    if (!S.next(0, cur)) return;
    f32x4 acc[2][2][4][2];
#pragma unroll
    for (int a = 0; a < 2; ++a)
#pragma unroll
        for (int b = 0; b < 2; ++b)
#pragma unroll
            for (int m = 0; m < 4; ++m)
#pragma unroll
                for (int n = 0; n < 2; ++n) acc[a][b][m][n] = (f32x4){0.f, 0.f, 0.f, 0.f};
    bf16x8 At[4][2], B0[2][2], B1[2][2];
    const char* cA = (const char*)g.A + (size_t)cur.pm * tstep; const char* cB = (const char*)g.Bt + (size_t)cur.pn * tstep;
    S.a_ready(cur);
    if constexpr (SP2) {
        PG8_STAGE(PG8_SB(0, 0), cB, voffB); PG8_STAGE(PG8_SB(0, 1), cB + hstep, voffB); PG8_STAGE(PG8_SA(0, 0), cA, voffA); PG8_STAGE(PG8_SA(0, 1), cA + hstep, voffA);
        if (wr == 1) PG8_BAR;
        PG8_WAIT_V(2); PG8_BAR;
        PG8_STAGE(PG8_SB(1, 0), cB + kstep, voffB); PG8_STAGE(PG8_SA(1, 0), cA + kstep, voffA); PG8_STAGE(PG8_SB(1, 1), cB + hstep + kstep, voffB);
        PG8_WAIT_V(6); PG8_BAR;
    } else {
        PG8_STAGE(PG8_SB(0, 0), cB, voffB); PG8_STAGE(PG8_SA(0, 0), cA, voffA); PG8_STAGE(PG8_SB(0, 1), cB + hstep, voffB); PG8_STAGE(PG8_SA(0, 1), cA + hstep, voffA);
        if (wr == 1) PG8_BAR;
        PG8_WAIT_V(4); PG8_BAR;
        PG8_STAGE(PG8_SB(1, 0), cB + kstep, voffB); PG8_STAGE(PG8_SA(1, 0), cA + kstep, voffA); PG8_STAGE(PG8_SB(1, 1), cB + hstep + kstep, voffB);
        PG8_WAIT_V(6); PG8_BAR;
    }
    for (;;) {
        const bool has_next = S.next(ui + 1, nxt);
        const char* nA = has_next ? (const char*)g.A + (size_t)nxt.pm * tstep : cA; const char* nB = has_next ? (const char*)g.Bt + (size_t)nxt.pn * tstep : cB;
        for (int t = 0; t < nt; t += 2) {
            const bool last = (t == nt - 2);
            const char* a1 = cA + (size_t)(t + 1) * kstep;
            const char* a2 = last ? nA : cA + (size_t)(t + 2) * kstep; const char* b2 = last ? nB : cB + (size_t)(t + 2) * kstep;
            const char* a3 = a2 + kstep; const char* b3 = b2 + kstep;
            if (last && has_next) S.a_ready(nxt);
            if constexpr (SP2) {
            PG8_LDB(B0, 0, 0); PG8_LDB(B1, 0, 1); PG8_SCHED; PG8_LDA(At, 0, 0); PG8_STAGE(PG8_SA(1, 1), a1 + hstep, voffA);
            PG8_WAIT_V(8); PG8_WAIT_L(0); PG8_BAR; PG8_MMA(0, 0, At, B0); PG8_MMA(0, 1, At, B1); PG8_BAR; PG8_SCHED;
            PG8_LDA(At, 0, 1); PG8_STAGE(PG8_SB(0, 0), b2, voffB); PG8_STAGE(PG8_SB(0, 1), b2 + hstep, voffB); PG8_STAGE(PG8_SA(0, 0), a2, voffA);
            PG8_WAIT_V(8); PG8_WAIT_L(0); PG8_BAR; PG8_MMA(1, 0, At, B0); PG8_MMA(1, 1, At, B1); PG8_BAR; PG8_SCHED;
            PG8_LDB(B0, 1, 0); PG8_LDB(B1, 1, 1); PG8_SCHED; PG8_LDA(At, 1, 0); PG8_STAGE(PG8_SA(0, 1), a2 + hstep, voffA);
            PG8_WAIT_V(8); PG8_WAIT_L(0); PG8_BAR; PG8_MMA(0, 0, At, B0); PG8_MMA(0, 1, At, B1); PG8_BAR; PG8_SCHED;
            PG8_LDA(At, 1, 1); PG8_STAGE(PG8_SB(1, 0), b3, voffB); PG8_STAGE(PG8_SB(1, 1), b3 + hstep, voffB); PG8_STAGE(PG8_SA(1, 0), a3, voffA);
            PG8_WAIT_V(8); PG8_WAIT_L(0); PG8_BAR; PG8_MMA(1, 0, At, B0); PG8_MMA(1, 1, At, B1); PG8_BAR; PG8_SCHED;
            } else {
            PG8_LDB(B0, 0, 0); PG8_SCHED; PG8_LDA(At, 0, 0); PG8_STAGE(PG8_SA(1, 1), a1 + hstep, voffA);
            PG8_WAIT_L(8); PG8_BAR; PG8_WAIT_L(0); PG8_MMA(0, 0, At, B0); PG8_BAR; PG8_SCHED;
            PG8_LDB(B1, 0, 1); PG8_STAGE(PG8_SB(0, 0), b2, voffB);
            PG8_BAR; PG8_WAIT_L(0); PG8_MMA(0, 1, At, B1); PG8_BAR;
            PG8_LDA(At, 0, 1); PG8_STAGE(PG8_SA(0, 0), a2, voffA);
            PG8_BAR; PG8_WAIT_L(0); PG8_MMA(1, 0, At, B0); PG8_BAR; PG8_SCHED;
            PG8_STAGE(PG8_SB(0, 1), b2 + hstep, voffB);
            PG8_WAIT_V(6); PG8_BAR; PG8_MMA(1, 1, At, B1); PG8_BAR;
            PG8_LDB(B0, 1, 0); PG8_SCHED; PG8_LDA(At, 1, 0); PG8_STAGE(PG8_SA(0, 1), a2 + hstep, voffA);
            PG8_WAIT_L(8); PG8_BAR; PG8_WAIT_L(0); PG8_MMA(0, 0, At, B0); PG8_BAR; PG8_SCHED;
            PG8_LDB(B1, 1, 1); PG8_STAGE(PG8_SB(1, 0), b3, voffB);
            PG8_BAR; PG8_WAIT_L(0); PG8_MMA(0, 1, At, B1); PG8_BAR;
            PG8_LDA(At, 1, 1); PG8_STAGE(PG8_SA(1, 0), a3, voffA);
            PG8_BAR; PG8_WAIT_L(0); PG8_MMA(1, 0, At, B0); PG8_BAR; PG8_SCHED;
            PG8_STAGE(PG8_SB(1, 1), b3 + hstep, voffB);
            PG8_WAIT_V(6); PG8_BAR; PG8_MMA(1, 1, At, B1); PG8_BAR;
            }
        }
        if constexpr (ALIGN_EPI) { if (wr == 0) PG8_BAR; }
        if constexpr (!Epi::AFTER_DRAIN) { E(acc, cur, wr, wc, fr, fq); S.done(cur); }
        if (!has_next) break;
#pragma unroll
        for (int a = 0; a < 2; ++a)
#pragma unroll
            for (int b = 0; b < 2; ++b)
#pragma unroll
                for (int m = 0; m < 4; ++m)
#pragma unroll
                    for (int n = 0; n < 2; ++n) acc[a][b][m][n] = (f32x4){0.f, 0.f, 0.f, 0.f};
        cur = nxt; cA = nA; cB = nB; ++ui;
        if constexpr (ALIGN_EPI) { if (wr == 1) PG8_BAR; }
    }
    PG8_WAIT_V(0);
    if constexpr (!ALIGN_EPI) { if (wr == 0) PG8_BAR; }
    PG8_BAR;
#undef PG8_SA
#undef PG8_SB
#undef PG8_STAGE
#undef PG8_LDA
#undef PG8_LDB
#undef PG8_MMA
#undef PG8_WAIT_V
#undef PG8_WAIT_L
#undef PG8_BAR
#undef PG8_SCHED
}
}

constexpr int NWAVES = 8, NTHREADS = 512;
constexpr int BATCH = 8, SEQ = 4096, D = 1024, T = BATCH * SEQ;
constexpr int NIN = 2304, NQ = 2048, NEXP = 16384;
constexpr int C_B = 0, C_C = 512, C_H = 1024, C_Q = 1536, C_K = 2048, C_V = 2176;
constexpr float EPS = 1e-6f;
constexpr size_t MiB = 1u << 20;
constexpr size_t WS_CTL = 0;
constexpr size_t WS_MOD = 1 * MiB;
constexpr size_t WS_BIAS = WS_MOD + 256 * 1024;
constexpr size_t WS_WIN = 2 * MiB;
constexpr size_t WS_WOUT = 7 * MiB;
constexpr size_t WS_WQ = 9 * MiB;
constexpr size_t WS_KEYS = 13 * MiB;
constexpr size_t WS_SU = WS_MOD + 384 * 1024;
constexpr size_t WS_SV = WS_MOD + 448 * 1024;
constexpr size_t WS_U = 14 * MiB;
constexpr size_t WS_V = 30 * MiB;
constexpr size_t WS_H = 78 * MiB;
constexpr size_t WS_MIX = 142 * MiB;
constexpr size_t WS_H4 = WS_MIX + 16 * MiB;
constexpr size_t WS_ST = WS_MOD + 512 * 1024;
constexpr size_t WS_CP = WS_MIX + 48 * MiB;
constexpr size_t WS_CS = WS_MOD + 640 * 1024;
constexpr size_t WS_PACK = WS_MIX;
constexpr size_t WS_PROJ = 206 * MiB;
constexpr size_t WS_PART = WS_PROJ;
constexpr size_t WS_EIDX = 350 * MiB;
constexpr size_t WS_GATE = 366 * MiB;
constexpr size_t WS_DELTA = 382 * MiB;
constexpr size_t WS_END = 510 * MiB;

constexpr int LDS_BYTES = 147456;

#define GAS __attribute__((address_space(1)))
#define LAS __attribute__((address_space(3)))
typedef unsigned short bf16;
typedef unsigned v4u __attribute__((ext_vector_type(4)));
typedef unsigned v2u __attribute__((ext_vector_type(2)));
typedef float f32x4 __attribute__((ext_vector_type(4)));
typedef float f32x16 __attribute__((ext_vector_type(16)));
typedef short bf16x8 __attribute__((ext_vector_type(8)));
typedef int v8i __attribute__((ext_vector_type(8)));

__device__ __forceinline__ unsigned f2bf(float f) { unsigned u = __builtin_bit_cast(unsigned, f); return (u + 0x7fffu + ((u >> 16) & 1u)) >> 16; }
__device__ __forceinline__ unsigned pk2(float lo, float hi) { unsigned r; asm("v_cvt_pk_bf16_f32 %0, %1, %2" : "=v"(r) : "v"(lo), "v"(hi)); return r; }
__device__ __forceinline__ float bf_lo(unsigned w) { return __builtin_bit_cast(float, w << 16); }
__device__ __forceinline__ float bf_hi(unsigned w) { return __builtin_bit_cast(float, w & 0xffff0000u); }
__device__ __forceinline__ float wave_sum(float v) {
#pragma unroll
    for (int o = 1; o < 64; o <<= 1) v += __shfl_xor(v, o);
    return v;
}

#define XB_TMO      128
#define XB_XCNT(j)  (256  + 64 * (j))
#define XB_XSUB(j)  (1280 + 64 * (j))
#define XB_XGEN(j)  (2304 + 64 * (j))
#define XB_TOP      3328
#define XB_TOPGEN   3392
#define XCD_BAR_WORDS 3456
#define XB_SPIN_CAP (1u << 18)
__device__ __forceinline__ unsigned xb_ld(unsigned* p)              { return __hip_atomic_load(p, __ATOMIC_RELAXED, __HIP_MEMORY_SCOPE_AGENT); }
__device__ __forceinline__ unsigned xb_add(unsigned* p, unsigned v) { return __hip_atomic_fetch_add(p, v, __ATOMIC_RELAXED, __HIP_MEMORY_SCOPE_AGENT); }
__device__ __forceinline__ unsigned xb_xcc_id() { return (unsigned)__builtin_amdgcn_s_getreg((3 << 11) | 20) & 0xFu; }
#define XB_SPIN(cond, bar) do { unsigned _sp = 0; while (cond) { __builtin_amdgcn_s_sleep(1); \
    if ((++_sp & 255u) == 0u) { if (xb_ld(&(bar)[XB_TMO])) break; if (_sp > XB_SPIN_CAP) { atomicAdd(&(bar)[XB_TMO], 1u); break; } } } } while (0)
struct XcdBarrier { unsigned* bar; unsigned x; volatile LAS unsigned* st; };
__device__ __forceinline__ XcdBarrier xcd_barrier_post(unsigned* bar, volatile LAS unsigned* st) {
    XcdBarrier b; b.bar = bar; b.x = xb_xcc_id(); b.st = st;
    if (threadIdx.x == 0) (void)xb_add(&bar[XB_XCNT(b.x)], 1u);
    return b;
}
__device__ __forceinline__ void xcd_barrier_complete(unsigned* bar, unsigned x, unsigned& nloc, unsigned& nx) {
    const unsigned G = gridDim.x * gridDim.y * gridDim.z;
    unsigned sum, cnt, mine, sp = 0u;
    for (;;) {
        sum = 0u; cnt = 0u; mine = 0u;
#pragma unroll
        for (unsigned j = 0; j < 16; ++j) { const unsigned c = xb_ld(&bar[XB_XCNT(j)]); sum += c; cnt += (c > 0u) ? 1u : 0u; mine = (j == x) ? c : mine; }
        if (sum == G) break;
        __builtin_amdgcn_s_sleep(1);
        if ((++sp & 255u) == 0u) { if (xb_ld(&bar[XB_TMO])) break; if (sp > XB_SPIN_CAP) { atomicAdd(&bar[XB_TMO], 1u); break; } }
    }
    nloc = mine > 0u ? mine : 1u; nx = cnt > 0u ? cnt : 1u;
}
__device__ __forceinline__ void xcd_barrier(const XcdBarrier& b) {
    asm volatile("s_waitcnt vmcnt(0)" ::: "memory");
    __syncthreads();
    if (threadIdx.x == 0) {
        unsigned* bar = b.bar;
        __builtin_amdgcn_s_waitcnt(0);
        unsigned nloc = b.st[0], nx = b.st[1];
        if (nloc == 0u) { xcd_barrier_complete(bar, b.x, nloc, nx); b.st[0] = nloc; b.st[1] = nx; }
        const unsigned old = xb_add(&bar[XB_XSUB(b.x)], 1u);
        const unsigned gen = old / nloc;
        if (old + 1u == (gen + 1u) * nloc) {
            __builtin_amdgcn_fence(__ATOMIC_RELEASE, "agent");
            asm volatile("s_waitcnt vmcnt(0)" ::: "memory");
            const unsigned og = xb_add(&bar[XB_TOP], 1u);
            const unsigned tg = og / nx;
            if (og + 1u == (tg + 1u) * nx) xb_add(&bar[XB_TOPGEN], 1u);
            else XB_SPIN(xb_ld(&bar[XB_TOPGEN]) == tg, bar);
            __builtin_amdgcn_fence(__ATOMIC_ACQUIRE, "agent");
            xb_add(&bar[XB_XGEN(b.x)], 1u);
            asm volatile("s_waitcnt vmcnt(0)" ::: "memory");
        } else {
            XB_SPIN(xb_ld(&bar[XB_XGEN(b.x)]) == gen, bar);
            __builtin_amdgcn_fence(__ATOMIC_ACQUIRE, "agent");
            asm volatile("s_waitcnt vmcnt(0)" ::: "memory");
        }
    }
    __syncthreads();
}

struct Args {
    const float *x, *c, *w_ada, *b_ada, *norm1_g, *w_in, *conv_w, *q_norm_g, *k_norm_g, *sinks, *rel_bias, *conv_out_g, *attn_out_g, *w_out, *norm2_g, *peer_wq, *peer_keys, *peer_u, *peer_v;
    float* out; unsigned char* ws; int ph_lo, ph_hi, var, pad;
};

struct Frame {
    LAS unsigned char* lds; int tid, lane, wave, G, bid;
    int sl_x, sl_rank, sl_n;
};

__device__ __forceinline__ void mod_item(const Args& a, Frame& F, int item) {
    LAS float* sc = (LAS float*)F.lds;
    LAS float* red = (LAS float*)(F.lds + 32768);
    for (int i = F.tid; i < 8192; i += NTHREADS) { const float v = a.c[i]; sc[i] = v / (1.f + __expf(-v)); }
    __syncthreads();
    const int cl = F.tid & 31, kg = F.tid >> 5, col = item * 32 + cl;
    float acc[8];
#pragma unroll
    for (int b = 0; b < 8; ++b) acc[b] = 0.f;
#pragma unroll 1
    for (int k0 = kg * 64; k0 < kg * 64 + 64; k0 += 32) { float w[32];
#pragma unroll
        for (int i = 0; i < 32; ++i) w[i] = a.w_ada[(size_t)(k0 + i) * 6144 + col];
#pragma unroll
        for (int i = 0; i < 32; ++i)
#pragma unroll
            for (int b = 0; b < 8; ++b) acc[b] += sc[b * 1024 + k0 + i] * w[i]; }
#pragma unroll
    for (int b = 0; b < 8; ++b) red[(kg * 32 + cl) * 8 + b] = acc[b];
    __syncthreads();
    if (F.tid < 256) { const int b = F.tid >> 5; float s = 0.f;
#pragma unroll
      for (int g = 0; g < 16; ++g) s += red[(g * 32 + cl) * 8 + b];
      ((float*)(a.ws + WS_MOD))[b * 6144 + col] = s + a.b_ada[col]; }
    __syncthreads();
}
__device__ __forceinline__ void transpose_item(const float* W, int K, int N, bf16* WT, LAS float* scr, int item, int lane) {
    const int nblk = N / 32, kb = item / nblk, nb = item % nblk, k0 = 64 * kb, n0 = 32 * nb;
    { float wv[32];
#pragma unroll
      for (int i = 0; i < 32; ++i) wv[i] = W[(size_t)(k0 + 2 * i + (lane >> 5)) * N + n0 + (lane & 31)];
#pragma unroll
      for (int i = 0; i < 32; ++i) scr[(2 * i + (lane >> 5)) * 33 + (lane & 31)] = wv[i]; }
    asm volatile("s_waitcnt lgkmcnt(0)" ::: "memory");
    const int c = lane & 7;
#pragma unroll
    for (int j = 0; j < 4; ++j) { const int n = (lane >> 3) + 8 * j; const LAS float* s = scr + (8 * c) * 33 + n;
        v4u o; o.x = pk2(s[0 * 33], s[1 * 33]); o.y = pk2(s[2 * 33], s[3 * 33]); o.z = pk2(s[4 * 33], s[5 * 33]); o.w = pk2(s[6 * 33], s[7 * 33]);
        *(v4u*)(WT + (size_t)(n0 + n) * K + k0 + 8 * c) = o; }
    asm volatile("s_waitcnt lgkmcnt(0)" ::: "memory");
}
__device__ __forceinline__ void cvt_rows(const float* src, bf16* dst, size_t n8, size_t gtid, size_t gn) {
    for (size_t i = gtid; i < n8; i += gn) { const f32x4 a = ((const f32x4*)src)[2 * i], b = ((const f32x4*)src)[2 * i + 1];
        v4u o; o.x = pk2(a.x, a.y); o.y = pk2(a.z, a.w); o.z = pk2(b.x, b.y); o.w = pk2(b.z, b.w); ((v4u*)dst)[i] = o; }
}
__device__ __forceinline__ void quant_tables(const Args& a, Frame& F, int widx, int nw) {
    for (int r0 = 4 * widx; r0 < 2 * NEXP; r0 += 4 * nw) {
        const bool isv = r0 >= NEXP; const int e0 = isv ? r0 - NEXP : r0;
        const float* tab = isv ? a.peer_v : a.peer_u;
        f32x4 v[4][4];
#pragma unroll
        for (int r = 0; r < 4; ++r) { const f32x4* src = (const f32x4*)(tab + (size_t)(e0 + r) * D) + F.lane;
#pragma unroll
            for (int j = 0; j < 4; ++j) v[r][j] = src[64 * j]; }
#pragma unroll
        for (int r = 0; r < 4; ++r) { float mx = 0.f;
#pragma unroll
            for (int j = 0; j < 4; ++j) mx = fmaxf(mx, fmaxf(fmaxf(fabsf(v[r][j].x), fabsf(v[r][j].y)), fmaxf(fabsf(v[r][j].z), fabsf(v[r][j].w))));
#pragma unroll
            for (int o = 1; o < 64; o <<= 1) mx = fmaxf(mx, __shfl_xor(mx, o));
            float ssq = 0.f;
#pragma unroll
            for (int j = 0; j < 4; ++j) ssq += (v[r][j].x * v[r][j].x + v[r][j].y * v[r][j].y) + (v[r][j].z * v[r][j].z + v[r][j].w * v[r][j].w);
            ssq = wave_sum(ssq);
            const float rms = sqrtf(ssq * (1.f / D));
            const float scale = mx > 0.f ? (isv ? fminf(mx, 3.0f * rms) * (1.f / 6.f) : fminf(mx, 2.5f * rms) * (1.f / 7.f)) : 1.f, inv = 1.f / scale;
            unsigned char* dst = a.ws + (isv ? WS_V : WS_U) + (size_t)(e0 + r) * 128 + 2 * F.lane;
#pragma unroll
            for (int j = 0; j < 4; ++j) { unsigned w;
                if (isv) { const float y0 = fminf(fmaxf(v[r][j].x * inv, -6.f), 6.f), y1 = fminf(fmaxf(v[r][j].y * inv, -6.f), 6.f), y2 = fminf(fmaxf(v[r][j].z * inv, -6.f), 6.f), y3 = fminf(fmaxf(v[r][j].w * inv, -6.f), 6.f);
                    w = __builtin_amdgcn_cvt_scalef32_pk_fp4_f32(0u, y0, y1, 1.0f, 0); w = __builtin_amdgcn_cvt_scalef32_pk_fp4_f32(w, y2, y3, 1.0f, 1); }
                else { w = 0u;
#pragma unroll
                    for (int c = 0; c < 4; ++c) { const int qi = (int)fminf(fmaxf(rintf(v[r][j][c] * inv), -7.f), 7.f); w |= ((unsigned)qi & 15u) << (4 * c); } }
                *(unsigned short*)(dst + (size_t)j * (2 * MiB)) = (unsigned short)w; }
            if (F.lane == 0) ((float*)(a.ws + (isv ? WS_SV : WS_SU)))[e0 + r] = scale; }
    }
}
__device__ __forceinline__ void prep_rest(const Args& a, Frame& F) {
    LAS float* scr = (LAS float*)(F.lds + 65536 + F.wave * 8448);
    const int gw = F.bid * NWAVES + F.wave, NGW = F.G * NWAVES;
    constexpr int I_IN = (D / 64) * (NIN / 32), I_OUT = (D / 64) * (D / 32), I_Q = (D / 64) * (NQ / 32);
    for (int it = gw; it < I_IN + I_OUT + I_Q; it += NGW) {
        int r = it;
        if (r < I_IN) { transpose_item(a.w_in, D, NIN, (bf16*)(a.ws + WS_WIN), scr, r, F.lane); continue; } r -= I_IN;
        if (r < I_OUT) { transpose_item(a.w_out, D, D, (bf16*)(a.ws + WS_WOUT), scr, r, F.lane); continue; } r -= I_OUT;
        transpose_item(a.peer_wq, D, NQ, (bf16*)(a.ws + WS_WQ), scr, r, F.lane);
    }
    const size_t gtid = (size_t)F.bid * NTHREADS + F.tid, gn = (size_t)F.G * NTHREADS;
    cvt_rows(a.peer_keys, (bf16*)(a.ws + WS_KEYS), (size_t)2 * 8 * 128 * 128 / 8, gtid, gn);
    if (F.bid == 0) { for (int i = F.tid; i < 1024; i += NTHREADS) { const int h = i >> 7, dist = i & 127; int bk;
            if (dist < 16) bk = dist; else { bk = 16 + (int)(__logf((float)dist * (1.f / 16.f)) / 2.0794415416798357f * 16.f); bk = bk < 31 ? bk : 31; }
            ((float*)(a.ws + WS_BIAS))[i] = a.rel_bias[bk * 8 + h]; } }
}
template <bool ADD_DELTA, int RIF>
__device__ __forceinline__ void modnorm_rows(const Args& a, Frame& F, const float* src, const float* g, int sh_off, int sc_off) {
    const int gw = F.bid * NWAVES + F.wave, NGW = F.G * NWAVES;
    const float* mod = (const float*)(a.ws + WS_MOD);
    bf16* H = (bf16*)(a.ws + WS_H);
    for (int m0 = 16 * gw; m0 < T; m0 += 16 * NGW) {
        const float* mb = mod + (size_t)(m0 / SEQ) * 6144;
        f32x4 gam[4], sh[4];
#pragma unroll
        for (int j = 0; j < 4; ++j) { const int col = 4 * F.lane + 256 * j; gam[j] = *(const f32x4*)(g + col) * (*(const f32x4*)(mb + sc_off + col) + 1.f); sh[j] = *(const f32x4*)(mb + sh_off + col); }
#pragma unroll 1
        for (int r0 = 0; r0 < 16; r0 += RIF) {
            f32x4 v[RIF][4]; v2u dl[RIF][4];
#pragma unroll
            for (int r = 0; r < RIF; ++r) { const f32x4* xr = (const f32x4*)(src + (size_t)(m0 + r0 + r) * D) + F.lane;
                const v2u* dr = (const v2u*)((const bf16*)(a.ws + WS_DELTA) + (size_t)(m0 + r0 + r) * D) + F.lane;
#pragma unroll
                for (int j = 0; j < 4; ++j) { v[r][j] = xr[64 * j]; if (ADD_DELTA) dl[r][j] = dr[64 * j]; } }
#pragma unroll
            for (int r = 0; r < RIF; ++r) { float s = 0.f;
                if (ADD_DELTA) {
#pragma unroll
                    for (int j = 0; j < 4; ++j) { v[r][j].x += bf_lo(dl[r][j].x); v[r][j].y += bf_hi(dl[r][j].x); v[r][j].z += bf_lo(dl[r][j].y); v[r][j].w += bf_hi(dl[r][j].y); } }
#pragma unroll
                for (int j = 0; j < 4; ++j) s += (v[r][j].x * v[r][j].x + v[r][j].y * v[r][j].y) + (v[r][j].z * v[r][j].z + v[r][j].w * v[r][j].w);
                const float rstd = rsqrtf(wave_sum(s) * (1.f / D) + EPS);
                v2u* o8 = (v2u*)(H + (size_t)(m0 + r0 + r) * D) + F.lane;
                f32x4 y[4]; float am = 0.f;
#pragma unroll
                for (int j = 0; j < 4; ++j) { y[j] = v[r][j] * rstd * gam[j] + sh[j]; v2u w; w.x = pk2(y[j].x, y[j].y); w.y = pk2(y[j].z, y[j].w); o8[64 * j] = w;
                    am = fmaxf(am, fmaxf(fmaxf(fabsf(y[j].x), fabsf(y[j].y)), fmaxf(fabsf(y[j].z), fabsf(y[j].w)))); }
                if (ADD_DELTA) {
#pragma unroll
                    for (int o = 1; o < 64; o <<= 1) am = fmaxf(am, __shfl_xor(am, o));
                    const float st = am > 0.f ? am * (1.f / 7.f) : 1.f, ist = 1.f / st;
                    unsigned char* hp = a.ws + WS_H4 + (size_t)(m0 + r0 + r) * 1024 + 2 * F.lane;
#pragma unroll
                    for (int j = 0; j < 4; ++j) { unsigned w0 = 0u, w1 = 0u;
#pragma unroll
                        for (int c = 0; c < 4; ++c) { const float rr = y[j][c] * ist; const float d0 = fminf(fmaxf(rintf(rr), -7.f), 7.f); const float d1 = fminf(fmaxf(rintf((rr - d0) * 16.f), -8.f), 7.f);
                            w0 |= ((unsigned)(int)d0 & 15u) << (4 * c); w1 |= ((unsigned)(int)d1 & 15u) << (4 * c); }
                        *(unsigned short*)(hp + 128 * j) = (unsigned short)w0; *(unsigned short*)(hp + 512 + 128 * j) = (unsigned short)w1; }
                    if (F.lane == 0) ((float*)(a.ws + WS_ST))[m0 + r0 + r] = st; } }
        }
    }
}

constexpr int KS_STRIDE = 72, VT_STRIDE = 260;
constexpr int ATT_KS = 0, ATT_VT = 256 * KS_STRIDE * 2, ATT_BIAS = ATT_VT + 64 * VT_STRIDE * 2, ATT_Q = ATT_BIAS + 8192;
__device__ __forceinline__ void attn_unit(const Args& a, Frame& F, int unit, int pv = 0) {
    const int kvh = unit & 1, nb = (unit >> 1) & 31, b = unit >> 6;
    const bf16* PROJ = (const bf16*)(a.ws + WS_PROJ);
    bf16* MIX = (bf16*)(a.ws + WS_MIX);
    LAS bf16* Ks = (LAS bf16*)(F.lds + ATT_KS); LAS bf16* Vt = (LAS bf16*)(F.lds + ATT_VT); LAS float* bl = (LAS float*)(F.lds + ATT_BIAS);
    const int g = F.wave & 3, hq = kvh * 4 + g, hh = F.lane >> 5, l31 = F.lane & 31;
    v4u qraw[2][4];
#pragma unroll
    for (int qq = 0; qq < 2; ++qq) { const int qi = 32 * ((F.wave >> 2) * 2 + qq) + l31; const size_t tok = (size_t)b * SEQ + nb * 128 + qi;
#pragma unroll
        for (int ks = 0; ks < 4; ++ks) qraw[qq][ks] = *(const v4u*)(PROJ + tok * NIN + C_Q + hq * 64 + 16 * ks + 8 * hh); }
    if (pv != 2) {
        const int key = F.tid >> 1, half = F.tid & 1; const bool valid = (nb > 0) || (key >= 128);
        const size_t tok = (size_t)b * SEQ + nb * 128 - 128 + key;
        v4u kr[4], vr[4];
#pragma unroll
        for (int i = 0; i < 4; ++i) { kr[i] = (v4u){0u, 0u, 0u, 0u}; vr[i] = kr[i]; }
        if (valid) {
            const v4u* kp = (const v4u*)(PROJ + tok * NIN + C_K + kvh * 64 + 32 * half);
            const v4u* vp = (const v4u*)(PROJ + tok * NIN + C_V + kvh * 64 + 32 * half);
#pragma unroll
            for (int i = 0; i < 4; ++i) { kr[i] = kp[i]; vr[i] = vp[i]; }
        }
        float ss = 0.f;
#pragma unroll
        for (int i = 0; i < 4; ++i) {
#pragma unroll
            for (int e = 0; e < 4; ++e) { const float lo = bf_lo(kr[i][e]), hi = bf_hi(kr[i][e]); ss += lo * lo + hi * hi; } }
        ss += __shfl_xor(ss, 1);
        const float rstd = rsqrtf(ss * (1.f / 64.f) + EPS);
#pragma unroll
        for (int i = 0; i < 4; ++i) { v4u o;
#pragma unroll
            for (int e = 0; e < 4; ++e) { const int d = 32 * half + 8 * i + 2 * e;
                o[e] = pk2(bf_lo(kr[i][e]) * rstd * a.k_norm_g[d], bf_hi(kr[i][e]) * rstd * a.k_norm_g[d + 1]); }
            *(LAS v4u*)(Ks + key * KS_STRIDE + 32 * half + 8 * i) = o; }
#pragma unroll
        for (int i = 0; i < 4; ++i)
#pragma unroll
            for (int e = 0; e < 4; ++e) { const int d = 32 * half + 8 * i + 2 * e;
                Vt[d * VT_STRIDE + key] = (bf16)(vr[i][e] & 0xffffu); Vt[(d + 1) * VT_STRIDE + key] = (bf16)(vr[i][e] >> 16); }
        for (int i = F.tid; i < 768; i += NTHREADS) { const int g = i / 192, dist = i % 192 - 32;
            bl[i] = (dist >= 0 && dist < 128) ? ((const float*)(a.ws + WS_BIAS))[(kvh * 4 + g) * 128 + dist] * 1.4426950408889634f : 0.f; }
        if (F.tid < 64) bl[768 + F.tid] = a.q_norm_g[F.tid]; else if (F.tid < 128) bl[768 + F.tid] = a.k_norm_g[F.tid - 64]; else if (F.tid < 384) bl[768 + F.tid] = a.attn_out_g[kvh * 256 + (F.tid - 128)];
    }
    { LAS v4u* qpark = (LAS v4u*)(F.lds + ATT_Q) + F.wave * 512 + F.lane;
#pragma unroll
      for (int qq = 0; qq < 2; ++qq)
#pragma unroll
          for (int ks = 0; ks < 4; ++ks) qpark[(qq * 4 + ks) * 64] = qraw[qq][ks]; }
    __syncthreads();
    const float sink2 = a.sinks[hq] * 1.4426950408889634f;
#pragma unroll 1
    for (int qq = 0; qq < (pv == 1 ? 0 : 2); ++qq) {
        const int qt = (F.wave >> 2) * 2 + qq, qi = 32 * qt + l31;
        const size_t tok = (size_t)b * SEQ + nb * 128 + qi;
        bf16x8 qf[4];
        {
            v4u qr[4]; float ss = 0.f;
#pragma unroll
            for (int ks = 0; ks < 4; ++ks) { qr[ks] = ((const LAS v4u*)(F.lds + ATT_Q))[F.wave * 512 + (qq * 4 + ks) * 64 + F.lane];
#pragma unroll
                for (int e = 0; e < 4; ++e) { const float lo = bf_lo(qr[ks][e]), hi = bf_hi(qr[ks][e]); ss += lo * lo + hi * hi; } }
            ss += __shfl_xor(ss, 32);
            const float rstd = rsqrtf(ss * (1.f / 64.f) + EPS) * (0.125f * 1.4426950408889634f);
#pragma unroll
            for (int ks = 0; ks < 4; ++ks) { v4u o;
#pragma unroll
                for (int e = 0; e < 4; ++e) { const int d = 16 * ks + 8 * hh + 2 * e;
                    o[e] = pk2(bf_lo(qr[ks][e]) * rstd * bl[768 + d], bf_hi(qr[ks][e]) * rstd * bl[768 + d + 1]); }
                qf[ks] = __builtin_bit_cast(bf16x8, o); }
        }
        f32x16 s[5];
#pragma unroll
        for (int k5 = 0; k5 < 5; ++k5) { const int kt = qt + k5;
            f32x16 acc;
#pragma unroll
            for (int r = 0; r < 16; ++r) acc[r] = 0.f;
#pragma unroll
            for (int ks = 0; ks < 4; ++ks) { const bf16x8 kf = *(const LAS bf16x8*)(Ks + (32 * kt + l31) * KS_STRIDE + 16 * ks + 8 * hh);
                acc = __builtin_amdgcn_mfma_f32_32x32x16_bf16(kf, qf[ks], acc, 0, 0, 0); }
            s[k5] = acc; }
        float mx = -INFINITY;
        const LAS float* blb = bl + (g * 192 + 32 + l31 - 4 * hh - 27); const int dbase = l31 - 4 * hh + 128;
#pragma unroll
        for (int k5 = 0; k5 < 5; ++k5) { const float pen_tile = (nb == 0 && (qt + k5) < 4) ? -INFINITY : 0.f;
#pragma unroll
            for (int r = 0; r < 16; ++r) { const int cr = (r & 3) + 8 * (r >> 2);
                float v = s[k5][r] + blb[155 - 32 * k5 - cr] + pen_tile;
                if (k5 == 0) v += (dbase - cr > 127) ? -INFINITY : 0.f;
                if (k5 == 4) v += (dbase - 128 - cr < 0) ? -INFINITY : 0.f;
                s[k5][r] = v; mx = fmaxf(mx, v); }
            __builtin_amdgcn_sched_barrier(0); }
        mx = fmaxf(mx, __shfl_xor(mx, 32)); mx = fmaxf(mx, sink2);
        float ls = 0.f;
#pragma unroll
        for (int k5 = 0; k5 < 5; ++k5)
#pragma unroll
            for (int r = 0; r < 16; ++r) { const float p = __builtin_amdgcn_exp2f(s[k5][r] - mx); s[k5][r] = p; ls += p; }
        ls += __shfl_xor(ls, 32);
        const float inv = 1.f / (ls + __builtin_amdgcn_exp2f(sink2 - mx));
        f32x16 o[2];
#pragma unroll
        for (int dt = 0; dt < 2; ++dt)
#pragma unroll
            for (int r = 0; r < 16; ++r) o[dt][r] = 0.f;
#pragma unroll
        for (int k5 = 0; k5 < 5; ++k5)
#pragma unroll
            for (int s2 = 0; s2 < 2; ++s2) { const int kt = qt + k5;
                v4u pw; pw.x = pk2(s[k5][8 * s2 + 0], s[k5][8 * s2 + 1]); pw.y = pk2(s[k5][8 * s2 + 2], s[k5][8 * s2 + 3]); pw.z = pk2(s[k5][8 * s2 + 4], s[k5][8 * s2 + 5]); pw.w = pk2(s[k5][8 * s2 + 6], s[k5][8 * s2 + 7]);
                const bf16x8 pf = __builtin_bit_cast(bf16x8, pw);
#pragma unroll
                for (int dt = 0; dt < 2; ++dt) { const LAS bf16* vp = Vt + (32 * dt + l31) * VT_STRIDE + 32 * kt + 16 * s2 + 4 * hh;
                    const v2u v0 = *(const LAS v2u*)vp, v1 = *(const LAS v2u*)(vp + 8);
                    v4u vw; vw.x = v0.x; vw.y = v0.y; vw.z = v1.x; vw.w = v1.y;
                    o[dt] = __builtin_amdgcn_mfma_f32_32x32x16_bf16(__builtin_bit_cast(bf16x8, vw), pf, o[dt], 0, 0, 0); }
                asm volatile("" ::: "memory"); }
        float ss = 0.f;
#pragma unroll
        for (int dt = 0; dt < 2; ++dt)
#pragma unroll
            for (int r = 0; r < 16; ++r) { o[dt][r] *= inv; ss += o[dt][r] * o[dt][r]; }
        ss += __shfl_xor(ss, 32);
        const float rstd = rsqrtf(ss * (1.f / 64.f) + EPS);
#pragma unroll
        for (int dt = 0; dt < 2; ++dt)
#pragma unroll
            for (int rq = 0; rq < 4; ++rq) { const int d = 32 * dt + 8 * rq + 4 * hh; const f32x4 gg = *(const LAS f32x4*)(bl + 896 + g * 64 + d);
                v2u w; w.x = pk2(o[dt][4 * rq + 0] * rstd * gg.x, o[dt][4 * rq + 1] * rstd * gg.y); w.y = pk2(o[dt][4 * rq + 2] * rstd * gg.z, o[dt][4 * rq + 3] * rstd * gg.w);
                *(v2u*)(MIX + tok * D + 512 + hq * 64 + d) = w; }
    }
    __syncthreads();
}
__device__ __forceinline__ void unpack8(const v4u r, float (&f)[8]) {
#pragma unroll
    for (int e = 0; e < 4; ++e) { f[2 * e] = bf_lo(r[e]); f[2 * e + 1] = bf_hi(r[e]); }
}
__device__ __forceinline__ void conv_unit(const Args& a, Frame& F, int unit) {
    const int nb = unit & 31, b = unit >> 5;
    const bf16* PROJ = (const bf16*)(a.ws + WS_PROJ);
    bf16* MIX = (bf16*)(a.ws + WS_MIX);
    const int ch = 8 * F.lane, pos0 = nb * 128 + 16 * F.wave;
    const size_t tok0 = (size_t)b * SEQ + pos0;
    float w0[8], w1[8], w2[8], gg[8], um2[8], um1[8];
#pragma unroll
    for (int e = 0; e < 8; ++e) { w0[e] = a.conv_w[ch + e]; w1[e] = a.conv_w[512 + ch + e]; w2[e] = a.conv_w[1024 + ch + e]; gg[e] = a.conv_out_g[ch + e]; um2[e] = 0.f; um1[e] = 0.f; }
    if (pos0 >= 2) {
        float c[8], h[8];
        unpack8(*(const v4u*)(PROJ + (tok0 - 2) * NIN + C_C + ch), c); unpack8(*(const v4u*)(PROJ + (tok0 - 2) * NIN + C_H + ch), h);
#pragma unroll
        for (int e = 0; e < 8; ++e) um2[e] = c[e] * h[e];
        unpack8(*(const v4u*)(PROJ + (tok0 - 1) * NIN + C_C + ch), c); unpack8(*(const v4u*)(PROJ + (tok0 - 1) * NIN + C_H + ch), h);
#pragma unroll
        for (int e = 0; e < 8; ++e) um1[e] = c[e] * h[e];
    }
#pragma unroll 1
    for (int i0 = 0; i0 < 16; i0 += 4) {
        v4u rb[4], rc[4], rh[4];
#pragma unroll
        for (int i = 0; i < 4; ++i) { const size_t tok = tok0 + i0 + i; rb[i] = *(const v4u*)(PROJ + tok * NIN + C_B + ch); rc[i] = *(const v4u*)(PROJ + tok * NIN + C_C + ch); rh[i] = *(const v4u*)(PROJ + tok * NIN + C_H + ch); }
#pragma unroll
        for (int i = 0; i < 4; ++i) { const size_t tok = tok0 + i0 + i;
            float bg[8], c[8], h[8], y[8]; float ss = 0.f;
            unpack8(rb[i], bg); unpack8(rc[i], c); unpack8(rh[i], h);
#pragma unroll
            for (int e = 0; e < 8; ++e) { const float u0 = c[e] * h[e]; y[e] = bg[e] * (w0[e] * um2[e] + w1[e] * um1[e] + w2[e] * u0); ss += y[e] * y[e]; um2[e] = um1[e]; um1[e] = u0; }
            ss += __shfl_xor(ss, 1); ss += __shfl_xor(ss, 2); ss += __shfl_xor(ss, 4);
            const float rstd = rsqrtf(ss * (1.f / 64.f) + EPS);
            v4u o;
#pragma unroll
            for (int e = 0; e < 4; ++e) o[e] = pk2(y[2 * e] * rstd * gg[2 * e], y[2 * e + 1] * rstd * gg[2 * e + 1]);
            *(v4u*)(MIX + tok * D + ch) = o; }
    }
}

#define CE_DESC(x, y) do { const unsigned _hi = (x) > (y) ? (x) : (y), _lo = (x) > (y) ? (y) : (x); (x) = _hi; (y) = _lo; } while (0)
__device__ __forceinline__ void sort16_desc(unsigned (&v)[16]) {
#define S16(i, j) CE_DESC(v[i], v[j]);
    S16(0, 1) S16(2, 3) S16(0, 2) S16(1, 3) S16(1, 2) S16(4, 5) S16(6, 7) S16(4, 6) S16(5, 7) S16(5, 6) S16(0, 4) S16(2, 6) S16(2, 4) S16(1, 5) S16(3, 7) S16(3, 5) S16(1, 2) S16(3, 4) S16(5, 6)
    S16(8, 9) S16(10, 11) S16(8, 10) S16(9, 11) S16(9, 10) S16(12, 13) S16(14, 15) S16(12, 14) S16(13, 15) S16(13, 14) S16(8, 12) S16(10, 14) S16(10, 12) S16(9, 13) S16(11, 15) S16(11, 13) S16(9, 10) S16(11, 12) S16(13, 14)
    S16(0, 8) S16(4, 12) S16(4, 8) S16(2, 10) S16(6, 14) S16(6, 10) S16(2, 4) S16(6, 8) S16(10, 12) S16(1, 9) S16(5, 13) S16(5, 9) S16(3, 11) S16(7, 15) S16(7, 11) S16(3, 5) S16(7, 9) S16(11, 13)
    S16(1, 2) S16(3, 4) S16(5, 6) S16(7, 8) S16(9, 10) S16(11, 12) S16(13, 14)
#undef S16
}
__device__ __forceinline__ void merge16_desc(unsigned (&x)[16], const unsigned (&y)[16]) {
#pragma unroll
    for (int i = 0; i < 16; ++i) x[i] = x[i] > y[15 - i] ? x[i] : y[15 - i];
#pragma unroll
    for (int j = 8; j > 0; j >>= 1)
#pragma unroll
        for (int i = 0; i < 16; ++i) if ((i & j) == 0) CE_DESC(x[i], x[i | j]);
}
constexpr int KEY_LDS_STRIDE = 136;
__device__ __forceinline__ void side_top16(const bf16* QP, const LAS bf16* KL, int tok0, int h, int s, int lane, unsigned (&top)[16]) {
    const int l31 = lane & 31, hh = lane >> 5;
    bf16x8 qf[8];
    const bf16* qp = QP + (size_t)(tok0 + l31) * NQ + h * 256 + s * 128 + 8 * hh;
#pragma unroll
    for (int ks = 0; ks < 8; ++ks) qf[ks] = *(const bf16x8*)(qp + 16 * ks);
    const LAS bf16* kp = KL + (s * 128 + l31) * KEY_LDS_STRIDE + 8 * hh;
#define SIDE_TILE(kt, dst) do { f32x16 acc; \
        _Pragma("unroll") for (int r = 0; r < 16; ++r) acc[r] = 0.f; \
        _Pragma("unroll") for (int ks = 0; ks < 8; ++ks) { const bf16x8 kf = *(const LAS bf16x8*)(kp + (32 * (kt)) * KEY_LDS_STRIDE + 16 * ks); \
            acc = __builtin_amdgcn_mfma_f32_32x32x16_bf16(kf, qf[ks], acc, 0, 0, 0); } \
        _Pragma("unroll") for (int r = 0; r < 16; ++r) { const int nn = 32 * (kt) + (r & 3) + 8 * (r >> 2) + 4 * hh; \
            int fx = (int)__builtin_fmaf(acc[r], 524288.f, 16777216.f); fx = fx < 0 ? 0 : (fx > (1 << 25) - 1 ? (1 << 25) - 1 : fx); \
            dst[r] = ((unsigned)fx << 7) | (unsigned)(127 - nn); } \
        sort16_desc(dst); } while (0)
    SIDE_TILE(0, top);
#pragma unroll 1
    for (int kt = 1; kt < 4; ++kt) { unsigned v[16]; SIDE_TILE(kt, v); merge16_desc(top, v); }
#undef SIDE_TILE
    unsigned oth[16];
#pragma unroll
    for (int i = 0; i < 16; ++i) oth[i] = (unsigned)__shfl_xor((int)top[i], 32);
    merge16_desc(top, oth);
}
__device__ __forceinline__ void topk_unit(const Args& a, Frame& F, int tile, int h) {
    const int tok0 = tile * 32;
    const bf16* QP = (const bf16*)(a.ws + WS_PROJ); const LAS bf16* KL = (const LAS bf16*)F.lds;
    unsigned ka[16], kb[16];
    side_top16(QP, KL, tok0, h, 0, F.lane, ka);
    side_top16(QP, KL, tok0, h, 1, F.lane, kb);
    unsigned c[4][16];
    int n = 0;
#pragma unroll
    for (int i = 0; i < 16; ++i)
#pragma unroll
        for (int j = 0; j < 16; ++j) if ((i + 1) * (j + 1) <= 16) {
            int sfx = (int)(ka[i] >> 7) + (int)(kb[j] >> 7) - (1 << 25);
            sfx = sfx < 0 ? 0 : (sfx > (1 << 23) - 1 ? (1 << 23) - 1 : sfx);
            const unsigned e = (127u - (ka[i] & 127u)) * 128u + (127u - (kb[j] & 127u));
            c[n >> 4][n & 15] = ((unsigned)(sfx >> 5) << 14) | (16383u - e); ++n; }
#pragma unroll
    for (; n < 64; ++n) c[n >> 4][n & 15] = 0u;
    sort16_desc(c[0]); sort16_desc(c[1]); sort16_desc(c[2]); CE_DESC(c[3][0], c[3][1]);
    merge16_desc(c[0], c[1]); merge16_desc(c[2], c[3]); merge16_desc(c[0], c[2]);
    float w[16]; float sum = 0.f; const float f0 = (float)(c[0][0] >> 14);
#pragma unroll
    for (int k = 0; k < 16; ++k) { w[k] = __expf(((float)(c[0][k] >> 14) - f0) * (1.f / 16384.f)); sum += w[k]; }
    const float inv = 1.f / sum;
    const int tok = tok0 + (F.lane & 31), hh = F.lane >> 5;
    int* ei = (int*)(a.ws + WS_EIDX) + (size_t)tok * 128 + h * 16 + 8 * hh;
    float* gt = (float*)(a.ws + WS_GATE) + (size_t)tok * 128 + h * 16 + 8 * hh;
    v4u e0, e1; f32x4 g0, g1;
#pragma unroll
    for (int k = 0; k < 4; ++k) { const unsigned x0 = hh ? c[0][8 + k] : c[0][k], x1 = hh ? c[0][12 + k] : c[0][4 + k];
        e0[k] = 16383u - (x0 & 16383u); e1[k] = 16383u - (x1 & 16383u);
        g0[k] = (hh ? w[8 + k] : w[k]) * inv; g1[k] = (hh ? w[12 + k] : w[4 + k]) * inv; }
    *(v4u*)ei = e0; *(v4u*)(ei + 4) = e1; *(f32x4*)gt = g0; *(f32x4*)(gt + 4) = g1;
}

__device__ __forceinline__ float gelu_tanh(float x) {
    const float u = 0.7978845608028654f * (x + 0.044715f * x * x * x);
    const float t = 1.f - 2.f / (1.f + __expf(2.f * u));
    return 0.5f * x * (1.f + t);
}
__device__ __forceinline__ void peer_coef(const Args& a, Frame& F) {
    const int gw = F.bid * NWAVES + F.wave, NGW = F.G * NWAVES, lane = F.lane;
    const float* SU = (const float*)(a.ws + WS_SU); const float* SV = (const float*)(a.ws + WS_SV);
    for (int t0 = 4 * gw; t0 < T; t0 += 4 * NGW) {
        float s0[4], s1[4], st[4]; int2 e[4]; float2 g[4]; float su0[4], su1[4], sv0[4], sv1[4];
#pragma unroll
        for (int k = 0; k < 4; ++k) { const int tok = t0 + k;
            const float* pp = (const float*)(a.ws + WS_PART) + (size_t)tok * 512 + 2 * lane;
            float2 p0 = *(const float2*)pp, p1 = *(const float2*)(pp + 128), p2 = *(const float2*)(pp + 256), p3 = *(const float2*)(pp + 384);
            s0[k] = (p0.x + p1.x) + (p2.x + p3.x); s1[k] = (p0.y + p1.y) + (p2.y + p3.y);
            e[k] = *(const int2*)((const int*)(a.ws + WS_EIDX) + (size_t)tok * 128 + 2 * lane);
            g[k] = *(const float2*)((const float*)(a.ws + WS_GATE) + (size_t)tok * 128 + 2 * lane);
            st[k] = ((const float*)(a.ws + WS_ST))[tok]; }
#pragma unroll
        for (int k = 0; k < 4; ++k) { su0[k] = SU[e[k].x]; su1[k] = SU[e[k].y]; sv0[k] = SV[e[k].x]; sv1[k] = SV[e[k].y]; }
#pragma unroll
        for (int k = 0; k < 4; ++k) { const int tok = t0 + k;
            const float r0 = g[k].x * gelu_tanh(s0[k] * (su0[k] * st[k])) * sv0[k], r1 = g[k].y * gelu_tanh(s1[k] * (su1[k] * st[k])) * sv1[k];
            if (!V_MFMA) {
                uint2 w; w.x = ((__float_as_uint(r0) + 0x2000u) & 0xffffc000u) | (unsigned)e[k].x; w.y = ((__float_as_uint(r1) + 0x2000u) & 0xffffc000u) | (unsigned)e[k].y;
                *(uint2*)((unsigned*)(a.ws + WS_PACK) + (size_t)tok * 128 + 2 * lane) = w; }
            if (V_MFMA) {
                float am = fmaxf(fabsf(r0), fabsf(r1));
#pragma unroll
                for (int o = 1; o < 64; o <<= 1) am = fmaxf(am, __shfl_xor(am, o));
                const float cs = am > 0.f ? am * (1.f / 4.5f) : 1.f, ics = 1.f / cs;
                float ra = r0 * ics, rb = r1 * ics;
                unsigned char* cp = a.ws + WS_CP + (size_t)tok * 256 + lane;
#pragma unroll
                for (int pl = 0; pl < 4; ++pl) { const float da = fminf(fmaxf(rintf(ra), -4.f), 4.f), db = fminf(fmaxf(rintf(rb), -4.f), 4.f);
                    cp[64 * pl] = (unsigned char)__builtin_amdgcn_cvt_scalef32_pk_fp4_f32(0u, da, db, 1.0f, 0);
                    ra = (ra - da) * 8.f; rb = (rb - db) * 8.f; }
                if (lane == 0) ((float*)(a.ws + WS_CS))[tok] = cs; }
        }
    }
}
typedef float f32x2 __attribute__((ext_vector_type(2)));
__device__ __forceinline__ float dpp_sum8(float s) {
    s += __builtin_bit_cast(float, __builtin_amdgcn_update_dpp(0, __builtin_bit_cast(int, s), 0xB1, 0xF, 0xF, true));
    s += __builtin_bit_cast(float, __builtin_amdgcn_update_dpp(0, __builtin_bit_cast(int, s), 0x4E, 0xF, 0xF, true));
    s += __builtin_bit_cast(float, __builtin_amdgcn_update_dpp(0, __builtin_bit_cast(int, s), 0x141, 0xF, 0xF, true));
    return s;
}
struct PTok { v4u vr[16]; v4u aux[4]; f32x4 xo, xg; };
template <bool VSIDE>
__device__ __forceinline__ void peer_issue(const unsigned char* TB, unsigned poff, const v4u (&w)[4], PTok& P, const unsigned char* sidep, const float* xop, const float* xgp) {
#pragma unroll
    for (int i = 0; i < 16; ++i) { const unsigned id = w[i >> 2][i & 3] & 0x3fffu; P.vr[i] = *(const v4u*)(TB + (id * 128u + poff)); }
    if (VSIDE) { P.xo = *(const f32x4*)xop; P.xg = *(const f32x4*)xgp; P.aux[0].x = ((const unsigned*)sidep)[0]; P.aux[0].y = ((const unsigned*)sidep)[1]; }
    else { (void)sidep; }
}
template <bool VSIDE>
__device__ __forceinline__ void peer_compute(const PTok& P, const v4u (&w)[4], int lane, float* outp) {
    const int p = lane & 7;
    if (VSIDE) {
        f32x2 acc2[16];
#pragma unroll
        for (int j = 0; j < 16; ++j) acc2[j] = (f32x2){0.f, 0.f};
#pragma unroll
        for (int i = 0; i < 16; ++i) {
            const v2u cpair = (i & 2) ? (v2u){w[i >> 2].z, w[i >> 2].w} : (v2u){w[i >> 2].x, w[i >> 2].y};
#pragma unroll
            for (int q = 0; q < 4; ++q) { const unsigned wd = P.vr[i][q];
                const f32x2 f0 = __builtin_amdgcn_cvt_scalef32_pk_f32_fp4(wd, 1.0f, 0), f1 = __builtin_amdgcn_cvt_scalef32_pk_f32_fp4(wd, 1.0f, 1), f2 = __builtin_amdgcn_cvt_scalef32_pk_f32_fp4(wd, 1.0f, 2), f3 = __builtin_amdgcn_cvt_scalef32_pk_f32_fp4(wd, 1.0f, 3);
                if (i & 1) {
                    asm volatile("v_pk_fma_f32 %0, %1, %2, %0 op_sel:[0,1,0] op_sel_hi:[1,1,1]" : "+v"(acc2[4 * q]) : "v"(f0), "v"(cpair));
                    asm volatile("v_pk_fma_f32 %0, %1, %2, %0 op_sel:[0,1,0] op_sel_hi:[1,1,1]" : "+v"(acc2[4 * q + 1]) : "v"(f1), "v"(cpair));
                    asm volatile("v_pk_fma_f32 %0, %1, %2, %0 op_sel:[0,1,0] op_sel_hi:[1,1,1]" : "+v"(acc2[4 * q + 2]) : "v"(f2), "v"(cpair));
                    asm volatile("v_pk_fma_f32 %0, %1, %2, %0 op_sel:[0,1,0] op_sel_hi:[1,1,1]" : "+v"(acc2[4 * q + 3]) : "v"(f3), "v"(cpair));
                } else {
                    asm volatile("v_pk_fma_f32 %0, %1, %2, %0 op_sel_hi:[1,0,1]" : "+v"(acc2[4 * q]) : "v"(f0), "v"(cpair));
                    asm volatile("v_pk_fma_f32 %0, %1, %2, %0 op_sel_hi:[1,0,1]" : "+v"(acc2[4 * q + 1]) : "v"(f1), "v"(cpair));
                    asm volatile("v_pk_fma_f32 %0, %1, %2, %0 op_sel_hi:[1,0,1]" : "+v"(acc2[4 * q + 2]) : "v"(f2), "v"(cpair));
                    asm volatile("v_pk_fma_f32 %0, %1, %2, %0 op_sel_hi:[1,0,1]" : "+v"(acc2[4 * q + 3]) : "v"(f3), "v"(cpair));
                } } }
        float acc[32];
#pragma unroll
        for (int j = 0; j < 16; ++j) { acc[2 * j] = acc2[j].x; acc[2 * j + 1] = acc2[j].y; }
        const int b5 = (lane >> 5) & 1, b4 = (lane >> 4) & 1, b3 = (lane >> 3) & 1;
        float v1[16], v2[8], v3[4];
#pragma unroll
        for (int j = 0; j < 16; ++j) { const v2u r = __builtin_amdgcn_permlane32_swap(__float_as_uint(acc[j]), __float_as_uint(acc[16 + j]), false, false);
            v1[j] = __uint_as_float(r.x) + __uint_as_float(r.y); }
#pragma unroll
        for (int j = 0; j < 8; ++j) { const v2u r = __builtin_amdgcn_permlane16_swap(__float_as_uint(v1[j]), __float_as_uint(v1[8 + j]), false, false);
            v2[j] = __uint_as_float(r.x) + __uint_as_float(r.y); }
#pragma unroll
        for (int j = 0; j < 4; ++j) { const float kp = b3 ? v2[4 + j] : v2[j], sd = b3 ? v2[j] : v2[4 + j];
            v3[j] = kp + __builtin_bit_cast(float, __builtin_amdgcn_update_dpp(0, __builtin_bit_cast(int, sd), 0x128, 0xF, 0xF, true)); }
        f32x4 o; o.x = (P.xo.x + bf_lo(P.aux[0].x)) + P.xg.x * v3[0]; o.y = (P.xo.y + bf_hi(P.aux[0].x)) + P.xg.y * v3[1]; o.z = (P.xo.z + bf_lo(P.aux[0].y)) + P.xg.z * v3[2]; o.w = (P.xo.w + bf_hi(P.aux[0].y)) + P.xg.w * v3[3]; *(f32x4*)outp = o;
    } else {
        f32x2 keep = {0.f, 0.f};
#pragma unroll
        for (int i = 0; i < 16; ++i) { int s0 = 0, s1 = 0;
#pragma unroll
            for (int q = 0; q < 4; ++q) { s0 = __builtin_amdgcn_sdot8((int)P.vr[i][q], (int)P.aux[0][q], s0, false); s1 = __builtin_amdgcn_sdot8((int)P.vr[i][q], (int)P.aux[1][q], s1, false); }
            const float dt = dpp_sum8((float)s0 + (float)s1 * 0.0625f);
            if ((i >> 1) == p) { if (i & 1) keep.y = dt; else keep.x = dt; } }
        *(f32x2*)outp = keep;
    }
}
template <bool VSIDE>
__device__ __forceinline__ void peer_slice(const Args& a, Frame& F) {
    const int x = F.sl_x, wx = F.sl_rank * NWAVES + F.wave, nwx = F.sl_n * NWAVES;
    if (wx >= T) return;
    const int lane = F.lane, eg = lane >> 3, p = lane & 7;
    const unsigned char* TB = a.ws + (VSIDE ? WS_V : WS_U) + (size_t)x * (2 * MiB); const unsigned poff = 16u * (unsigned)p;
    const unsigned* Wb = (const unsigned*)(a.ws + (VSIDE ? WS_PACK : WS_EIDX)) + 16 * eg;
    const unsigned char* Hb = a.ws + WS_H4 + 128 * x + 16 * p;
    const int dcol = 256 * x + 32 * p + 16 * ((lane >> 5) & 1) + 8 * ((lane >> 4) & 1) + 4 * ((lane >> 3) & 1);
    const float* G2 = (const float*)(a.ws + WS_MOD) + 5120 + dcol;
    float* PART = (float*)(a.ws + WS_PART) + (size_t)x * 128 + 16 * eg + 2 * p;
    const float* X1 = a.x;
    const unsigned char* DLb = a.ws + WS_DELTA + 2 * dcol;
    v4u nA[4], nB[4];
    int tA = wx, tB = wx + nwx;
#define PS_LDW(dst, tok) do { const unsigned* _w = Wb + (size_t)((tok) < T ? (tok) : T - 1) * 128; _Pragma("unroll") for (int _q = 0; _q < 4; ++_q) dst[_q] = *(const v4u*)(_w + 4 * _q); } while (0)
    PS_LDW(nA, tA); PS_LDW(nB, tB);
    v4u hA[2], hB[2];
    if (!VSIDE) { const int tb0 = tB < T ? tB : tA; hA[0] = *(const v4u*)(Hb + (size_t)tA * 1024); hA[1] = *(const v4u*)(Hb + (size_t)tA * 1024 + 512); hB[0] = *(const v4u*)(Hb + (size_t)tb0 * 1024); hB[1] = *(const v4u*)(Hb + (size_t)tb0 * 1024 + 512); }
#pragma unroll 1
    for (; tA < T; tA += 2 * nwx, tB += 2 * nwx) {
        const int tBc = tB < T ? tB : tA;
        v4u wA[4], wB[4];
#pragma unroll
        for (int q = 0; q < 4; ++q) { wA[q] = nA[q]; wB[q] = nB[q]; }
        PTok A, B;
        peer_issue<VSIDE>(TB, poff, wA, A, VSIDE ? DLb + (size_t)tA * 2048 : Hb + (size_t)tA * 1024, X1 + (size_t)tA * D + dcol, G2 + (size_t)(tA / SEQ) * 6144);
        peer_issue<VSIDE>(TB, poff, wB, B, VSIDE ? DLb + (size_t)tBc * 2048 : Hb + (size_t)tBc * 1024, X1 + (size_t)tBc * D + dcol, G2 + (size_t)(tBc / SEQ) * 6144);
        if (!VSIDE) {
            A.aux[0] = hA[0]; A.aux[1] = hA[1]; B.aux[0] = hB[0]; B.aux[1] = hB[1];
            { const int t2 = tA + 2 * nwx < T ? tA + 2 * nwx : T - 1, t3 = tB + 2 * nwx < T ? tB + 2 * nwx : T - 1;
              hA[0] = *(const v4u*)(Hb + (size_t)t2 * 1024); hA[1] = *(const v4u*)(Hb + (size_t)t2 * 1024 + 512); hB[0] = *(const v4u*)(Hb + (size_t)t3 * 1024); hB[1] = *(const v4u*)(Hb + (size_t)t3 * 1024 + 512); }
            PS_LDW(nA, tA + 2 * nwx); PS_LDW(nB, tB + 2 * nwx); }
        peer_compute<VSIDE>(A, wA, lane, VSIDE ? a.out + (size_t)tA * D + dcol : PART + (size_t)tA * 512);
        if (VSIDE) { PS_LDW(nA, tA + 2 * nwx); PS_LDW(nB, tB + 2 * nwx); }
        if (tB < T) peer_compute<VSIDE>(B, wB, lane, VSIDE ? a.out + (size_t)tB * D + dcol : PART + (size_t)tB * 512);
    }
#undef PS_LDW
}

struct VTok { v4u vr[16]; };
struct VStr { v4u aw; f32x4 xo, xg; v2u dl; float cs; };
__device__ __forceinline__ void vmfma_issue(const unsigned char* TB, unsigned poff, const v4u (&w)[4], VTok& P) {
#pragma unroll
    for (int i = 0; i < 16; ++i) { const unsigned id = w[i >> 2][i & 3]; P.vr[i] = *(const v4u*)(TB + (id * 128u + poff)); }
}
__device__ __forceinline__ void vmfma_stream(VStr& S, const unsigned char* cpp, const float* csp, const float* xop, const float* xgp, const unsigned char* dlp) {
    S.aw = *(const v4u*)cpp; S.cs = *csp; S.xo = __builtin_nontemporal_load((const f32x4*)xop); S.xg = *(const f32x4*)xgp; S.dl = __builtin_nontemporal_load((const v2u*)dlp);
}
__device__ __forceinline__ void vmfma_compute(const VTok& P, const VStr& S, int lane, LAS unsigned char* img, float* outp, int pv = 0) {
    const int eg = lane >> 3, p = lane & 7, n = lane & 15, q = lane >> 4;
    if (pv == 1) { unsigned acc = 0;
#pragma unroll
        for (int i = 0; i < 16; ++i) acc ^= P.vr[i].x ^ P.vr[i].w;
        f32x4 o; o.x = S.xo.x + bf_lo(S.dl.x) + S.xg.x * S.cs; o.y = S.xo.y + (acc == 0x12345u ? 1.f : 0.f); o.z = S.xo.z + __uint_as_float(S.aw.x & 1u); o.w = S.xo.w; *(f32x4*)outp = o; return; }
    asm volatile("s_waitcnt lgkmcnt(0)" ::: "memory");
#pragma unroll
    for (int i = 0; i < 16; ++i) *(LAS v4u*)(img + (16 * eg + i) * 128 + 16 * (p ^ (i & 7))) = P.vr[i];
    asm volatile("s_waitcnt lgkmcnt(0)" ::: "memory");
    const unsigned rowb = (unsigned)(size_t)img + (unsigned)(32 * q + n) * 128u;
    v8i A; A[0] = (int)S.aw.x; A[1] = (int)S.aw.y; A[2] = (int)S.aw.z; A[3] = (int)S.aw.w; A[4] = 0; A[5] = 0; A[6] = 0; A[7] = 0;
    LAS float* scr = (LAS float*)(img + 16384);
#pragma unroll
    for (int hb = 0; hb < 2; ++hb) {
        v2u tr[8][2];
#pragma unroll
        for (int t2 = 0; t2 < 4; ++t2) { const unsigned a0 = rowb + 16u * (unsigned)((4 * hb + t2) ^ (n & 7));
            asm volatile("ds_read_b64_tr_b4 %0, %1" : "=v"(tr[2 * t2][0]) : "v"(a0) : "memory");
            asm volatile("ds_read_b64_tr_b4 %0, %1 offset:2048" : "=v"(tr[2 * t2][1]) : "v"(a0) : "memory");
            asm volatile("ds_read_b64_tr_b4 %0, %1 offset:8" : "=v"(tr[2 * t2 + 1][0]) : "v"(a0) : "memory");
            asm volatile("ds_read_b64_tr_b4 %0, %1 offset:2056" : "=v"(tr[2 * t2 + 1][1]) : "v"(a0) : "memory"); }
        asm volatile("s_waitcnt lgkmcnt(0)" : "+v"(tr[0][0]), "+v"(tr[0][1]), "+v"(tr[1][0]), "+v"(tr[1][1]), "+v"(tr[2][0]), "+v"(tr[2][1]), "+v"(tr[3][0]), "+v"(tr[3][1]), "+v"(tr[4][0]), "+v"(tr[4][1]), "+v"(tr[5][0]), "+v"(tr[5][1]), "+v"(tr[6][0]), "+v"(tr[6][1]), "+v"(tr[7][0]), "+v"(tr[7][1]) :: "memory");
        __builtin_amdgcn_sched_barrier(0);
#pragma unroll
        for (int t = 0; t < 8; ++t) { const int nt = 8 * hb + t; v8i B; B[0] = (int)tr[t][0].x; B[1] = (int)tr[t][0].y; B[2] = (int)tr[t][1].x; B[3] = (int)tr[t][1].y; B[4] = 0; B[5] = 0; B[6] = 0; B[7] = 0;
            f32x4 c = {0.f, 0.f, 0.f, 0.f};
            c = __builtin_amdgcn_mfma_scale_f32_16x16x128_f8f6f4(A, B, c, 4  , 4  , 0, 0, 0, 0);
            const float val = c[0] + c[1] * 0.125f + c[2] * 0.015625f + c[3] * 0.001953125f;
            if (q == 0) scr[16 * nt + n] = val; }
    }
    asm volatile("s_waitcnt lgkmcnt(0)" ::: "memory");
    const f32x4 v = *(const LAS f32x4*)(scr + 4 * lane);
    const float k = S.cs;
    f32x4 o; o.x = (S.xo.x + bf_lo(S.dl.x)) + S.xg.x * (k * v.x); o.y = (S.xo.y + bf_hi(S.dl.x)) + S.xg.y * (k * v.y); o.z = (S.xo.z + bf_lo(S.dl.y)) + S.xg.z * (k * v.z); o.w = (S.xo.w + bf_hi(S.dl.y)) + S.xg.w * (k * v.w);
    __builtin_nontemporal_store(o, (f32x4*)outp);
}
__device__ __forceinline__ void peer_vslice_mfma(const Args& a, Frame& F, int pv = 0) {
    const int x = F.sl_x, wx = F.sl_rank * NWAVES + F.wave, nwx = F.sl_n * NWAVES;
    if (wx >= T) return;
    const int lane = F.lane, eg = lane >> 3, p = lane & 7;
    const unsigned char* TB = a.ws + WS_V + (size_t)x * (2 * MiB); const unsigned poff = 16u * (unsigned)p;
    const unsigned* Wb = (const unsigned*)(a.ws + WS_EIDX) + 16 * eg;
    const unsigned char* CPb = a.ws + WS_CP + ((lane & 15) & 3) * 64 + 16 * (lane >> 4);
    const float* CSb = (const float*)(a.ws + WS_CS);
    const int dcol = 256 * x + 4 * lane;
    const float* G2 = (const float*)(a.ws + WS_MOD) + 5120 + dcol;
    const unsigned char* DLb = a.ws + WS_DELTA + 2 * dcol;
    LAS unsigned char* img = F.lds + F.wave * 17408;
    v4u nA[4], nB[4]; VStr sA, sB;
    int tA = wx, tB = wx + nwx;
#define PS_LDW(dst, tok) do { const unsigned* _w = Wb + (size_t)((tok) < T ? (tok) : T - 1) * 128; _Pragma("unroll") for (int _q = 0; _q < 4; ++_q) dst[_q] = *(const v4u*)(_w + 4 * _q); } while (0)
#define VS_STREAM(S, tok) do { const int _t = (tok) < T ? (tok) : T - 1; vmfma_stream(S, CPb + (size_t)_t * 256, CSb + _t, a.x + (size_t)_t * D + dcol, G2 + (size_t)(_t / SEQ) * 6144, DLb + (size_t)_t * 2048); } while (0)
    PS_LDW(nA, tA); PS_LDW(nB, tB); VS_STREAM(sA, tA); VS_STREAM(sB, tB);
#pragma unroll 1
    for (; tA < T; tA += 2 * nwx, tB += 2 * nwx) {
        VTok A, B;
        vmfma_issue(TB, poff, nA, A);
        vmfma_issue(TB, poff, nB, B);
        const VStr cA = sA, cB = sB;
        VS_STREAM(sA, tA + 2 * nwx); VS_STREAM(sB, tB + 2 * nwx);
        vmfma_compute(A, cA, lane, img, a.out + (size_t)tA * D + dcol, pv);
        PS_LDW(nA, tA + 2 * nwx); PS_LDW(nB, tB + 2 * nwx);
        if (tB < T) vmfma_compute(B, cB, lane, img, a.out + (size_t)tB * D + dcol, pv);
    }
#undef VS_STREAM
#undef PS_LDW
}

constexpr int N_PHASES = 11;
__global__ void __launch_bounds__(NTHREADS, 2) fwd_kernel(Args a) {
    extern __shared__ __attribute__((aligned(16))) unsigned char lds_raw[];
    Frame F; F.lds = (LAS unsigned char*)lds_raw; F.tid = threadIdx.x; F.lane = F.tid & 63; F.wave = __builtin_amdgcn_readfirstlane(F.tid >> 6); F.G = gridDim.x; F.bid = blockIdx.x;
    const int lo = a.ph_lo, hi = a.ph_hi;
    F.sl_x = F.bid & 3; F.sl_rank = F.bid >> 2; F.sl_n = (F.G - F.sl_x + 3) >> 2;
    unsigned* ctl = (unsigned*)(a.ws + WS_CTL);
    const bool census = (lo == 0 && hi == N_PHASES);
    int my_xcc = 0, my_rank = 0;
    XcdBarrier xbar; xbar.bar = ctl + 4096; xbar.x = 0; xbar.st = (volatile LAS unsigned*)(F.lds + LDS_BYTES - 32);
    if (census) {
        if (F.tid == 0) { xbar.st[0] = 0u; xbar.st[1] = 0u; }
        __syncthreads();
        xbar = xcd_barrier_post(ctl + 4096, (volatile LAS unsigned*)(F.lds + LDS_BYTES - 32));
    }
    if (census) {
        LAS volatile unsigned* top = (LAS volatile unsigned*)(F.lds + LDS_BYTES - 64);
        if (F.tid == 0) { const unsigned xcc = (unsigned)__builtin_amdgcn_s_getreg((3 << 11) | 20) & 7u;
            top[0] = xcc; top[1] = __hip_atomic_fetch_add(ctl + 64 * xcc, 1u, __ATOMIC_RELAXED, __HIP_MEMORY_SCOPE_AGENT); }
        __syncthreads();
        my_xcc = __builtin_amdgcn_readfirstlane((int)top[0]); my_rank = __builtin_amdgcn_readfirstlane((int)top[1]);
    }
#ifndef PH_MASK
#define PH_MASK 0x7ff
#endif
#define REPS(k) ((REP_PH == (k)) ? REP_N : 0)
#define IN(k) (((PH_MASK >> (k)) & 1) && lo <= (k) && (k) < hi)
#define PHASE_IDS() do { int _t = threadIdx.x; asm volatile("" : "+v"(_t)); F.tid = _t; F.lane = _t & 63; } while (0)
#define SEAM(k) do { if (IN(k) && IN((k) + 1)) { if ((k) == 0 && USE_CG_SYNC) cg::this_grid().sync(); else xcd_barrier(xbar); } } while (0)
    const float* mod = (const float*)(a.ws + WS_MOD);
    for (int rep = 0; rep <= REPS(0); ++rep) if (IN(0)) { if (rep) xcd_barrier(xbar); PHASE_IDS(); for (int it = F.bid; it < 192; it += F.G) mod_item(a, F, it); prep_rest(a, F); }
    SEAM(0);
    for (int rep = 0; rep <= REPS(1); ++rep) if (IN(1)) { if (rep) xcd_barrier(xbar); PHASE_IDS(); modnorm_rows<false, 8>(a, F, a.x, a.norm1_g, 0, 1024); }
    SEAM(1);
    for (int rep = 0; rep <= REPS(2); ++rep) if (IN(2)) { if (rep) xcd_barrier(xbar); PHASE_IDS();
        pg8::Gemm g{(const bf16*)(a.ws + WS_H), (const bf16*)(a.ws + WS_WIN), T, NIN, D}; pg8::StaticOrder S; S.init(T, NIN, F.G, F.bid);
        pg8::EpiBf16 E{(bf16*)(a.ws + WS_PROJ), NIN};
        pg8::gemm_phase<pg8::EpiBf16, pg8::StaticOrder, true, true>(F.lds, g, S, E);
        const int extra = S.nwg % F.G;
        if (extra == 0) quant_tables(a, F, F.bid * NWAVES + F.wave, F.G * NWAVES);
        else if (F.bid >= extra) quant_tables(a, F, (F.bid - extra) * NWAVES + F.wave, (F.G - extra) * NWAVES);
    }
    SEAM(2);
    for (int rep = 0; rep <= REPS(3); ++rep) if (IN(3)) { if (rep) xcd_barrier(xbar); PHASE_IDS();
        if (ATT_ON && a.var != 2 && (rep == 0 || MIX_VAR != 2)) { for (int u = F.bid; u < 512; u += F.G) attn_unit(a, F, u, rep == 0 ? 0 : ATT_VAR); }
        if (CONV_ON && a.var != 1 && (rep == 0 || MIX_VAR != 1)) { for (int u = F.bid; u < 256; u += F.G) conv_unit(a, F, u); }
    }
    SEAM(3);
    for (int rep = 0; rep <= REPS(4); ++rep) if (IN(4)) { if (rep) xcd_barrier(xbar); PHASE_IDS();
        pg8::Gemm g{(const bf16*)(a.ws + WS_MIX), (const bf16*)(a.ws + WS_WOUT), T, D, D}; pg8::StaticOrder S; S.init(T, D, F.G, F.bid);
        pg8::EpiGateBf16 E{(bf16*)(a.ws + WS_DELTA), D, mod + 2048, 6144, SEQ};
        pg8::gemm_phase<pg8::EpiGateBf16, pg8::StaticOrder, true, true>(F.lds, g, S, E);
    }
    SEAM(4);
    for (int rep = 0; rep <= REPS(5); ++rep) if (IN(5)) { if (rep) xcd_barrier(xbar); PHASE_IDS(); modnorm_rows<true, 4>(a, F, a.x, a.norm2_g, 3072, 4096); }
    SEAM(5);
    for (int rep = 0; rep <= REPS(6); ++rep) if (IN(6)) { if (rep) xcd_barrier(xbar); PHASE_IDS();
        pg8::Gemm g{(const bf16*)(a.ws + WS_H), (const bf16*)(a.ws + WS_WQ), T, NQ, D}; pg8::StaticOrder S; S.init(T, NQ, F.G, F.bid);
        pg8::EpiBf16 E{(bf16*)(a.ws + WS_PROJ), NQ};
        pg8::gemm_phase<pg8::EpiBf16, pg8::StaticOrder, true, true>(F.lds, g, S, E);
    }
    SEAM(6);
    for (int rep = 0; rep <= REPS(7); ++rep) if (IN(7)) { if (rep) xcd_barrier(xbar); PHASE_IDS();
        const int h = F.bid & 7, nbh = (F.G - h + 7) >> 3;
        { const bf16* KEYS = (const bf16*)(a.ws + WS_KEYS); LAS bf16* KL = (LAS bf16*)F.lds;
          v4u kv[8];
#pragma unroll
          for (int j = 0; j < 8; ++j) { const int i = F.tid + j * NTHREADS; const int sd = i >> 11, row = (i >> 4) & 127, c16 = i & 15; kv[j] = *(const v4u*)(KEYS + ((size_t)(sd * 8 + h) * 128 + row) * 128 + 8 * c16); }
#pragma unroll
          for (int j = 0; j < 8; ++j) { const int i = F.tid + j * NTHREADS; const int sd = i >> 11, row = (i >> 4) & 127, c16 = i & 15; *(LAS v4u*)(KL + (sd * 128 + row) * KEY_LDS_STRIDE + 8 * c16) = kv[j]; } }
        __syncthreads();
        for (int t = (F.bid >> 3) * NWAVES + F.wave; t < T / 32; t += nbh * NWAVES) topk_unit(a, F, t, h);
        __syncthreads(); }
    SEAM(7);
    if (census) {
        unsigned sum = 0; bool ok = true; unsigned mine = 1, other = 0;
#pragma unroll
        for (int j = 0; j < 8; ++j) { const unsigned cj = __hip_atomic_load(ctl + 64 * j, __ATOMIC_RELAXED, __HIP_MEMORY_SCOPE_AGENT); sum += cj; ok = ok && (cj > 0u); if (j == my_xcc) mine = cj; if (j == (my_xcc ^ 4)) other = cj; }
        if (ok && sum == (unsigned)F.G) { F.sl_x = my_xcc & 3; F.sl_rank = my_rank + ((my_xcc & 4) ? (int)other : 0); F.sl_n = (int)(mine + other); }
    }
    for (int rep = 0; rep <= REPS(8); ++rep) if (IN(8)) { if (rep) xcd_barrier(xbar); PHASE_IDS(); peer_slice<false>(a, F); }
    SEAM(8);
    for (int rep = 0; rep <= REPS(9); ++rep) if (IN(9)) { if (rep) xcd_barrier(xbar); PHASE_IDS(); peer_coef(a, F); }
    SEAM(9);
    for (int rep = 0; rep <= REPS(10); ++rep) if (IN(10)) { if (rep) xcd_barrier(xbar); PHASE_IDS(); if (V_MFMA) peer_vslice_mfma(a, F, (rep >= 1 && rep < REP_N) ? VS_VAR : 0); else peer_slice<true>(a, F); }
#undef IN
#undef SEAM
}

extern "C" void kernel_launch(void* const* d_in, const int* in_sizes, int n_in, void* d_out, int out_size, void* d_ws, size_t ws_size, hipStream_t stream) {
    static int grid = 0;
    if (grid == 0) {
        if (n_in != 19 || in_sizes[0] != T * D || out_size != T * D || ws_size < WS_END) { fprintf(stderr, "kernel_launch: unexpected shapes (n_in %d, in0 %d, out %d, ws %zu)\n", n_in, n_in > 0 ? in_sizes[0] : -1, out_size, ws_size); grid = -1; return; }
        int dev = 0, cus = 0, per_cu = 0;
        hipGetDevice(&dev); hipDeviceGetAttribute(&cus, hipDeviceAttributeMultiprocessorCount, dev);
        hipFuncSetAttribute((const void*)fwd_kernel, hipFuncAttributeMaxDynamicSharedMemorySize, LDS_BYTES);
        hipOccupancyMaxActiveBlocksPerMultiprocessor(&per_cu, (const void*)fwd_kernel, NTHREADS, LDS_BYTES);
        (void)hipGetLastError();
        if (per_cu < 1) { fprintf(stderr, "kernel_launch: occupancy query says %d blocks/CU\n", per_cu); per_cu = 1; }
        grid = cus * 1;
    }
    if (grid < 0) return;
    (void)hipMemsetAsync(d_ws, 0, 32768, stream);
    Args a{};
    const float** p = (const float**)&a;
    for (int i = 0; i < 19; ++i) p[i] = (const float*)d_in[i];
    a.out = (float*)d_out; a.ws = (unsigned char*)d_ws;
#if N_LAUNCH_SPLIT
    for (int ph = 0; ph < N_PHASES; ++ph) { a.ph_lo = ph; a.ph_hi = ph + 1;
        for (int rep = 0; rep < (((REP_MASK >> ph) & 1) ? 2 : 1); ++rep) hipLaunchKernelGGL(fwd_kernel, dim3(grid), dim3(NTHREADS), LDS_BYTES, stream, a); }
    for (int ph = 0; ph < N_PHASES - 1; ++ph) if ((LATE_MASK >> ph) & 1) { a.ph_lo = ph; a.ph_hi = ph + 1; a.var = LATE_VAR; hipLaunchKernelGGL(fwd_kernel, dim3(grid), dim3(NTHREADS), LDS_BYTES, stream, a); }
#else
    a.ph_lo = 0; a.ph_hi = N_PHASES;
    void* args[] = {&a};
    hipError_t e = hipLaunchCooperativeKernel((const void*)fwd_kernel, dim3(grid), dim3(NTHREADS), args, LDS_BYTES, stream);
    if (e != hipSuccess) fprintf(stderr, "cooperative launch failed: %s (grid %d)\n", hipGetErrorString(e), grid);
#endif
}
```
